# Optimizing an MI355X kernel written in HIP

```python
import math
import jax
import jax.numpy as jnp
from jax import lax
import numpy as np

D_MODEL = 1024
BATCH = 4
SEQ = 8192
DEPTH = 1

GRID_W = 64
CTX_LEN = 256
N_MOD = 6
EPS = 1e-6

SSM_WIDTH = D_MODEL // 2
SSM_GROUP = 16
SSM_GROUPS = SSM_WIDTH // SSM_GROUP
SSM_STATE = 64
STEP_MIN = 1e-3
STEP_MAX = 1e-1

HEAD_DIM = 64
N_HEADS = (D_MODEL // 2) // HEAD_DIM
N_KV_HEADS = N_HEADS // 4
GQA_GROUP = N_HEADS // N_KV_HEADS
ATTN_WIDTH = N_HEADS * HEAD_DIM
KV_WIDTH = N_KV_HEADS * HEAD_DIM
ROPE_THETA = 10000.0
Q_BLOCK = 128

COL_K = SSM_WIDTH
COL_V = COL_K + KV_WIDTH
COL_Q = COL_V + KV_WIDTH
COL_GATE = COL_Q + ATTN_WIDTH
D_IN = COL_GATE + 2 * D_MODEL

N_EXPERTS = 32
TOP_K = 4
D_EXPERT = D_MODEL
SWIGLU_ALPHA = 1.702
SWIGLU_LIMIT = 7.0
MOE_BLOCK = 256

kernel_name = 'hybrid_s5_gqa_moe_dit_block'


def _silu(x):
    return x * jax.nn.sigmoid(x)


def _rmsnorm(x, g):
    xf = x.astype(jnp.float32)
    y = xf * lax.rsqrt(jnp.mean(xf * xf, axis=-1, keepdims=True) + EPS)
    return (y * g.astype(jnp.float32)).astype(x.dtype)


def _modulate(h, shift, scale):
    return h * (1 + scale) + shift


def _scan_combine(left, right):
    a_l, b_l = left
    a_r, b_r = right
    return a_r * a_l, a_r * b_l + b_r


def _diag_scan(lbar, bu, h0, reverse):
    if h0 is not None:
        edge = -1 if reverse else 0
        bu = bu.at[:, edge].add(lbar * h0)
    a = jnp.broadcast_to(lbar, (1,) + bu.shape[1:])
    _, h = lax.associative_scan(_scan_combine, (a, bu), reverse=reverse, axis=1)
    return h


def _s5_discretise(lam_re, lam_im, log_step, b_re, b_im):
    f32 = jnp.float32
    lam = lax.complex(lam_re.astype(f32), lam_im.astype(f32))
    step = jnp.exp(log_step.astype(f32))[:, None]
    lbar = jnp.exp(lam * step)
    bmat = lax.complex(b_re.astype(f32), b_im.astype(f32))
    bbar = ((lbar - 1) / lam)[..., None] * bmat
    return lbar, bbar


def _s5_readout(h, cmat):
    b_, l_ = h.shape[:2]
    return jnp.einsum('blgn,gpn->blgp', h, cmat).real.reshape(b_, l_, SSM_WIDTH)


def _s5_mixer(u, u_c, lam_re, lam_im, log_step, b_re, b_im, c_re, c_im, d_skip, with_ctx_out):
    f32 = jnp.float32
    b_, l_, _ = u.shape
    lc = u_c.shape[1]
    uf = u.astype(f32)
    ucf = u_c.astype(f32)
    ug = uf.reshape(b_, l_, SSM_GROUPS, SSM_GROUP)
    ucg = ucf.reshape(b_, lc, SSM_GROUPS, SSM_GROUP)
    d = d_skip.astype(f32)
    y = uf * d
    y_c = ucf * d if with_ctx_out else None
    for direction, reverse in enumerate((False, True)):
        lbar, bbar = _s5_discretise(lam_re[direction], lam_im[direction], log_step[direction],
                                    b_re[direction], b_im[direction])
        cmat = lax.complex(c_re[direction].astype(f32), c_im[direction].astype(f32))
        h_c = _diag_scan(lbar, jnp.einsum('blgp,gnp->blgn', ucg, bbar), None, reverse)
        h0 = h_c[:, 0] if reverse else h_c[:, -1]
        h = _diag_scan(lbar, jnp.einsum('blgp,gnp->blgn', ug, bbar), h0, reverse)
        y = y + _s5_readout(h, cmat)
        if with_ctx_out:
            y_c = y_c + _s5_readout(h_c, cmat)
    return y.astype(u.dtype), (y_c.astype(u.dtype) if with_ctx_out else None)


def _axial_rope_tables(row_id, col_id):
    half = HEAD_DIM // 2
    inv_freq = ROPE_THETA ** (-jnp.arange(0, half, 2, dtype=jnp.float32) / half)
    ang = jnp.concatenate([row_id.astype(jnp.float32)[:, None] * inv_freq,
                           col_id.astype(jnp.float32)[:, None] * inv_freq], axis=-1)
    return jnp.cos(ang), jnp.sin(ang)


def _rope(x, cos, sin):
    xf = x.astype(jnp.float32)
    x1, x2 = xf[..., 0::2], xf[..., 1::2]
    cos = cos[None, :, None, :]
    sin = sin[None, :, None, :]
    out = jnp.stack([x1 * cos - x2 * sin, x1 * sin + x2 * cos], axis=-1).reshape(x.shape)
    return out.astype(x.dtype)


def _attention(q, k, v):
    b_, lq = q.shape[:2]
    nb = lq // Q_BLOCK
    scale = HEAD_DIM ** -0.5
    qb = q.reshape(b_, nb, Q_BLOCK, N_KV_HEADS, GQA_GROUP, HEAD_DIM).transpose(1, 0, 2, 3, 4, 5)

    def one_block(qblk):
        s = jnp.einsum('bqkgd,bskd->bkgqs', qblk, k).astype(jnp.float32) * scale
        p = jax.nn.softmax(s, axis=-1).astype(v.dtype)
        return jnp.einsum('bkgqs,bskd->bqkgd', p, v)

    o = lax.map(one_block, qb)
    return o.transpose(1, 0, 2, 3, 4, 5).reshape(b_, lq, ATTN_WIDTH)


def _merge_branches(y_ssm, o_attn, gate_logits, w_glu, b_glu, w_ssm_out, w_attn_out, w_out):
    s = jax.nn.gelu(y_ssm)
    s = s * jax.nn.sigmoid(s @ w_glu + b_glu)
    gates = jax.nn.sigmoid(gate_logits)
    merged = gates[..., :D_MODEL] * (s @ w_ssm_out) + gates[..., D_MODEL:] * (o_attn @ w_attn_out)
    return merged @ w_out


def _moe(h, router_w, router_b, w_gate_up, b_gate_up, w_down, b_down):
    t_ = h.shape[0]
    m_ = t_ * TOP_K
    nb = (m_ + N_EXPERTS * (MOE_BLOCK - 1)) // MOE_BLOCK
    logits = (h @ router_w + router_b).astype(jnp.float32)
    top_vals, top_idx = lax.top_k(logits, TOP_K)
    gates = jax.nn.softmax(top_vals, axis=-1)
    flat_e = top_idx.reshape(-1)
    order = jnp.argsort(flat_e)
    sorted_e = flat_e[order]
    sorted_tok = order // TOP_K
    counts = jnp.bincount(flat_e, length=N_EXPERTS)
    starts = jnp.cumsum(counts) - counts
    blk_counts = (counts + MOE_BLOCK - 1) // MOE_BLOCK
    blk_ends = jnp.cumsum(blk_counts)
    pad_starts = (blk_ends - blk_counts) * MOE_BLOCK
    dest = pad_starts[sorted_e] + (jnp.arange(m_) - starts[sorted_e])
    n_slots = nb * MOE_BLOCK
    slot_tok = jnp.full((n_slots,), t_, jnp.int32).at[dest].set(sorted_tok.astype(jnp.int32))
    slot_gate = jnp.zeros((n_slots,), jnp.float32).at[dest].set(gates.reshape(-1)[order])
    block_expert = jnp.minimum(jnp.searchsorted(blk_ends, jnp.arange(nb), side='right'), N_EXPERTS - 1)
    h_pad = jnp.concatenate([h, jnp.zeros((1, h.shape[1]), h.dtype)], axis=0)
    xb = h_pad[slot_tok].reshape(nb, MOE_BLOCK, h.shape[1])

    def expert_block(args):
        xblk, e = args
        gu = xblk @ w_gate_up[e] + b_gate_up[e]
        gate, up = gu[..., :D_EXPERT], gu[..., D_EXPERT:]
        gate = jnp.minimum(gate, SWIGLU_LIMIT)
        up = jnp.clip(up, -SWIGLU_LIMIT, SWIGLU_LIMIT)
        act = (up + 1) * (gate * jax.nn.sigmoid(SWIGLU_ALPHA * gate))
        return act @ w_down[e] + b_down[e]

    yb = lax.map(expert_block, (xb, block_expert)).reshape(n_slots, -1).astype(jnp.float32)
    out = jnp.zeros((t_ + 1, h.shape[1]), jnp.float32).at[slot_tok].add(yb * slot_gate[:, None])
    return out[:t_].astype(h.dtype)


def setup_inputs(seed: int = 0) -> dict:
    key = jax.random.key(seed)
    ks = jax.random.split(key, 40)
    f32 = jnp.float32

    def nrm(k, shape, scale):
        return jax.random.normal(k, shape, f32) * scale

    def gain(k, shape):
        return 1.0 + 0.05 * jax.random.normal(k, shape, f32)

    n_idx = jnp.arange(SSM_STATE, dtype=f32)
    lam_shape = (DEPTH, 2, SSM_GROUPS, SSM_STATE)
    return {
        'x': nrm(ks[0], (BATCH, SEQ, D_MODEL), 1.0),
        'c': nrm(ks[1], (BATCH, D_MODEL), 1.0),
        'ctx': nrm(ks[2], (BATCH, CTX_LEN, D_MODEL), 1.0),
        'c_ctx': nrm(ks[3], (D_MODEL,), 1.0),
        'w_mod': nrm(ks[4], (DEPTH, D_MODEL, N_MOD * D_MODEL), 0.5 * D_MODEL ** -0.5),
        'b_mod': nrm(ks[5], (DEPTH, N_MOD * D_MODEL), 0.02),
        'norm1_g': gain(ks[6], (DEPTH, D_MODEL)),
        'norm2_g': gain(ks[7], (DEPTH, D_MODEL)),
        'w_in': nrm(ks[8], (DEPTH, D_MODEL, D_IN), D_MODEL ** -0.5),
        's5_lam_re': -0.5 + nrm(ks[9], lam_shape, 0.01),
        's5_lam_im': math.pi * n_idx + nrm(ks[10], lam_shape, 0.01),
        's5_log_step': jax.random.uniform(ks[11], (DEPTH, 2, SSM_GROUPS), f32,
                                          minval=math.log(STEP_MIN), maxval=math.log(STEP_MAX)),
        's5_b_re': nrm(ks[12], (DEPTH, 2, SSM_GROUPS, SSM_STATE, SSM_GROUP), (2 * SSM_GROUP) ** -0.5),
        's5_b_im': nrm(ks[13], (DEPTH, 2, SSM_GROUPS, SSM_STATE, SSM_GROUP), (2 * SSM_GROUP) ** -0.5),
        's5_c_re': nrm(ks[14], (DEPTH, 2, SSM_GROUPS, SSM_GROUP, SSM_STATE), SSM_STATE ** -0.5),
        's5_c_im': nrm(ks[15], (DEPTH, 2, SSM_GROUPS, SSM_GROUP, SSM_STATE), SSM_STATE ** -0.5),
        's5_d': nrm(ks[16], (DEPTH, SSM_WIDTH), 1.0),
        'w_glu': nrm(ks[17], (DEPTH, SSM_WIDTH, SSM_WIDTH), SSM_WIDTH ** -0.5),
        'b_glu': nrm(ks[18], (DEPTH, SSM_WIDTH), 0.02),
        'w_ssm_out': nrm(ks[19], (DEPTH, SSM_WIDTH, D_MODEL), SSM_WIDTH ** -0.5),
        'q_norm_g': gain(ks[20], (DEPTH, HEAD_DIM)),
        'k_norm_g': gain(ks[21], (DEPTH, HEAD_DIM)),
        'w_attn_out': nrm(ks[22], (DEPTH, ATTN_WIDTH, D_MODEL), ATTN_WIDTH ** -0.5),
        'w_out': nrm(ks[23], (DEPTH, D_MODEL, D_MODEL), D_MODEL ** -0.5),
        'router_w': nrm(ks[24], (DEPTH, D_MODEL, N_EXPERTS), D_MODEL ** -0.5),
        'router_b': nrm(ks[25], (DEPTH, N_EXPERTS), 0.01),
        'w_gate_up': nrm(ks[26], (DEPTH, N_EXPERTS, D_MODEL, 2 * D_EXPERT), D_MODEL ** -0.5),
        'b_gate_up': nrm(ks[27], (DEPTH, N_EXPERTS, 2 * D_EXPERT), 0.02),
        'w_down': nrm(ks[28], (DEPTH, N_EXPERTS, D_EXPERT, D_MODEL), D_EXPERT ** -0.5),
        'b_down': nrm(ks[29], (DEPTH, N_EXPERTS, D_MODEL), 0.02),
        'final_norm_g': gain(ks[30], (D_MODEL,)),
    }


def reference(x, c, ctx, c_ctx, w_mod, b_mod, norm1_g, norm2_g, w_in,
              s5_lam_re, s5_lam_im, s5_log_step, s5_b_re, s5_b_im, s5_c_re, s5_c_im, s5_d,
              w_glu, b_glu, w_ssm_out, q_norm_g, k_norm_g, w_attn_out, w_out,
              router_w, router_b, w_gate_up, b_gate_up, w_down, b_down, final_norm_g):
    b_, l_, _ = x.shape
    lc = ctx.shape[1]
    rows = l_ // GRID_W
    row_id = jnp.repeat(jnp.arange(rows, dtype=jnp.int32), GRID_W)
    col_id = jnp.arange(rows * GRID_W, dtype=jnp.int32) % GRID_W
    cos, sin = _axial_rope_tables(row_id, col_id)

    for i in range(DEPTH):
        update_ctx = i < DEPTH - 1
        mod = (_silu(c) @ w_mod[i] + b_mod[i])[:, None, :]
        sh1, sc1, g1, sh2, sc2, g2 = jnp.split(mod, N_MOD, axis=-1)
        mod_c = _silu(c_ctx) @ w_mod[i] + b_mod[i]
        sh1c, sc1c, g1c, sh2c, sc2c, g2c = jnp.split(mod_c, N_MOD, axis=-1)

        h = _modulate(_rmsnorm(x, norm1_g[i]), sh1, sc1)
        hc = _modulate(_rmsnorm(ctx, norm1_g[i]), sh1c, sc1c)
        proj = h @ w_in[i]
        n_ctx_cols = D_IN if update_ctx else COL_Q
        proj_c = hc @ w_in[i][:, :n_ctx_cols]

        y_ssm, y_ssm_c = _s5_mixer(proj[..., :SSM_WIDTH], proj_c[..., :SSM_WIDTH],
                                   s5_lam_re[i], s5_lam_im[i], s5_log_step[i],
                                   s5_b_re[i], s5_b_im[i], s5_c_re[i], s5_c_im[i], s5_d[i],
                                   update_ctx)

        q = proj[..., COL_Q:COL_GATE].reshape(b_, l_, N_HEADS, HEAD_DIM)
        k = proj[..., COL_K:COL_V].reshape(b_, l_, N_KV_HEADS, HEAD_DIM)
        v = proj[..., COL_V:COL_Q].reshape(b_, l_, N_KV_HEADS, HEAD_DIM)
        q = _rope(_rmsnorm(q, q_norm_g[i]), cos, sin)
        k = _rope(_rmsnorm(k, k_norm_g[i]), cos, sin)
        k_c = _rmsnorm(proj_c[..., COL_K:COL_V].reshape(b_, lc, N_KV_HEADS, HEAD_DIM), k_norm_g[i])
        v_c = proj_c[..., COL_V:COL_Q].reshape(b_, lc, N_KV_HEADS, HEAD_DIM)
        k_all = jnp.concatenate([k_c, k], axis=1)
        v_all = jnp.concatenate([v_c, v], axis=1)
        o_attn = _attention(q, k_all, v_all)

        x_mix = x + g1 * _merge_branches(y_ssm, o_attn, proj[..., COL_GATE:],
                                         w_glu[i], b_glu[i], w_ssm_out[i], w_attn_out[i], w_out[i])

        h2 = _modulate(_rmsnorm(x_mix, norm2_g[i]), sh2, sc2).reshape(b_ * l_, D_MODEL)
        if update_ctx:
            q_c = _rmsnorm(proj_c[..., COL_Q:COL_GATE].reshape(b_, lc, N_HEADS, HEAD_DIM), q_norm_g[i])
            o_attn_c = _attention(q_c, k_c, v_c)
            ctx_mix = ctx + g1c * _merge_branches(y_ssm_c, o_attn_c, proj_c[..., COL_GATE:],
                                                  w_glu[i], b_glu[i], w_ssm_out[i], w_attn_out[i], w_out[i])
            h2c = _modulate(_rmsnorm(ctx_mix, norm2_g[i]), sh2c, sc2c).reshape(b_ * lc, D_MODEL)
            f = _moe(jnp.concatenate([h2, h2c], axis=0), router_w[i], router_b[i],
                     w_gate_up[i], b_gate_up[i], w_down[i], b_down[i])
            x = x_mix + g2 * f[:b_ * l_].reshape(x.shape)
            ctx = ctx_mix + g2c * f[b_ * l_:].reshape(ctx.shape)
        else:
            f = _moe(h2, router_w[i], router_b[i], w_gate_up[i], b_gate_up[i], w_down[i], b_down[i])
            x = x_mix + g2 * f.reshape(x.shape)

    return _rmsnorm(x, final_norm_g)
```

```cpp
#include <hip/hip_runtime.h>
#include <cstdio>
#include <cstdint>

constexpr int NB = 4, SEQ = 8192, DM = 1024, LC = 256;
constexpr int T = NB * SEQ;
constexpr int TC = NB * LC;
constexpr int TR = T + TC;
constexpr int DIN = 3328, COL_K = 512, COL_V = 640, COL_Q = 768, COL_GATE = 1280;
constexpr int NMOD = 6 * DM;
constexpr int SKV = LC + SEQ;
constexpr int NE = 32;
constexpr int NSLOT_MAX = 139264;
constexpr int NCHUNK_PAD = 2304;
constexpr float EPS = 1e-6f;
constexpr float C2 = 0.125f * 1.4426950408889634f;

constexpr size_t MiB = 1u << 20;
constexpr size_t WS_CTL = 0;
constexpr size_t WS_MOD = 1 * MiB;
constexpr size_t WS_ROPE = 1 * MiB + 256 * 1024;
constexpr size_t WS_WCNT = 2 * MiB;
constexpr size_t WS_TILE = 2 * MiB + 512 * 1024;
constexpr size_t WS_WIN = 4 * MiB, WS_WGLU = 11 * MiB, WS_W12 = 12 * MiB, WS_WOUT = 14 * MiB;
constexpr size_t WS_TCV = 16 * MiB, WS_WS5 = 24 * MiB;
constexpr size_t WS_WGU = 32 * MiB, WS_WD = 160 * MiB;
constexpr size_t WS_SL = 733 * MiB;
constexpr size_t WS_TOPI = 28 * MiB, WS_TOPG = 28 * MiB + 512 * 1024, WS_TOKSLOT = 29 * MiB;
constexpr size_t WS_SLOTTOK = 29 * MiB + 512 * 1024, WS_SLOTGATE = 30 * MiB + 512 * 1024;
constexpr size_t WS_XM = 224 * MiB;
constexpr size_t WS_H2 = 352 * MiB;
constexpr size_t WS_H1 = 417 * MiB;
constexpr size_t WS_UH = 483 * MiB;
constexpr size_t WS_KB = 555 * MiB, WS_VB = 564 * MiB;
constexpr size_t WS_QB = 573 * MiB;
constexpr size_t WS_GT = 605 * MiB;
constexpr size_t WS_SG = 769 * MiB;
constexpr size_t WS_GO = 801 * MiB;
constexpr size_t WS_M1 = 865 * MiB;
constexpr size_t WS_MG = 417 * MiB;
constexpr size_t WS_ACT = 417 * MiB;
constexpr size_t WS_YB = 689 * MiB;
constexpr size_t WS_END = 993 * MiB;

typedef unsigned short bf16;
struct P { const float* in[31]; float* out; unsigned char* ws; };

__device__ __forceinline__ float bf2f(bf16 v) { return __uint_as_float(((unsigned)v) << 16); }
__device__ __forceinline__ bf16 f2bf(float f) { unsigned u = __float_as_uint(f); return (bf16)((u + 0x7fffu + ((u >> 16) & 1u)) >> 16); }
__device__ __forceinline__ unsigned pk2(float lo, float hi) { return (unsigned)f2bf(lo) | ((unsigned)f2bf(hi) << 16); }
__device__ __forceinline__ float wave_sum(float v) {
#pragma unroll
    for (int o = 1; o < 64; o <<= 1) v += __shfl_xor(v, o);
    return v;
}
__device__ __forceinline__ float sigmoidf(float v) { return 1.f / (1.f + expf(-v)); }

__device__ __forceinline__ void ph_mod(const P& p, int bid, int nb, float* lds) {
    float* s = lds; float* red = lds + 5 * 1024;
    const float* c = p.in[1]; const float* cc = p.in[3];
    for (int i = threadIdx.x; i < 5 * 1024; i += 512) { const float v = i < 4096 ? c[i] : cc[i - 4096]; s[i] = v / (1.f + expf(-v)); }
    __syncthreads();
    const float* w = p.in[4]; const float* bm = p.in[5]; float* mod = (float*)(p.ws + WS_MOD);
    const int jl = threadIdx.x & 63, ks = threadIdx.x >> 6;
    for (int it = bid; it < 96; it += nb) {
        const int j = it * 64 + jl;
        float a0 = 0.f, a1 = 0.f, a2 = 0.f, a3 = 0.f, a4 = 0.f;
        for (int k = ks * 128; k < ks * 128 + 128; ++k) {
            const float wv = w[(size_t)k * NMOD + j];
            a0 += s[k] * wv; a1 += s[1024 + k] * wv; a2 += s[2048 + k] * wv; a3 += s[3072 + k] * wv; a4 += s[4096 + k] * wv;
        }
        red[(ks * 5 + 0) * 64 + jl] = a0; red[(ks * 5 + 1) * 64 + jl] = a1; red[(ks * 5 + 2) * 64 + jl] = a2; red[(ks * 5 + 3) * 64 + jl] = a3; red[(ks * 5 + 4) * 64 + jl] = a4;
        __syncthreads();
        if (threadIdx.x < 320) { const int r = threadIdx.x >> 6; float t = 0.f;
            for (int q = 0; q < 8; ++q) t += red[(q * 5 + r) * 64 + jl];
            mod[r * NMOD + j] = t + bm[j]; }
        __syncthreads();
    }
}
__device__ __forceinline__ void ph_rope(const P& p, int bid, int nb) {
    float* R = (float*)(p.ws + WS_ROPE);
    for (int i = bid * 512 + threadIdx.x; i < 192 * 16; i += nb * 512) {
        const int j = i & 15; const int pos = i >> 4;
        const float invf = powf(10000.f, -(float)j / 16.f);
        if (pos < 128) { const float a = (float)pos * invf; R[pos * 16 + j] = cosf(a); R[2048 + pos * 16 + j] = sinf(a); }
        else { const int cp = pos - 128; const float a = (float)cp * invf; R[4096 + cp * 16 + j] = cosf(a); R[5120 + cp * 16 + j] = sinf(a); }
    }
}
__device__ __forceinline__ void ph_h1(const P& p, int bid, int nb) {
    const int lane = threadIdx.x & 63, wave = threadIdx.x >> 6, gw = bid * 8 + wave, ngw = nb * 8;
    const float* g = p.in[6]; const float* mod = (const float*)(p.ws + WS_MOD); bf16* H1 = (bf16*)(p.ws + WS_H1);
    for (int r = gw; r < TR; r += ngw) {
        const float* xr; int mrow;
        if (r < T) { xr = p.in[0] + (size_t)r * DM; mrow = r / SEQ; } else { xr = p.in[2] + (size_t)(r - T) * DM; mrow = 4; }
        float4 v[4]; float ss = 0.f;
#pragma unroll
        for (int j = 0; j < 4; ++j) { v[j] = ((const float4*)xr)[lane + 64 * j]; ss += v[j].x * v[j].x + v[j].y * v[j].y + v[j].z * v[j].z + v[j].w * v[j].w; }
        ss = wave_sum(ss); const float rs = 1.f / sqrtf(ss * (1.f / DM) + EPS);
#pragma unroll
        for (int j = 0; j < 4; ++j) { const int col = 4 * lane + 256 * j;
            const float4 gg = *(const float4*)(g + col), sh = *(const float4*)(mod + mrow * NMOD + col), sc = *(const float4*)(mod + mrow * NMOD + 1024 + col);
            const float h0 = v[j].x * rs * gg.x * (1.f + sc.x) + sh.x, h1 = v[j].y * rs * gg.y * (1.f + sc.y) + sh.y;
            const float h2 = v[j].z * rs * gg.z * (1.f + sc.z) + sh.z, h3 = v[j].w * rs * gg.w * (1.f + sc.w) + sh.w;
            uint2 o; o.x = pk2(h0, h1); o.y = pk2(h2, h3); *(uint2*)(H1 + (size_t)r * DM + col) = o; }
    }
}
__device__ __forceinline__ void ph_route_a(const P& p, int bid, int nb, float* lds) {
    const float* rw = p.in[24];
    for (int i = threadIdx.x; i < 32768; i += 512) { const int k = i >> 5, e = i & 31; lds[e * 1024 + k] = rw[i]; }
    __syncthreads();
    const int lane = threadIdx.x & 63, wave = threadIdx.x >> 6, gw = bid * 8 + wave;
    const int rpw = T / (nb * 8);
    const float* g = p.in[7]; const float* mod = (const float*)(p.ws + WS_MOD); const float* XM = (const float*)(p.ws + WS_XM);
    bf16* H2 = (bf16*)(p.ws + WS_H2); int* TOPI = (int*)(p.ws + WS_TOPI); float* TOPG = (float*)(p.ws + WS_TOPG); int* WCNT = (int*)(p.ws + WS_WCNT);
    const int my_e = (lane >> 1) & 31; const float rb = p.in[25][my_e];
    int mycnt = 0;
    if (bid == 0) { for (int i = threadIdx.x; i < 512; i += 512) ((unsigned*)(H2 + (size_t)T * DM))[i] = 0u; }
    for (int r = gw * rpw; r < gw * rpw + rpw; ++r) {
        const int b = r / SEQ; const float* xr = XM + (size_t)r * DM;
        float4 v[4]; float ss = 0.f;
#pragma unroll
        for (int j = 0; j < 4; ++j) { v[j] = ((const float4*)xr)[lane + 64 * j]; ss += v[j].x * v[j].x + v[j].y * v[j].y + v[j].z * v[j].z + v[j].w * v[j].w; }
        ss = wave_sum(ss); const float rs = 1.f / sqrtf(ss * (1.f / DM) + EPS);
#pragma unroll
        for (int j = 0; j < 4; ++j) { const int col = 4 * lane + 256 * j;
            const float4 gg = *(const float4*)(g + col), sh = *(const float4*)(mod + b * NMOD + 3072 + col), sc = *(const float4*)(mod + b * NMOD + 4096 + col);
            v[j].x = v[j].x * rs * gg.x * (1.f + sc.x) + sh.x; v[j].y = v[j].y * rs * gg.y * (1.f + sc.y) + sh.y;
            v[j].z = v[j].z * rs * gg.z * (1.f + sc.z) + sh.z; v[j].w = v[j].w * rs * gg.w * (1.f + sc.w) + sh.w;
            uint2 o; o.x = pk2(v[j].x, v[j].y); o.y = pk2(v[j].z, v[j].w); *(uint2*)(H2 + (size_t)r * DM + col) = o; }
        float part[32];
#pragma unroll
        for (int e = 0; e < 32; ++e) { float a = 0.f;
#pragma unroll
            for (int j = 0; j < 4; ++j) { const float4 w4 = *(const float4*)(lds + e * 1024 + 4 * lane + 256 * j); a += v[j].x * w4.x + v[j].y * w4.y + v[j].z * w4.z + v[j].w * w4.w; }
            part[e] = a; asm volatile("" ::: "memory"); }
        float y16[16], y8[8], y4[4], y2[2], val;
        { const bool h = lane & 32;
#pragma unroll
          for (int i = 0; i < 16; ++i) { const float a = part[i], bq = part[i + 16]; const float send = h ? a : bq, keep = h ? bq : a; y16[i] = keep + __shfl_xor(send, 32); } }
        { const bool h = lane & 16;
#pragma unroll
          for (int i = 0; i < 8; ++i) { const float a = y16[i], bq = y16[i + 8]; const float send = h ? a : bq, keep = h ? bq : a; y8[i] = keep + __shfl_xor(send, 16); } }
        { const bool h = lane & 8;
#pragma unroll
          for (int i = 0; i < 4; ++i) { const float a = y8[i], bq = y8[i + 4]; const float send = h ? a : bq, keep = h ? bq : a; y4[i] = keep + __shfl_xor(send, 8); } }
        { const bool h = lane & 4;
#pragma unroll
          for (int i = 0; i < 2; ++i) { const float a = y4[i], bq = y4[i + 2]; const float send = h ? a : bq, keep = h ? bq : a; y2[i] = keep + __shfl_xor(send, 4); } }
        { const bool h = lane & 2; const float a = y2[0], bq = y2[1]; const float send = h ? a : bq, keep = h ? bq : a; val = keep + __shfl_xor(send, 2); }
        val += __shfl_xor(val, 1);
        float cur = val + rb; float tv[4]; int ti[4];
#pragma unroll
        for (int k = 0; k < 4; ++k) { float m = cur; int mi = my_e;
#pragma unroll
            for (int off = 2; off < 64; off <<= 1) { const float om = __shfl_xor(m, off); const int oi = __shfl_xor(mi, off); if (om > m || (om == m && oi < mi)) { m = om; mi = oi; } }
            tv[k] = m; ti[k] = mi; if (my_e == mi) { cur = -INFINITY; mycnt += (lane & 1) ? 0 : 1; } }
        const float e0 = 1.f, e1 = expf(tv[1] - tv[0]), e2 = expf(tv[2] - tv[0]), e3 = expf(tv[3] - tv[0]); const float inv = 1.f / (e0 + e1 + e2 + e3);
        if (lane == 0) { *(int4*)(TOPI + r * 4) = make_int4(ti[0], ti[1], ti[2], ti[3]); *(float4*)(TOPG + r * 4) = make_float4(e0 * inv, e1 * inv, e2 * inv, e3 * inv); }
    }
    if ((lane & 1) == 0) WCNT[gw * 32 + my_e] = mycnt;
}
__device__ __forceinline__ void ph_route_b(const P& p, int bid, int nb, int* ldsI) {
    int* partT = ldsI; int* partB = ldsI + 512; int* total = ldsI + 1024; int* before = ldsI + 1056; int* pstart = ldsI + 1088;
    const int* WCNT = (const int*)(p.ws + WS_WCNT); const int* TOPI = (const int*)(p.ws + WS_TOPI); const float* TOPG = (const float*)(p.ws + WS_TOPG);
    int* SLOT_TOK = (int*)(p.ws + WS_SLOTTOK); float* SLOT_GATE = (float*)(p.ws + WS_SLOTGATE); int* TOK_SLOT = (int*)(p.ws + WS_TOKSLOT); int* TILE_E = (int*)(p.ws + WS_TILE);
    const int t = threadIdx.x, e = t & 31, part = t >> 5, gw0 = bid * 8, nwav = nb * 8, per = nwav / 16;
    int sT = 0, sB = 0;
    for (int w = part * per; w < part * per + per; ++w) { const int c = WCNT[w * 32 + e]; sT += c; if (w < gw0) sB += c; }
    partT[part * 32 + e] = sT; partB[part * 32 + e] = sB;
    __syncthreads();
    if (t < 32) { int a = 0, bsum = 0; for (int q = 0; q < 16; ++q) { a += partT[q * 32 + t]; bsum += partB[q * 32 + t]; } total[t] = a; before[t] = bsum; }
    __syncthreads();
    if (t == 0) { int acc = 0; for (int q = 0; q < 32; ++q) { pstart[q] = acc; acc += ((total[q] + 255) / 256) * 256; } pstart[32] = acc; }
    __syncthreads();
    const int lane = t & 63, wave = t >> 6, my_e = (lane >> 1) & 31, rpw = T / nwav;
    int base = pstart[my_e] + before[my_e];
    for (int w = 0; w < wave; ++w) base += WCNT[(gw0 + w) * 32 + my_e];
    int run = 0;
    for (int r = (gw0 + wave) * rpw; r < (gw0 + wave) * rpw + rpw; ++r) {
        const int4 ti = *(const int4*)(TOPI + r * 4); const float4 tg = *(const float4*)(TOPG + r * 4);
        const int tia[4] = {ti.x, ti.y, ti.z, ti.w}; const float tga[4] = {tg.x, tg.y, tg.z, tg.w};
#pragma unroll
        for (int k = 0; k < 4; ++k) { const int ek = tia[k]; const int slot = __shfl(base + run, 2 * ek); if (my_e == ek) run++;
            if (lane == 0) { SLOT_TOK[slot] = r; SLOT_GATE[slot] = tga[k]; TOK_SLOT[r * 4 + k] = slot; } }
    }
    if (bid == 0) {
        for (int q = wave; q < 32; q += 8) { const int ps = pstart[q], pe = pstart[q + 1];
            for (int s = ps + total[q] + lane; s < pe; s += 64) { SLOT_TOK[s] = T; SLOT_GATE[s] = 0.f; }
            for (int tl = ps / 256 + lane; tl < pe / 256; tl += 64) TILE_E[tl] = q; }
        if (t == 0) TILE_E[1023] = pstart[32] / 256;
    }
}
__device__ __forceinline__ void ph_final(const P& p, int bid, int nb) {
    const int lane = threadIdx.x & 63, wave = threadIdx.x >> 6, gw = bid * 8 + wave, ngw = nb * 8;
    const float* gfin = p.in[30]; const float* mod = (const float*)(p.ws + WS_MOD); const float* XM = (const float*)(p.ws + WS_XM);
    const bf16* YB = (const bf16*)(p.ws + WS_YB); const int* TOK_SLOT = (const int*)(p.ws + WS_TOKSLOT);
    for (int r = gw; r < T; r += ngw) {
        const int b = r / SEQ; const int4 sl = *(const int4*)(TOK_SLOT + r * 4); const int sla[4] = {sl.x, sl.y, sl.z, sl.w};
        float4 v[4]; float ss = 0.f;
#pragma unroll
        for (int j = 0; j < 4; ++j) { const int col = 4 * lane + 256 * j; const float4 xm = *(const float4*)(XM + (size_t)r * DM + col);
            float f0 = 0.f, f1 = 0.f, f2 = 0.f, f3 = 0.f;
#pragma unroll
            for (int k = 0; k < 4; ++k) { const uint2 y = *(const uint2*)(YB + (size_t)sla[k] * DM + col);
                f0 += __uint_as_float(y.x << 16); f1 += __uint_as_float(y.x & 0xffff0000u); f2 += __uint_as_float(y.y << 16); f3 += __uint_as_float(y.y & 0xffff0000u); }
            const float4 g2 = *(const float4*)(mod + b * NMOD + 5120 + col);
            v[j].x = xm.x + g2.x * f0; v[j].y = xm.y + g2.y * f1; v[j].z = xm.z + g2.z * f2; v[j].w = xm.w + g2.w * f3;
            ss += v[j].x * v[j].x + v[j].y * v[j].y + v[j].z * v[j].z + v[j].w * v[j].w; }
        ss = wave_sum(ss); const float rs = 1.f / sqrtf(ss * (1.f / DM) + EPS);
#pragma unroll
        for (int j = 0; j < 4; ++j) { const int col = 4 * lane + 256 * j; const float4 gg = *(const float4*)(gfin + col);
            *(float4*)(p.out + (size_t)r * DM + col) = make_float4(v[j].x * rs * gg.x, v[j].y * rs * gg.y, v[j].z * rs * gg.z, v[j].w * rs * gg.w); }
    }
}

extern __shared__ __attribute__((aligned(16))) unsigned char dyn_lds[];
__global__ void __launch_bounds__(512) k_mod(P p) { ph_mod(p, blockIdx.x, gridDim.x, (float*)dyn_lds); ph_rope(p, blockIdx.x, gridDim.x); }
__global__ void __launch_bounds__(512) k_h1(P p) { ph_h1(p, blockIdx.x, gridDim.x); }
__global__ void __launch_bounds__(512) k_route_a(P p) { ph_route_a(p, blockIdx.x, gridDim.x, (float*)dyn_lds); }
__global__ void __launch_bounds__(512) k_route_b(P p) { ph_route_b(p, blockIdx.x, gridDim.x, (int*)dyn_lds); }
__global__ void __launch_bounds__(512) k_final(P p) { ph_final(p, blockIdx.x, gridDim.x); }


namespace pg8 {
#define PG8_LAS __attribute__((address_space(3)))
typedef unsigned short bf16_t;
typedef short bf16x8 __attribute__((ext_vector_type(8)));
typedef float f32x4 __attribute__((ext_vector_type(4)));
typedef unsigned u32x4 __attribute__((ext_vector_type(4)));
constexpr int BM = 256, BK = 64, HALF = 128, HTB = HALF * BK * 2  , STAGE_BYTES = 8 * HTB, NXCD = 8, WGM = 8;

__host__ __device__ __forceinline__ int lds_byte(int r, int c) { const int st = (r >> 4) * 2 + (c >> 5), rr = r & 15, cc = c & 31, ob = rr * 64 + cc * 2; return st * 1024 + (ob ^ (((ob >> 9) & 1) << 5)); }
__host__ __device__ __forceinline__ void stage_rc(int b, int& R, int& C) { const int st = b / 1024, sb = b % 1024, swz = sb ^ (((sb >> 9) & 1) << 5); R = (st >> 1) * 16 + swz / 64; C = (st & 1) * 32 + (swz % 64) / 2; }
__host__ __device__ __forceinline__ int perm32(int rho) { const int n = rho >> 4, i = rho & 15; return 8 * (i >> 2) + 4 * n + (i & 3); }

struct Unit { int pm, pn; };
struct GemmG { const char* A; const char* Bt; size_t a_kstep, a_hstep, a_tstep; int ldb; int K; const int* gidx; unsigned g_row; };
struct AoRow { int lda; __device__ __forceinline__ unsigned operator()(int R, int C) const { return (unsigned)(R * lda + C) * 2u; } };
struct AoGrp { __device__ __forceinline__ unsigned operator()(int R, int C) const { return (unsigned)(((C >> 4) * T + R) * 16 + (C & 15)) * 2u; } };

struct StaticOrder {
    int nM, nN, nwg, G, c;
    __host__ __device__ void init(int M, int N, int G_, int c_) { nM = M / BM; nN = N / BM; nwg = nM * nN; G = G_; c = c_; }
    __host__ __device__ bool next(int i, Unit& u) const {
        const long L = (long)i * G + c; if (L >= nwg) return false;
        int wgid = (int)L; { const int q = nwg / NXCD, r = nwg % NXCD, xcd = wgid % NXCD, off = wgid / NXCD; wgid = (xcd < r ? xcd * (q + 1) : r * (q + 1) + (xcd - r) * q) + off; }
        const int nig = WGM * nN, gid = wgid / nig, fm = gid * WGM, gsz = (nM - fm) < WGM ? (nM - fm) : WGM;
        u.pm = fm + ((wgid % nig) % gsz); u.pn = (wgid % nig) / gsz; return true;
    }
};
typedef float f32x2_t __attribute__((ext_vector_type(2))); typedef __bf16 bf16x2_t __attribute__((ext_vector_type(2)));
__device__ __forceinline__ unsigned cvt_pk_bf16(float lo, float hi) { const f32x2_t v = {lo, hi}; const bf16x2_t b = __builtin_convertvector(v, bf16x2_t); return __builtin_bit_cast(unsigned, b); }
__device__ __forceinline__ u32x4 pack8(const f32x4 a, const f32x4 b) { u32x4 w; w.x = cvt_pk_bf16(a[0], a[1]); w.y = cvt_pk_bf16(a[2], a[3]); w.z = cvt_pk_bf16(b[0], b[1]); w.w = cvt_pk_bf16(b[2], b[3]); return w; }
__device__ __forceinline__ f32x4 unpack_lo(const u32x4 w) { return (f32x4){__uint_as_float(w.x << 16), __uint_as_float(w.x & 0xffff0000u), __uint_as_float(w.y << 16), __uint_as_float(w.y & 0xffff0000u)}; }
__device__ __forceinline__ f32x4 unpack_hi(const u32x4 w) { return (f32x4){__uint_as_float(w.z << 16), __uint_as_float(w.z & 0xffff0000u), __uint_as_float(w.w << 16), __uint_as_float(w.w & 0xffff0000u)}; }
__device__ __forceinline__ float fsig(float v) { return __builtin_amdgcn_rcpf(1.f + __builtin_amdgcn_exp2f(-1.4426950408889634f * v)); }
__device__ __forceinline__ f32x4 fsig4(const f32x4 v) { return (f32x4){fsig(v[0]), fsig(v[1]), fsig(v[2]), fsig(v[3])}; }

template <class Epi, class Sched, class AO, bool GATHER = false, bool ALIGN_EPI = true>
__device__ __forceinline__ void gemm_phase(PG8_LAS unsigned char* lds, const GemmG g, const AO& ao, const Sched& S, const Epi& E) {
    const int tid = threadIdx.x, wid = __builtin_amdgcn_readfirstlane(tid >> 6), lane = tid & 63, wr = wid >> 2, wc = wid & 3, fr = lane & 15, fq = lane >> 4;
    const int K = g.K, nt = K / BK;
    unsigned voffB[2]; unsigned oc[2][2], on[2][2]; int RA[2]; unsigned CA2[2];
#pragma unroll
    for (int i = 0; i < 2; ++i) { int R, C; stage_rc(tid * 16 + i * 8192, R, C); const int Rb = (R & ~31) + perm32(R & 31);
        voffB[i] = (unsigned)(Rb * g.ldb + C) * 2u; RA[i] = R; CA2[i] = (unsigned)C * 2u;
        if constexpr (!GATHER) { oc[0][i] = ao(R, C); oc[1][i] = oc[0][i] + (unsigned)g.a_hstep; on[0][i] = oc[0][i]; on[1][i] = oc[1][i]; } }
    const size_t kstepA = g.a_kstep, kstepB = (size_t)(BK * 2);
    const size_t hstepB = (size_t)HALF * g.ldb * 2, tstepB = 2 * hstepB;
    const unsigned ldsw = (unsigned)wid * 1024u;
    const int aoff = lds_byte(wr * 64 + fr, fq * 8), boff = lds_byte(wc * 32 + fr, fq * 8);
#define PG8_SA(b, h) (((b) * 2 + (h)) * HTB)
#define PG8_SB(b, h) ((4 + (b) * 2 + (h)) * HTB)
#define PG8_STAGE_B(bufoff, gbase) do { _Pragma("unroll") for (int _i = 0; _i < 2; ++_i) \
        __builtin_amdgcn_global_load_lds((const unsigned*)((const char*)(gbase) + voffB[_i]), (PG8_LAS unsigned*)(lds + (bufoff) + ldsw + _i * 8192), 16, 0, 0); } while (0)
#define PG8_STAGE_A(bufoff, gbase, OFFS, h) do { _Pragma("unroll") for (int _i = 0; _i < 2; ++_i) \
        __builtin_amdgcn_global_load_lds((const unsigned*)((const char*)(gbase) + OFFS[h][_i]), (PG8_LAS unsigned*)(lds + (bufoff) + ldsw + _i * 8192), 16, 0, 0); } while (0)
#define PG8_LDA(dst, b, h) do { _Pragma("unroll") for (int m = 0; m < 4; ++m) _Pragma("unroll") for (int k = 0; k < 2; ++k) dst[m][k] = *(const PG8_LAS bf16x8*)(lds + PG8_SA(b, h) + aoff + m * 2048 + k * 1024); } while (0)
#define PG8_LDB(dst, b, h) do { _Pragma("unroll") for (int n = 0; n < 2; ++n) _Pragma("unroll") for (int k = 0; k < 2; ++k) dst[n][k] = *(const PG8_LAS bf16x8*)(lds + PG8_SB(b, h) + boff + n * 2048 + k * 1024); } while (0)
#define PG8_MMA(ai, bj, At, Bt) do { __builtin_amdgcn_s_setprio(1); _Pragma("unroll") for (int m = 0; m < 4; ++m) _Pragma("unroll") for (int n = 0; n < 2; ++n) _Pragma("unroll") for (int k = 0; k < 2; ++k) \
        acc[ai][bj][m][n] = __builtin_amdgcn_mfma_f32_16x16x32_bf16(Bt[n][k], At[m][k], acc[ai][bj][m][n], 0, 0, 0); __builtin_amdgcn_s_setprio(0); } while (0)
#define PG8_WAIT_V(n) asm volatile("s_waitcnt vmcnt(" #n ")" ::: "memory")
#define PG8_WAIT_L(n) asm volatile("s_waitcnt lgkmcnt(" #n ")" ::: "memory")
#define PG8_BAR __builtin_amdgcn_s_barrier()
#define PG8_SCHED __builtin_amdgcn_sched_barrier(0)
#define PG8_GIDX(dst, u) do { _Pragma("unroll") for (int _h = 0; _h < 2; ++_h) _Pragma("unroll") for (int _i = 0; _i < 2; ++_i) \
        dst[_h][_i] = (unsigned)g.gidx[(u).pm * BM + _h * HALF + RA[_i]] * g.g_row + CA2[_i]; } while (0)
    Unit cur, nxt; int ui = 0;
    if (!S.next(0, cur)) return;
    f32x4 acc[2][2][4][2];
#pragma unroll
    for (int a = 0; a < 2; ++a)
#pragma unroll
        for (int b = 0; b < 2; ++b)
#pragma unroll
            for (int m = 0; m < 4; ++m)
#pragma unroll
                for (int n = 0; n < 2; ++n) acc[a][b][m][n] = (f32x4){0.f, 0.f, 0.f, 0.f};
    bf16x8 At[4][2], B0[2][2], B1[2][2];
    if constexpr (GATHER) { PG8_GIDX(oc, cur); }
    const char* cA = GATHER ? g.A : g.A + (size_t)cur.pm * g.a_tstep; const char* cB = g.Bt + (size_t)cur.pn * tstepB;
    PG8_STAGE_B(PG8_SB(0, 0), cB); PG8_STAGE_B(PG8_SB(0, 1), cB + hstepB); PG8_STAGE_A(PG8_SA(0, 0), cA, oc, 0); PG8_STAGE_A(PG8_SA(0, 1), cA, oc, 1);
    if (wr == 1) PG8_BAR;
    PG8_WAIT_V(2); PG8_BAR;
    PG8_STAGE_B(PG8_SB(1, 0), cB + kstepB); PG8_STAGE_A(PG8_SA(1, 0), cA + kstepA, oc, 0); PG8_STAGE_B(PG8_SB(1, 1), cB + hstepB + kstepB);
    PG8_WAIT_V(6); PG8_BAR;
    for (;;) {
        const bool has_next = S.next(ui + 1, nxt);
        if constexpr (GATHER) { if (has_next) { PG8_GIDX(on, nxt); } else {
#pragma unroll
            for (int _h = 0; _h < 2; ++_h)
#pragma unroll
                for (int _i = 0; _i < 2; ++_i) on[_h][_i] = oc[_h][_i]; } }
        const char* nA = GATHER ? g.A : (has_next ? g.A + (size_t)nxt.pm * g.a_tstep : cA); const char* nB = has_next ? g.Bt + (size_t)nxt.pn * tstepB : cB;
#pragma unroll 1
        for (int t = 0; t < nt; t += 2) {
            const bool last = (t == nt - 2);
            const char* a1 = cA + (size_t)(t + 1) * kstepA;
            const char* a2 = last ? nA : cA + (size_t)(t + 2) * kstepA; const char* b2 = last ? nB : cB + (size_t)(t + 2) * kstepB;
            const char* a3 = a2 + kstepA; const char* b3 = b2 + kstepB;
            unsigned o2[2][2];
#pragma unroll
            for (int _h = 0; _h < 2; ++_h)
#pragma unroll
                for (int _i = 0; _i < 2; ++_i) o2[_h][_i] = (GATHER && last) ? on[_h][_i] : oc[_h][_i];
            PG8_LDB(B0, 0, 0); PG8_LDB(B1, 0, 1); PG8_SCHED; PG8_LDA(At, 0, 0); PG8_STAGE_A(PG8_SA(1, 1), a1, oc, 1);
            PG8_WAIT_V(8); PG8_WAIT_L(0); PG8_BAR; PG8_MMA(0, 0, At, B0); PG8_MMA(0, 1, At, B1); PG8_BAR; PG8_SCHED;
            PG8_LDA(At, 0, 1); PG8_STAGE_B(PG8_SB(0, 0), b2); PG8_STAGE_B(PG8_SB(0, 1), b2 + hstepB); PG8_STAGE_A(PG8_SA(0, 0), a2, o2, 0);
            PG8_WAIT_V(8); PG8_WAIT_L(0); PG8_BAR; PG8_MMA(1, 0, At, B0); PG8_MMA(1, 1, At, B1); PG8_BAR; PG8_SCHED;
            PG8_LDB(B0, 1, 0); PG8_LDB(B1, 1, 1); PG8_SCHED; PG8_LDA(At, 1, 0); PG8_STAGE_A(PG8_SA(0, 1), a2, o2, 1);
            PG8_WAIT_V(8); PG8_WAIT_L(0); PG8_BAR; PG8_MMA(0, 0, At, B0); PG8_MMA(0, 1, At, B1); PG8_BAR; PG8_SCHED;
            PG8_LDA(At, 1, 1); PG8_STAGE_B(PG8_SB(1, 0), b3); PG8_STAGE_B(PG8_SB(1, 1), b3 + hstepB); PG8_STAGE_A(PG8_SA(1, 0), a3, o2, 0);
            PG8_WAIT_V(8); PG8_WAIT_L(0); PG8_BAR; PG8_MMA(1, 0, At, B0); PG8_MMA(1, 1, At, B1); PG8_BAR; PG8_SCHED;
        }
        if constexpr (ALIGN_EPI) { if (wr == 0) PG8_BAR; }
        E(acc, cur, wr, wc, fr, fq);
        if (!has_next) break;
#pragma unroll
        for (int a = 0; a < 2; ++a)
#pragma unroll
            for (int b = 0; b < 2; ++b)
#pragma unroll
                for (int m = 0; m < 4; ++m)
#pragma unroll
                    for (int n = 0; n < 2; ++n) acc[a][b][m][n] = (f32x4){0.f, 0.f, 0.f, 0.f};
        cur = nxt; cA = nA; cB = nB; ++ui;
#pragma unroll
        for (int _h = 0; _h < 2; ++_h)
#pragma unroll
            for (int _i = 0; _i < 2; ++_i) oc[_h][_i] = on[_h][_i];
        if constexpr (ALIGN_EPI) { if (wr == 1) PG8_BAR; }
    }
    PG8_WAIT_V(0);
    if constexpr (!ALIGN_EPI) { if (wr == 0) PG8_BAR; }
    PG8_BAR;
#undef PG8_SA
#undef PG8_SB
#undef PG8_STAGE_A
#undef PG8_STAGE_B
#undef PG8_LDA
#undef PG8_LDB
#undef PG8_MMA
#undef PG8_WAIT_V
#undef PG8_WAIT_L
#undef PG8_BAR
#undef PG8_SCHED
#undef PG8_GIDX
}

#define EPI_ROWS(ai, m) (u.pm * BM + (ai) * HALF + wr * 64 + (m) * 16 + fr)
struct EpiProj {
    bf16_t* UH; bf16_t* KB; bf16_t* VB; bf16_t* QB; bf16_t* GT; const float* qg; const float* kg; const float* rope;
    __device__ __forceinline__ void operator()(const f32x4 (&acc)[2][2][4][2], const Unit& u, int wr, int wc, int fr, int fq) const {
        const int pn = u.pn;
        if (pn < 2) {
#pragma unroll
            for (int ai = 0; ai < 2; ++ai)
#pragma unroll
                for (int m = 0; m < 4; ++m) { const int row = EPI_ROWS(ai, m);
#pragma unroll
                    for (int bj = 0; bj < 2; ++bj) { const int c0 = pn * 256 + bj * 128 + wc * 32 + 8 * fq;
                        *(u32x4*)(UH + ((size_t)(c0 >> 4) * NCHUNK_PAD + (row >> 4)) * 512 + (row & 15) * 16 + (c0 & 15)) = pack8(acc[ai][bj][m][0], acc[ai][bj][m][1]); } }
        } else if (pn < 5) {
            const bool isq = pn >= 3, isv = (pn == 2) && (wc >= 2), lat = u.pm < (T / BM);
            const float* gn = isq ? qg : kg;
            f32x4 gv[2][2];
#pragma unroll
            for (int bj = 0; bj < 2; ++bj)
#pragma unroll
                for (int n = 0; n < 2; ++n) gv[bj][n] = *(const f32x4*)(gn + 32 * bj + 8 * fq + 4 * n);
            const float osc = isq ? C2 : 1.f;
#pragma unroll
            for (int ai = 0; ai < 2; ++ai)
#pragma unroll
                for (int m = 0; m < 4; ++m) { const int row = EPI_ROWS(ai, m);
                    int b, spos; if (lat) { b = row >> 13; spos = LC + (row & (SEQ - 1)); } else { const int rr = row - T; b = rr >> 8; spos = rr & (LC - 1); }
                    if (isv) {
                        bf16_t* o = VB + ((size_t)(b * 2 + (wc - 2)) * SKV + spos) * 64 + 8 * fq;
#pragma unroll
                        for (int bj = 0; bj < 2; ++bj) *(u32x4*)(o + 32 * bj) = pack8(acc[ai][bj][m][0], acc[ai][bj][m][1]);
                    } else {
                        float ss = 0.f;
#pragma unroll
                        for (int bj = 0; bj < 2; ++bj)
#pragma unroll
                            for (int n = 0; n < 2; ++n) { const f32x4 x = acc[ai][bj][m][n]; ss += (x[0] * x[0] + x[1] * x[1]) + (x[2] * x[2] + x[3] * x[3]); }
                        ss += __shfl_xor(ss, 16); ss += __shfl_xor(ss, 32);
                        const float rs = osc / sqrtf(ss * (1.f / 64.f) + EPS);
                        bf16_t* o = isq ? QB + (size_t)row * 512 + (4 * (pn - 3) + wc) * 64 + 8 * fq : KB + ((size_t)(b * 2 + wc) * SKV + spos) * 64 + 8 * fq;
                        const int t = row & (SEQ - 1), rid = t >> 6, cid = t & 63;
#pragma unroll
                        for (int bj = 0; bj < 2; ++bj) {
                            f32x4 y0 = acc[ai][bj][m][0] * gv[bj][0] * rs, y1 = acc[ai][bj][m][1] * gv[bj][1] * rs;
                            if (lat) { const float* rp = rope + (bj == 0 ? rid * 16 : 4096 + cid * 16) + 4 * fq; const f32x4 cs = *(const f32x4*)rp, sn = *(const f32x4*)(rp + (bj == 0 ? 2048 : 1024));
                                const f32x4 z0 = (f32x4){y0[0] * cs[0] - y0[1] * sn[0], y0[0] * sn[0] + y0[1] * cs[0], y0[2] * cs[1] - y0[3] * sn[1], y0[2] * sn[1] + y0[3] * cs[1]};
                                const f32x4 z1 = (f32x4){y1[0] * cs[2] - y1[1] * sn[2], y1[0] * sn[2] + y1[1] * cs[2], y1[2] * cs[3] - y1[3] * sn[3], y1[2] * sn[3] + y1[3] * cs[3]};
                                y0 = z0; y1 = z1; }
                            *(u32x4*)(o + 32 * bj) = pack8(y0, y1); }
                    } }
        } else {
#pragma unroll
            for (int ai = 0; ai < 2; ++ai)
#pragma unroll
                for (int m = 0; m < 4; ++m) { const int row = EPI_ROWS(ai, m);
#pragma unroll
                    for (int bj = 0; bj < 2; ++bj)
                        *(u32x4*)(GT + (size_t)row * 2048 + (pn - 5) * 256 + bj * 128 + wc * 32 + 8 * fq) = pack8(fsig4(acc[ai][bj][m][0]), fsig4(acc[ai][bj][m][1])); }
        }
    }
};
struct EpiGlu {
    const bf16_t* SG; const float* bias; bf16_t* GO;
    __device__ __forceinline__ void operator()(const f32x4 (&acc)[2][2][4][2], const Unit& u, int wr, int wc, int fr, int fq) const {
#pragma unroll
        for (int bj = 0; bj < 2; ++bj) { const int c0 = u.pn * BM + bj * HALF + wc * 32 + 8 * fq;
            const f32x4 b0 = *(const f32x4*)(bias + c0), b1 = *(const f32x4*)(bias + c0 + 4);
#pragma unroll
            for (int ai = 0; ai < 2; ++ai)
#pragma unroll
                for (int m = 0; m < 4; ++m) { const int row = EPI_ROWS(ai, m);
                    const u32x4 sw = *(const u32x4*)(SG + ((size_t)(c0 >> 4) * T + row) * 16 + (c0 & 15));
                    const f32x4 s0 = unpack_lo(sw), s1 = unpack_hi(sw);
                    *(u32x4*)(GO + (size_t)row * 1024 + c0) = pack8(s0 * fsig4(acc[ai][bj][m][0] + b0), s1 * fsig4(acc[ai][bj][m][1] + b1)); } }
    }
};
template <int MODE> struct EpiMerge {
    const bf16_t* GT; float* M1; bf16_t* MG;
    __device__ __forceinline__ void operator()(const f32x4 (&acc)[2][2][4][2], const Unit& u, int wr, int wc, int fr, int fq) const {
#pragma unroll
        for (int ai = 0; ai < 2; ++ai)
#pragma unroll
            for (int m = 0; m < 4; ++m) { const int row = EPI_ROWS(ai, m);
#pragma unroll
                for (int bj = 0; bj < 2; ++bj) { const int c0 = u.pn * BM + bj * HALF + wc * 32 + 8 * fq;
                    const u32x4 gw = *(const u32x4*)(GT + (size_t)row * 2048 + MODE * 1024 + c0);
                    const f32x4 v0 = unpack_lo(gw) * acc[ai][bj][m][0], v1 = unpack_hi(gw) * acc[ai][bj][m][1];
                    float* mp = M1 + (size_t)row * 1024 + c0;
                    if (MODE == 0) { *(f32x4*)mp = v0; *(f32x4*)(mp + 4) = v1; }
                    else { const f32x4 a0 = *(const f32x4*)mp, a1 = *(const f32x4*)(mp + 4); *(u32x4*)(MG + (size_t)row * 1024 + c0) = pack8(a0 + v0, a1 + v1); } } }
    }
};
struct EpiOut {
    const float* x; const float* mod; float* XM;
    __device__ __forceinline__ void operator()(const f32x4 (&acc)[2][2][4][2], const Unit& u, int wr, int wc, int fr, int fq) const {
        const int b = (u.pm * BM) / SEQ;
#pragma unroll
        for (int bj = 0; bj < 2; ++bj) { const int c0 = u.pn * BM + bj * HALF + wc * 32 + 8 * fq;
            const f32x4 g0 = *(const f32x4*)(mod + b * NMOD + 2048 + c0), g1 = *(const f32x4*)(mod + b * NMOD + 2048 + c0 + 4);
#pragma unroll
            for (int ai = 0; ai < 2; ++ai)
#pragma unroll
                for (int m = 0; m < 4; ++m) { const size_t off = (size_t)EPI_ROWS(ai, m) * 1024 + c0;
                    const f32x4 x0 = *(const f32x4*)(x + off), x1 = *(const f32x4*)(x + off + 4);
                    *(f32x4*)(XM + off) = x0 + g0 * acc[ai][bj][m][0]; *(f32x4*)(XM + off + 4) = x1 + g1 * acc[ai][bj][m][1]; } }
    }
};
struct EpiGU {
    const float* bgu; bf16_t* ACT;
    __device__ __forceinline__ void operator()(const f32x4 (&acc)[2][2][4][2], const Unit& u, int wr, int wc, int fr, int fq) const {
        const int e = u.pn >> 3, jc = (u.pn & 7) * 128 + wc * 32 + 8 * fq; const float* bp = bgu + e * 2048 + jc;
        const f32x4 bg0 = *(const f32x4*)bp, bg1 = *(const f32x4*)(bp + 4), bu0 = *(const f32x4*)(bp + 1024), bu1 = *(const f32x4*)(bp + 1028);
#pragma unroll
        for (int ai = 0; ai < 2; ++ai)
#pragma unroll
            for (int m = 0; m < 4; ++m) { const int row = EPI_ROWS(ai, m); f32x4 o[2];
#pragma unroll
                for (int n = 0; n < 2; ++n) { const f32x4 gt = acc[ai][0][m][n] + (n ? bg1 : bg0), up = acc[ai][1][m][n] + (n ? bu1 : bu0);
#pragma unroll
                    for (int j = 0; j < 4; ++j) { const float gq = fminf(gt[j], 7.f), uq = fminf(fmaxf(up[j], -7.f), 7.f); o[n][j] = (uq + 1.f) * (gq * fsig(1.702f * gq)); } }
                *(u32x4*)(ACT + (size_t)row * 1024 + jc) = pack8(o[0], o[1]); }
    }
};
struct EpiDown {
    const float* bd; const float* sgate; bf16_t* YB;
    __device__ __forceinline__ void operator()(const f32x4 (&acc)[2][2][4][2], const Unit& u, int wr, int wc, int fr, int fq) const {
        const int e = u.pn >> 2;
#pragma unroll
        for (int ai = 0; ai < 2; ++ai)
#pragma unroll
            for (int m = 0; m < 4; ++m) { const int row = EPI_ROWS(ai, m); const float gt = sgate[row];
#pragma unroll
                for (int bj = 0; bj < 2; ++bj) { const int c0 = (u.pn & 3) * BM + bj * HALF + wc * 32 + 8 * fq; const float* bp = bd + e * 1024 + c0;
                    const f32x4 b0 = *(const f32x4*)bp, b1 = *(const f32x4*)(bp + 4);
                    *(u32x4*)(YB + (size_t)row * 1024 + c0) = pack8((acc[ai][bj][m][0] + b0) * gt, (acc[ai][bj][m][1] + b1) * gt); } }
    }
};
struct EpiSloc {
    bf16_t* SL;
    __device__ __forceinline__ void operator()(const f32x4 (&acc)[2][2][4][2], const Unit& u, int wr, int wc, int fr, int fq) const {
#pragma unroll
        for (int ai = 0; ai < 2; ++ai)
#pragma unroll
            for (int m = 0; m < 4; ++m) { const int row = EPI_ROWS(ai, m);
#pragma unroll
                for (int bj = 0; bj < 2; ++bj) *(u32x4*)(SL + (size_t)row * 256 + bj * HALF + wc * 32 + 8 * fq) = pack8(acc[ai][bj][m][0], acc[ai][bj][m][1]); }
    }
};
struct EpiS5Y {
    bf16_t* SG;
    __device__ __forceinline__ f32x4 gelu4(const f32x4 x) const { f32x4 r;
#pragma unroll
        for (int j = 0; j < 4; ++j) { const float v = x[j], u2 = 1.5957691216057308f * (v + 0.044715f * v * v * v); r[j] = v * fsig(u2); } return r; }
    __device__ __forceinline__ void operator()(const f32x4 (&acc)[2][2][4][2], const Unit& u, int wr, int wc, int fr, int fq) const {
        const int grp = u.pn, mt = u.pm - 9 * grp;
#pragma unroll
        for (int ai = 0; ai < 2; ++ai)
#pragma unroll
            for (int m = 0; m < 4; ++m) { const int chunk = mt * BM + ai * HALF + wr * 64 + m * 16 + fr;
#pragma unroll
                for (int bj = 0; bj < 2; ++bj) { const int col = bj * HALF + wc * 32 + 8 * fq; const int tok = chunk * 16 + (col >> 4);
                    *(u32x4*)(SG + ((size_t)grp * T + tok) * 16 + (col & 15)) = pack8(gelu4(acc[ai][bj][m][0]), gelu4(acc[ai][bj][m][1])); } }
    }
};
#undef EPI_ROWS
struct SchedProj {
    StaticOrder so; int G, c;
    __device__ void init(int G_, int c_) { so.init(T, DIN, G_, c_); G = G_; c = c_; }
    __device__ bool next(int i, Unit& u) const { const int L = i * G + c; if (L < so.nwg) return so.next(i, u); const int r = L - so.nwg; if (r >= 12) return false; u.pm = T / BM + r / 3; u.pn = r % 3; return true; }
};
struct SchedS5 {
    int mper, G, c;
    __device__ bool next(int i, Unit& u) const { const int L = i * G + c; if (L >= 32 * mper) return false; const int grp = L / mper; u.pm = 9 * grp + (L % mper); u.pn = grp; return true; }
};
struct SchedOne { Unit u0; __device__ bool next(int i, Unit& u) const { if (i) return false; u = u0; return true; } };
struct SchedMoE {
    const PG8_LAS int* tile_e; int ntiles, nN, G, c;
    __device__ bool next(int i, Unit& u) const { const int L = i * G + c; if (L >= ntiles * nN) return false; u.pm = L / nN; u.pn = tile_e[u.pm] * nN + (L % nN); return true; }
};
}

#include <hip/hip_bf16.h>
#include <cmath>

namespace attn_body {
using bf16=__hip_bfloat16;
using bf16x8=__attribute__((ext_vector_type(8)))short;
using s16x4=__attribute__((ext_vector_type(4)))short;
using f32x16=__attribute__((ext_vector_type(16)))float;
using u32x4=__attribute__((ext_vector_type(4)))unsigned;
constexpr int D=64,QP=512,KP=64,OP=1024,ASEQ=8192,ASKV=8448;
constexpr int NW=8,QBLK=32,QB=QBLK*NW,KVBLK=64,NQB=ASEQ/QB;
constexpr int ATTN_UNIT_ROWS=QB;
__device__ __forceinline__ int crow(int r,int hi){return (r&3)+8*(r>>2)+4*hi;}
#define SBAR() __builtin_amdgcn_sched_barrier(0)
__device__ __forceinline__ void cmask(f32x16&p0,f32x16&p1,int jb,int qrel,int hi){
  const float NEG=-INFINITY; int kb=64*jb+4*hi;
  #pragma unroll
  for(int r=0;r<16;++r){int kv=kb+(r&3)+8*(r>>2); if(kv>qrel)p0[r]=NEG; if(kv+32>qrel)p1[r]=NEG;}
}

constexpr int NSLOT=3, SLOTB=8192;
constexpr int LDS_K=0, LDS_V=NSLOT*SLOTB, LDS_WS=2*NSLOT*SLOTB, LDS_OST=LDS_WS+NW*64*4, LDS_BYTES=LDS_OST+NW*4096;
constexpr float C2=0.125f*1.4426950408889634f;
__device__ __forceinline__ void glds16(const void*gsrc,unsigned lds_dst){unsigned keep;
  asm volatile("s_mov_b32 %0, m0\n\ts_mov_b32 m0, %2\n\ts_nop 0\n\tglobal_load_lds_dwordx4 %1, off\n\ts_mov_b32 m0, %0":"=&s"(keep):"v"(gsrc),"s"(lds_dst):"memory");}
__device__ __forceinline__ float max3f(float a,float b,float c){float r;asm("v_max3_f32 %0, %1, %2, %3":"=v"(r):"v"(a),"v"(b),"v"(c));return r;}
__device__ __forceinline__ float max2f(float a,float b){float r;asm("v_max_f32_e32 %0, %1, %2":"=v"(r):"v"(a),"v"(b));return r;}
__device__ __forceinline__ float fadd_s(float a,float b){float r;asm("v_add_f32_e32 %0, %1, %2":"=v"(r):"v"(a),"v"(b));return r;}
__device__ __forceinline__ float fsub_s(float a,float b){float r;asm("v_sub_f32_e32 %0, %1, %2":"=v"(r):"v"(a),"v"(b));return r;}
typedef float f32x2_t __attribute__((ext_vector_type(2))); typedef __bf16 bf16x2_t __attribute__((ext_vector_type(2)));
__device__ __forceinline__ unsigned cvtpk_s(float lo,float hi){f32x2_t v={lo,hi};bf16x2_t b=__builtin_convertvector(v,bf16x2_t);return __builtin_bit_cast(unsigned,b);}
#define WAIT_BAR(N) asm volatile("s_waitcnt vmcnt(" #N ") lgkmcnt(0)\n\ts_barrier":::"memory")

__device__ __forceinline__ void qkt(f32x16&p0,f32x16&p1,const char*Kslot,const bf16x8*qr,const f32x16&negm,int r32,int hi){
  const char*kb=Kslot+hi*1024+r32*16;
  #pragma unroll
  for(int d0=0;d0<4;++d0){
    const bf16x8 b0=*reinterpret_cast<const bf16x8*>(kb+d0*2048);
    const bf16x8 b1=*reinterpret_cast<const bf16x8*>(kb+d0*2048+512);
    if(d0==0){p0=__builtin_amdgcn_mfma_f32_32x32x16_bf16(b0,qr[0],negm,0,0,0);p1=__builtin_amdgcn_mfma_f32_32x32x16_bf16(b1,qr[0],negm,0,0,0);}
    else{p0=__builtin_amdgcn_mfma_f32_32x32x16_bf16(b0,qr[d0],p0,0,0,0);p1=__builtin_amdgcn_mfma_f32_32x32x16_bf16(b1,qr[d0],p1,0,0,0);}}
}
typedef __attribute__((address_space(3))) const char* lds_cptr;
typedef short v4i16_t __attribute__((ext_vector_type(4)));
__device__ __forceinline__ void kload8(bf16x8*kf,lds_cptr kp){
  kf[0]=*(const __attribute__((address_space(3))) bf16x8*)(kp);      kf[1]=*(const __attribute__((address_space(3))) bf16x8*)(kp+512);
  kf[2]=*(const __attribute__((address_space(3))) bf16x8*)(kp+2048); kf[3]=*(const __attribute__((address_space(3))) bf16x8*)(kp+2560);
  kf[4]=*(const __attribute__((address_space(3))) bf16x8*)(kp+4096); kf[5]=*(const __attribute__((address_space(3))) bf16x8*)(kp+4608);
  kf[6]=*(const __attribute__((address_space(3))) bf16x8*)(kp+6144); kf[7]=*(const __attribute__((address_space(3))) bf16x8*)(kp+6656);
}
__device__ __forceinline__ void kload2(bf16x8*kf,lds_cptr kp,int j){ kf[2*j]=*(const __attribute__((address_space(3))) bf16x8*)(kp+j*2048); kf[2*j+1]=*(const __attribute__((address_space(3))) bf16x8*)(kp+j*2048+512); }
__device__ __forceinline__ s16x4 vtr(lds_cptr p){ return __builtin_bit_cast(s16x4,__builtin_amdgcn_ds_read_tr16_b64_v4i16((__attribute__((address_space(3))) v4i16_t*)p)); }
__device__ __forceinline__ float rowmax(const f32x16&p0,const f32x16&p1){
  float a=max3f(p0[0],p0[1],p1[0]),b=max3f(p0[2],p0[3],p1[1]);a=max3f(a,p1[2],p1[3]);
  #pragma unroll
  for(int r=4;r<16;r+=4){a=max3f(a,p0[r],p0[r+1]);b=max3f(b,p0[r+2],p0[r+3]);a=max3f(a,p1[r],p1[r+1]);b=max3f(b,p1[r+2],p1[r+3]);}
  const float m=max2f(a,b);
  auto rr=__builtin_amdgcn_permlane32_swap(__float_as_uint(m),__float_as_uint(m),false,false);
  return max2f(__uint_as_float(rr[0]),__uint_as_float(rr[1]));
}
__device__ __forceinline__ void pv(f32x16*o,int vb,bf16x8 pa0,bf16x8 pa1,bf16x8 pa2,bf16x8 pa3){
  #pragma unroll
  for(int d0=0;d0<2;++d0){s16x4 lo[4],hi[4];
    #pragma unroll
    for(int ks=0;ks<4;++ks){
      asm volatile("ds_read_b64_tr_b16 %0,%1 offset:%c2":"=&v"(lo[ks]):"v"(vb),"i"(d0*4096+ks*1024):"memory");
      asm volatile("ds_read_b64_tr_b16 %0,%1 offset:%c2":"=&v"(hi[ks]):"v"(vb),"i"(d0*4096+ks*1024+512):"memory");}
    asm volatile("s_waitcnt lgkmcnt(0)":::"memory");SBAR();
    #define PK(k) (bf16x8){lo[k][0],lo[k][1],lo[k][2],lo[k][3],hi[k][0],hi[k][1],hi[k][2],hi[k][3]}
    o[d0]=__builtin_amdgcn_mfma_f32_32x32x16_bf16(pa0,PK(0),o[d0],0,0,0);
    o[d0]=__builtin_amdgcn_mfma_f32_32x32x16_bf16(pa1,PK(1),o[d0],0,0,0);
    o[d0]=__builtin_amdgcn_mfma_f32_32x32x16_bf16(pa2,PK(2),o[d0],0,0,0);
    o[d0]=__builtin_amdgcn_mfma_f32_32x32x16_bf16(pa3,PK(3),o[d0],0,0,0);
    #undef PK
  }
}

#ifndef ATTN_STORE16
#define ATTN_STORE16(p,v) (*(u32x4*)(p)=(v))
#endif
template<int THRL> __device__ __forceinline__ void attn_unit(int b,int h,int qb,const bf16*Q,const bf16*__restrict__ K,const bf16*__restrict__ V,bf16*O,char*shm){
  const int tid=threadIdx.x,lane=tid&63,r32=lane&31,hi=lane>>5; const int wid=__builtin_amdgcn_readfirstlane(tid>>6);
  const long rowbase=(long)b*ASEQ; const int q0=qb*QB;
  const bf16*Qw=Q+(rowbase+q0+wid*QBLK)*QP+h*D;
  const bf16*Kh=K+(long)(b*2+(h>>2))*ASKV*KP,*Vh=V+(long)(b*2+(h>>2))*ASKV*KP;
  const unsigned lds0=(unsigned)(uintptr_t)shm;
  float*wsf=(float*)(shm+LDS_WS)+wid*64;
  const bf16*ksrc=Kh+(long)lane*KP+wid*8;
  const bf16*vsrc=Vh+(long)(16*(wid&3)+(lane>>2))*KP+(wid>>2)*32+(lane&3)*8;
  const unsigned kdst=lds0+LDS_K+wid*1024, vdst=lds0+LDS_V+wid*1024;
  #define DMA_K(t,slot) glds16(ksrc+(long)(t)*KVBLK*KP,(unsigned)__builtin_amdgcn_readfirstlane(kdst+(slot)))
  #define DMA_V(t,slot) glds16(vsrc+(long)(t)*KVBLK*KP,(unsigned)__builtin_amdgcn_readfirstlane(vdst+(slot)))
  const int vb0=(int)(lds0+LDS_V)+((lane>>4)&1)*32+(lane&3)*8+(4*hi+((lane&15)>>2))*64;
  const char*Kbase=shm+LDS_K; bf16x8 kf[8];
  const lds_cptr shm3=(lds_cptr)shm; const lds_cptr kp0=shm3+LDS_K+hi*1024+r32*16; const lds_cptr vp0=shm3+LDS_V+((lane>>4)&1)*32+(lane&3)*8+(4*hi+((lane&15)>>2))*64;
  const int NT=ASKV/KVBLK;
  DMA_K(0,0);DMA_V(0,0);DMA_K(1,SLOTB);
  bf16x8 qr[4];
  #pragma unroll
  for(int d0=0;d0<4;++d0)qr[d0]=*reinterpret_cast<const bf16x8*>(&Qw[(long)r32*QP+d0*16+hi*8]);
  float mhat=0.f,l_reg=0.f;f32x16 o[2];o[0]=f32x16{};o[1]=f32x16{};f32x16 negm=f32x16{};asm volatile("":"+v"(negm));
  const int qrel=wid*QBLK+r32;
  #define CMASK(P0,P1,t) do{}while(0)
  bool resc=false;
  #define START(P0,P1) do{ const float rm=rowmax(P0,P1); resc=false; \
    { const float dl=rm; mhat=fadd_s(mhat,dl); \
      _Pragma("unroll") for(int r=0;r<16;++r){P0[r]=fsub_s(P0[r],dl);P1[r]=fsub_s(P1[r],dl);} \
      _Pragma("unroll") for(int r=0;r<16;++r)negm[r]=-mhat; asm volatile("":"+v"(negm)); } \
    _Pragma("unroll") for(int r=0;r<16;++r)P0[r]=__builtin_amdgcn_exp2f(P0[r]); }while(0)
  #define RESC() do{ if(resc){ asm volatile("s_waitcnt lgkmcnt(0)":::"memory"); \
      _Pragma("unroll") for(int d_=0;d_<2;++d_) _Pragma("unroll") for(int r=0;r<16;++r)o[d_][r]*=wsf[crow(r,hi)]; } }while(0)
  f32x16 pA0,pA1,pB0,pB1;
  int sl_prev=0,sl_cur=0,sl_next=SLOTB;
  #define ROT() do{sl_prev=sl_cur;sl_cur=sl_next;sl_next=(sl_next==(NSLOT-1)*SLOTB)?0:sl_next+SLOTB;}while(0)
  DMA_K(2,2*SLOTB);
  WAIT_BAR(3);
  qkt(pA0,pA1,Kbase,qr,negm,r32,hi);asm volatile("s_nop 15\n\ts_nop 7":"+v"(pA0),"+v"(pA1));CMASK(pA0,pA1,0);
  START(pA0,pA1);
  _Pragma("unroll") for(int r=0;r<16;++r)pA1[r]=__builtin_amdgcn_exp2f(pA1[r]);
  WAIT_BAR(0);
  DMA_K(3,0);DMA_V(1,SLOTB);
  ROT();
  kload8(kf,kp0+sl_cur);
  WAIT_BAR(2);
  s16x4 vlo[8],vhi[8]; u32x4 pw0,pw1,pw2,pw3;
  #define PKW(P,B) cvtpk_s(P[B],P[B+1])
  #define PAF(k) __builtin_bit_cast(bf16x8,pw##k)
  #define VFR(i) (bf16x8){vlo[i][0],vlo[i][1],vlo[i][2],vlo[i][3],vhi[i][0],vhi[i][1],vhi[i][2],vhi[i][3]}
  #define PIN(x) asm volatile("":"+v"(x))
  #define MX3(a,b,c) __builtin_fmaxf(__builtin_fmaxf((a),(b)),(c))
  #define GAPA(MF,A0,A1,A2,A3,W0,W1,PW) do{ MF; sacc+=A0; sacc+=A1; sacc+=A2; sacc+=A3; PIN(sacc); W0; W1; PIN(PW); SBAR(); }while(0)
  #define EX(v) __builtin_amdgcn_exp2f(v)
  #define GAPB(MF,X,B) do{ MF; X[B]=EX(X[B]); X[B+1]=EX(X[B+1]); X[B+2]=EX(X[B+2]); X[B+3]=EX(X[B+3]); PIN(X); SBAR(); }while(0)
  #define VRD(i) do{ vlo[i]=vtr(vp_+(((i)>>2)*4096+((i)&3)*1024)); vhi[i]=vtr(vp_+(((i)>>2)*4096+((i)&3)*1024+512)); }while(0)
  #define KRD(G,j) do{ if(G){ kload2(kf,kp0+sl_next,j); SBAR(); } }while(0)
  #define STEP(C0,C1,P0,P1,t,GK,GV,GL) do{ SBAR(); \
    const lds_cptr vp_=vp0+sl_prev; \
    VRD(0); SBAR(); float sacc=(P0[0]+P0[1]); \
    GAPA(C0=__builtin_amdgcn_mfma_f32_32x32x16_bf16(kf[0],qr[0],negm,0,0,0), P0[2],P0[3],P0[4],P0[5],     pw0[0]=PKW(P0,0), pw0[1]=PKW(P0,2), pw0); \
    VRD(4); SBAR(); GAPA(C1=__builtin_amdgcn_mfma_f32_32x32x16_bf16(kf[1],qr[0],negm,0,0,0), P0[6],P0[7],P0[8],P0[9],     pw0[2]=PKW(P0,4), pw0[3]=PKW(P0,6), pw0); \
    VRD(1); SBAR(); GAPA(C0=__builtin_amdgcn_mfma_f32_32x32x16_bf16(kf[2],qr[1],C0,0,0,0),   P0[10],P0[11],P0[12],P0[13], pw1[0]=PKW(P0,8), pw1[1]=PKW(P0,10), pw1); \
    VRD(5); SBAR(); GAPA(C1=__builtin_amdgcn_mfma_f32_32x32x16_bf16(kf[3],qr[1],C1,0,0,0),   P0[14],P0[15],P1[0],P1[1],   pw1[2]=PKW(P0,12),pw1[3]=PKW(P0,14), pw1); \
    VRD(2); SBAR(); GAPA(C0=__builtin_amdgcn_mfma_f32_32x32x16_bf16(kf[4],qr[2],C0,0,0,0),   P1[2],P1[3],P1[4],P1[5],     pw2[0]=PKW(P1,0), pw2[1]=PKW(P1,2), pw2); \
    VRD(6); SBAR(); GAPA(C1=__builtin_amdgcn_mfma_f32_32x32x16_bf16(kf[5],qr[2],C1,0,0,0),   P1[6],P1[7],P1[8],P1[9],     pw2[2]=PKW(P1,4), pw2[3]=PKW(P1,6), pw2); \
    VRD(3); SBAR(); GAPA(C0=__builtin_amdgcn_mfma_f32_32x32x16_bf16(kf[6],qr[3],C0,0,0,0),   P1[10],P1[11],P1[12],P1[13], pw3[0]=PKW(P1,8), pw3[1]=PKW(P1,10), pw3); \
    VRD(7); SBAR(); GAPA(C1=__builtin_amdgcn_mfma_f32_32x32x16_bf16(kf[7],qr[3],C1,0,0,0),   P1[14],P1[15],0.f,0.f,       pw3[2]=PKW(P1,12),pw3[3]=PKW(P1,14), pw3); \
    l_reg+=sacc; \
    if(GK){DMA_K((t)+3,sl_cur);} if(GV){DMA_V((t)+1,sl_next);} \
    CMASK(C0,C1,t); \
    { float a=MX3(C0[0],C0[1],C1[0]),b=MX3(C0[2],C0[3],C1[1]); a=MX3(a,C1[2],C1[3]); \
      _Pragma("unroll") for(int r=4;r<16;r+=4){a=MX3(a,C0[r],C0[r+1]);b=MX3(b,C0[r+2],C0[r+3]);a=MX3(a,C1[r],C1[r+1]);b=MX3(b,C1[r+2],C1[r+3]);} \
      float rm=__builtin_fmaxf(a,b); { auto rr=__builtin_amdgcn_permlane32_swap(__float_as_uint(rm),__float_as_uint(rm),false,false); rm=__builtin_fmaxf(__uint_as_float(rr[0]),__uint_as_float(rr[1])); } \
      resc=false; \
      if(__builtin_expect(__any(rm>(float)THRL),0)){ const float dl=__builtin_fmaxf(rm,0.f); mhat+=dl; \
        _Pragma("unroll") for(int r=0;r<16;++r){C0[r]-=dl;C1[r]-=dl;} \
        _Pragma("unroll") for(int r=0;r<16;++r)negm[r]=-mhat; asm volatile("":"+v"(negm)); \
        const float f=__builtin_amdgcn_exp2f(-dl); l_reg*=f; if(hi==0)wsf[r32]=f; resc=true; } } \
    SBAR(); \
    GAPB(o[0]=__builtin_amdgcn_mfma_f32_32x32x16_bf16(PAF(0),VFR(0),o[0],0,0,0), C0,0); \
    GAPB(o[1]=__builtin_amdgcn_mfma_f32_32x32x16_bf16(PAF(0),VFR(4),o[1],0,0,0), C0,4); \
    KRD(GL,0); GAPB(o[0]=__builtin_amdgcn_mfma_f32_32x32x16_bf16(PAF(1),VFR(1),o[0],0,0,0), C0,8); \
    KRD(GL,1); GAPB(o[1]=__builtin_amdgcn_mfma_f32_32x32x16_bf16(PAF(1),VFR(5),o[1],0,0,0), C0,12); \
    KRD(GL,2); GAPB(o[0]=__builtin_amdgcn_mfma_f32_32x32x16_bf16(PAF(2),VFR(2),o[0],0,0,0), C1,0); \
    KRD(GL,3); GAPB(o[1]=__builtin_amdgcn_mfma_f32_32x32x16_bf16(PAF(2),VFR(6),o[1],0,0,0), C1,4); \
    GAPB(o[0]=__builtin_amdgcn_mfma_f32_32x32x16_bf16(PAF(3),VFR(3),o[0],0,0,0), C1,8); \
    GAPB(o[1]=__builtin_amdgcn_mfma_f32_32x32x16_bf16(PAF(3),VFR(7),o[1],0,0,0), C1,12); \
    }while(0)
  int t=1;
  #undef CMASK
  #define CMASK(P0,P1,t) do{}while(0)
  for(;t+5<NT;t+=2){
    STEP(pB0,pB1,pA0,pA1,t,true,true,true);     WAIT_BAR(2); RESC(); ROT();
    STEP(pA0,pA1,pB0,pB1,t+1,true,true,true);   WAIT_BAR(2); RESC(); ROT();
  }
  #undef CMASK
  #define CMASK(P0,P1,t) do{}while(0)
  #define ENDW(tt) do{ if((tt)+3<NT){WAIT_BAR(2);} else if((tt)+2<NT){WAIT_BAR(1);} else {WAIT_BAR(0);} }while(0)
  for(;t+1<NT;t+=2){
    STEP(pB0,pB1,pA0,pA1,t,(t+3<NT),(t+1<NT),(t+1<NT));       ENDW(t);   RESC(); ROT();
    STEP(pA0,pA1,pB0,pB1,t+1,(t+4<NT),(t+2<NT),(t+2<NT));     ENDW(t+1); RESC(); ROT();
  }
  STEP(pB0,pB1,pA0,pA1,NT-1,false,false,false); RESC();
  { float sacc=pB0[0]+pB0[1]; _Pragma("unroll") for(int r=2;r<16;++r)sacc+=pB0[r]; _Pragma("unroll") for(int r=0;r<16;++r)sacc+=pB1[r]; l_reg+=sacc;
    pw0=(u32x4){PKW(pB0,0),PKW(pB0,2),PKW(pB0,4),PKW(pB0,6)};pw1=(u32x4){PKW(pB0,8),PKW(pB0,10),PKW(pB0,12),PKW(pB0,14)};pw2=(u32x4){PKW(pB1,0),PKW(pB1,2),PKW(pB1,4),PKW(pB1,6)};pw3=(u32x4){PKW(pB1,8),PKW(pB1,10),PKW(pB1,12),PKW(pB1,14)};
    SBAR(); pv(o,vb0+sl_cur,PAF(0),PAF(1),PAF(2),PAF(3)); }
  #undef PKW
  #undef PAF
  #undef VFR
  #undef PIN
  #undef MX3
  #undef GAPA
  #undef GAPB
  #undef EX
  #undef VRD
  #undef KRD
  #undef STEP
  #undef ENDW
  {auto rr=__builtin_amdgcn_permlane32_swap(__float_as_uint(l_reg),__float_as_uint(l_reg),false,false);l_reg=__uint_as_float(rr[0])+__uint_as_float(rr[1]);}
  if(hi==0)wsf[32+r32]=l_reg;asm volatile("s_waitcnt lgkmcnt(0)":::"memory");
  float rli[16];
  #pragma unroll
  for(int r=0;r<16;++r)rli[r]=__builtin_amdgcn_rcpf(wsf[32+crow(r,hi)]);
  bf16*Ow=O+(rowbase+q0+wid*QBLK)*OP+h*D;
  { bf16*stg=(bf16*)(shm+LDS_OST)+wid*2048;
    #pragma unroll
    for(int r=0;r<16;++r){const int orow=crow(r,hi);
      #pragma unroll
      for(int d0=0;d0<2;++d0)stg[orow*64+d0*32+r32]=__float2bfloat16(o[d0][r]*rli[r]);}
    asm volatile("s_waitcnt lgkmcnt(0)":::"memory");
    #pragma unroll
    for(int i=0;i<4;++i){const int row=i*8+(lane>>3),ch=lane&7; const u32x4 v=*(const u32x4*)(stg+row*64+ch*8); ATTN_STORE16(Ow+(long)row*OP+ch*8,v);} }
  asm volatile("s_waitcnt lgkmcnt(0)\n\ts_barrier":::"memory");
  #undef DMA_K
  #undef DMA_V
  #undef CMASK
  #undef START
  #undef RESC
  #undef ROT
}
constexpr int ATTN_LDS_BYTES=LDS_BYTES;
struct AttnTensors { const bf16* Q; const bf16* K; const bf16* V; bf16* O; };
struct AttnUnit { int bh; int qb; };
struct StaticOrder {
  int vcu;
  __device__ __forceinline__ explicit StaticOrder(int grid,int block):vcu((block%8)*(grid/8)+block/8){}
  __device__ __forceinline__ bool next(int i,AttnUnit&u)const{ if(i>=4)return false; const int s=vcu&7; u.bh=vcu>>3; u.qb=(i==0)?s:(i==1)?15-s:(i==2)?16+s:31-s; return true; }
  __device__ __forceinline__ void a_ready(const AttnUnit&)const{}
  __device__ __forceinline__ void done(const AttnUnit&)const{}
};
template<class Sched,int THRL=8> __device__ __forceinline__ void attn_phase(char*lds,const AttnTensors&T,const Sched&S){
  AttnUnit u;
  for(int i=0;S.next(i,u);++i){ S.a_ready(u); attn_unit<THRL>(u.bh>>3,u.bh&7,u.qb,T.Q,T.K,T.V,T.O,lds); S.done(u); }
}
#undef SBAR
#undef WAIT_BAR
}

#define LAS __attribute__((address_space(3)))

#define XB_TMO      128
#define XB_XCNT(j)  (256  + 64 * (j))
#define XB_XSUB(j)  (1280 + 64 * (j))
#define XB_XGEN(j)  (2304 + 64 * (j))
#define XB_TOP      3328
#define XB_TOPGEN   3392
#define XCD_BAR_WORDS 3456
#define XB_SPIN_CAP (1u << 18)

__device__ __forceinline__ unsigned xb_ld(unsigned* p)              { return __hip_atomic_load(p, __ATOMIC_RELAXED, __HIP_MEMORY_SCOPE_AGENT); }
__device__ __forceinline__ unsigned xb_add(unsigned* p, unsigned v) { return __hip_atomic_fetch_add(p, v, __ATOMIC_RELAXED, __HIP_MEMORY_SCOPE_AGENT); }
__device__ __forceinline__ unsigned xb_xcc_id() { return (unsigned)__builtin_amdgcn_s_getreg((3 << 11) | 20) & 0xFu; }
#define XB_SPIN(cond, bar) do { unsigned _sp = 0; while (cond) { __builtin_amdgcn_s_sleep(1); \
    if ((++_sp & 255u) == 0u) { if (xb_ld(&(bar)[XB_TMO])) break; if (_sp > XB_SPIN_CAP) { atomicAdd(&(bar)[XB_TMO], 1u); break; } } } } while (0)

struct XcdBarrier {
    unsigned* bar; unsigned x;
    volatile LAS unsigned* st;
};

__device__ __forceinline__ XcdBarrier xcd_barrier_post(unsigned* bar, volatile LAS unsigned* st) {
    XcdBarrier b; b.bar = bar; b.x = xb_xcc_id(); b.st = st;
    if (threadIdx.x == 0) (void)xb_add(&bar[XB_XCNT(b.x)], 1u);
    return b;
}
__device__ __forceinline__ void xcd_barrier_complete(unsigned* bar, unsigned x, unsigned& nloc, unsigned& nx) {
    const unsigned G = gridDim.x * gridDim.y * gridDim.z;
    unsigned sum, cnt, mine, sp = 0u;
    for (;;) {
        sum = 0u; cnt = 0u; mine = 0u;
#pragma unroll
        for (unsigned j = 0; j < 16; ++j) { const unsigned c = xb_ld(&bar[XB_XCNT(j)]); sum += c; cnt += (c > 0u) ? 1u : 0u; mine = (j == x) ? c : mine; }
        if (sum == G) break;
        __builtin_amdgcn_s_sleep(1);
        if ((++sp & 255u) == 0u) { if (xb_ld(&bar[XB_TMO])) break; if (sp > XB_SPIN_CAP) { atomicAdd(&bar[XB_TMO], 1u); break; } }
    }
    nloc = mine > 0u ? mine : 1u; nx = cnt > 0u ? cnt : 1u;
}

__device__ __forceinline__ void xcd_barrier(const XcdBarrier& b) {
    asm volatile("s_waitcnt vmcnt(0)" ::: "memory");
    __syncthreads();
    if (threadIdx.x == 0) {
        unsigned* bar = b.bar;
        __builtin_amdgcn_s_waitcnt(0);
        unsigned nloc = b.st[0], nx = b.st[1];
        if (nloc == 0u) { xcd_barrier_complete(bar, b.x, nloc, nx); b.st[0] = nloc; b.st[1] = nx; }
        const unsigned old = xb_add(&bar[XB_XSUB(b.x)], 1u);
        const unsigned gen = old / nloc;
        if (old + 1u == (gen + 1u) * nloc) {
            __builtin_amdgcn_fence(__ATOMIC_RELEASE, "agent");
            asm volatile("s_waitcnt vmcnt(0)" ::: "memory");
            const unsigned og = xb_add(&bar[XB_TOP], 1u);
            const unsigned tg = og / nx;
            if (og + 1u == (tg + 1u) * nx) xb_add(&bar[XB_TOPGEN], 1u);
            else XB_SPIN(xb_ld(&bar[XB_TOPGEN]) == tg, bar);
            __builtin_amdgcn_fence(__ATOMIC_ACQUIRE, "agent");
            xb_add(&bar[XB_XGEN(b.x)], 1u);
            asm volatile("s_waitcnt vmcnt(0)" ::: "memory");
        } else {
            XB_SPIN(xb_ld(&bar[XB_XGEN(b.x)]) == gen, bar);
            __builtin_amdgcn_fence(__ATOMIC_ACQUIRE, "agent");
            asm volatile("s_waitcnt vmcnt(0)" ::: "memory");
        }
    }
    __syncthreads();
}

#undef LAS

constexpr int NWAVES = 8;
constexpr int RING_OFF = 0, RING_BYTES = 131072;
constexpr int LDSCTL_OFF = RING_BYTES;
constexpr int LDS_TILE_OFF = LDSCTL_OFF + 4096;
constexpr int LDS_BYTES = 147456;
#define LAS __attribute__((address_space(3)))
#define GAS __attribute__((address_space(1)))
typedef unsigned v4u __attribute__((ext_vector_type(4)));

__device__ __forceinline__ int proj_perm(int n) {
    if (n < COL_K || n >= COL_GATE) return n;
    if (n < COL_Q) { const int r = n - COL_K, hs = r >> 6, d = r & 63; return COL_K + 128 * (d >> 5) + 32 * hs + (d & 31); }
    const int r = n - COL_Q, h = r >> 6, d = r & 63; return COL_Q + 256 * (h >> 2) + 128 * (d >> 5) + 32 * (h & 3) + (d & 31);
}
__device__ __forceinline__ int gu_perm(int c) { const int jc = c & 1023, up = c >> 10; return 256 * (jc >> 7) + 128 * up + (jc & 127); }
template <int PERM  >
__device__ __forceinline__ void transpose_item(const float* W, int N, bf16* WT, int ldk, int koff, LAS float* scr, int item, int lane) {
    const int nblk = N / 32, kb = item / nblk, nb = item % nblk, k0 = 64 * kb, n0 = 32 * nb;
#pragma unroll 8
    for (int i = 0; i < 32; ++i) { const int kk = 2 * i + (lane >> 5); scr[kk * 33 + (lane & 31)] = W[(size_t)(k0 + kk) * N + n0 + (lane & 31)]; }
    asm volatile("s_waitcnt lgkmcnt(0)" ::: "memory");
    const int c = lane & 7;
#pragma unroll
    for (int j = 0; j < 4; ++j) { const int n = (lane >> 3) + 8 * j; const LAS float* s = scr + (8 * c) * 33 + n;
        v4u o; o.x = pk2(s[0 * 33], s[1 * 33]); o.y = pk2(s[2 * 33], s[3 * 33]); o.z = pk2(s[4 * 33], s[5 * 33]); o.w = pk2(s[6 * 33], s[7 * 33]);
        const int dr = PERM == 1 ? proj_perm(n0 + n) : PERM == 2 ? gu_perm(n0 + n) : n0 + n;
        *(v4u*)(WT + (size_t)dr * ldk + koff + k0 + 8 * c) = o; }
    asm volatile("s_waitcnt lgkmcnt(0)" ::: "memory");
}
__device__ __forceinline__ void ph_wconv(const P& p, int vcu, int nb, LAS unsigned char* lds) {
    const int lane = threadIdx.x & 63, wave = threadIdx.x >> 6;
    LAS float* scr = (LAS float*)(lds + RING_OFF + wave * 16384);
    const int gw = vcu * NWAVES + wave, ngw = nb * NWAVES;
    constexpr int I_IN = 16 * 104, I_GLU = 8 * 16, I_SSM = 8 * 32, I_OUT = 16 * 32, I_GU1 = 16 * 64, I_D1 = 16 * 32;
    constexpr int NITEMS = I_IN + I_GLU + 2 * I_SSM + I_OUT + 32 * I_GU1 + 32 * I_D1;
    for (int it = gw; it < NITEMS; it += ngw) {
        int r = it;
        if (r < 32 * I_GU1) { const int e = r / I_GU1; transpose_item<2>(p.in[26] + (size_t)e * 1024 * 2048, 2048, (bf16*)(p.ws + WS_WGU) + (size_t)e * 2048 * 1024, 1024, 0, scr, r % I_GU1, lane); continue; } r -= 32 * I_GU1;
        if (r < 32 * I_D1) { const int e = r / I_D1; transpose_item<0>(p.in[28] + (size_t)e * 1024 * 1024, 1024, (bf16*)(p.ws + WS_WD) + (size_t)e * 1024 * 1024, 1024, 0, scr, r % I_D1, lane); continue; } r -= 32 * I_D1;
        if (r < I_IN) { transpose_item<1>(p.in[8], DIN, (bf16*)(p.ws + WS_WIN), 1024, 0, scr, r, lane); continue; } r -= I_IN;
        if (r < I_GLU) { transpose_item<0>(p.in[17], 512, (bf16*)(p.ws + WS_WGLU), 512, 0, scr, r, lane); continue; } r -= I_GLU;
        if (r < I_SSM) { transpose_item<0>(p.in[19], 1024, (bf16*)(p.ws + WS_W12), 1024, 0, scr, r, lane); continue; } r -= I_SSM;
        if (r < I_SSM) { transpose_item<0>(p.in[22], 1024, (bf16*)(p.ws + WS_W12), 1024, 512, scr, r, lane); continue; } r -= I_SSM;
        transpose_item<0>(p.in[23], 1024, (bf16*)(p.ws + WS_WOUT), 1024, 0, scr, r, lane);
    }
}

__device__ __forceinline__ void ph_s5tab(const P& p, int g, float* L) {
    float* pw = L; float* Bb = L + 4352; float* Cc = Bb + 4096; float* Kt = Cc + 4096;
    const int tid = threadIdx.x;
    if (tid < 128) { const int dir = tid >> 6, n = tid & 63, dg = dir * 32 + g;
        const float lr = p.in[9][dg * 64 + n], li = p.in[10][dg * 64 + n], step = expf(p.in[11][dg]); const float zr = lr * step, zi = li * step;
        for (int tau = 0; tau <= 16; ++tau) { const float e = expf(zr * (float)tau), a = zi * (float)tau; pw[((dir * 64 + n) * 17 + tau) * 2] = e * cosf(a); pw[((dir * 64 + n) * 17 + tau) * 2 + 1] = e * sinf(a); }
        const float lbr = pw[((dir * 64 + n) * 17 + 1) * 2], lbi = pw[((dir * 64 + n) * 17 + 1) * 2 + 1];
        const float nr = lbr - 1.f, ni = lbi, den = lr * lr + li * li; const float cr = (nr * lr + ni * li) / den, ci = (ni * lr - nr * li) / den;
        for (int q = 0; q < 16; ++q) { const float br = p.in[12][(dg * 64 + n) * 16 + q], bi = p.in[13][(dg * 64 + n) * 16 + q];
            Bb[((dir * 64 + n) * 16 + q) * 2] = cr * br - ci * bi; Bb[((dir * 64 + n) * 16 + q) * 2 + 1] = cr * bi + ci * br; } }
    for (int i = tid; i < 2048; i += 512) { const int dir = i >> 10, pp = (i >> 6) & 15, n = i & 63; Cc[i * 2] = p.in[14][((dir * 32 + g) * 16 + pp) * 64 + n]; Cc[i * 2 + 1] = p.in[15][((dir * 32 + g) * 16 + pp) * 64 + n]; }
    __syncthreads();
    for (int i = tid; i < 8192; i += 512) { const int dir = i >> 12, tau = (i >> 8) & 15, pp = (i >> 4) & 15, q = i & 15; float a = 0.f;
        for (int n = 0; n < 64; ++n) { const float cr = Cc[((dir * 16 + pp) * 64 + n) * 2], ci = Cc[((dir * 16 + pp) * 64 + n) * 2 + 1], wr = pw[((dir * 64 + n) * 17 + tau) * 2], wi = pw[((dir * 64 + n) * 17 + tau) * 2 + 1];
            const float zr = cr * wr - ci * wi, zi = cr * wi + ci * wr; a += zr * Bb[((dir * 64 + n) * 16 + q) * 2] - zi * Bb[((dir * 64 + n) * 16 + q) * 2 + 1]; }
        Kt[i] = a; }
    __syncthreads();
    bf16* TCV = (bf16*)(p.ws + WS_TCV) + (size_t)g * 256 * 512; const float* dsk = p.in[16] + g * 16;
    for (int i = tid; i < 256 * 512; i += 512) { const int row = i >> 9, k = i & 511, ii = row >> 4, pp = row & 15; float v;
        if (k < 256) { const int j = k >> 4, q = k & 15; v = 0.f; if (j <= ii) v += Kt[((ii - j) * 16 + pp) * 16 + q]; if (j >= ii) v += Kt[4096 + ((j - ii) * 16 + pp) * 16 + q]; if (j == ii && pp == q) v += dsk[pp]; }
        else { const int kk = k - 256, dir = kk >> 7, n = (kk >> 1) & 63, ri = kk & 1, tau = dir == 0 ? ii + 1 : 16 - ii;
            const float cr = Cc[((dir * 16 + pp) * 64 + n) * 2], ci = Cc[((dir * 16 + pp) * 64 + n) * 2 + 1], wr = pw[((dir * 64 + n) * 17 + tau) * 2], wi = pw[((dir * 64 + n) * 17 + tau) * 2 + 1];
            v = ri == 0 ? (cr * wr - ci * wi) : -(cr * wi + ci * wr); }
        TCV[i] = f2bf(v); }
    bf16* WS5 = (bf16*)(p.ws + WS_WS5) + (size_t)g * 256 * 256;
    for (int i = tid; i < 65536; i += 512) { const int row = i >> 8, k = i & 255, dir = row >> 7, n = (row >> 1) & 63, ri = row & 1, ii = k >> 4, q = k & 15, tau = dir == 0 ? 15 - ii : ii;
        const float wr = pw[((dir * 64 + n) * 17 + tau) * 2], wi = pw[((dir * 64 + n) * 17 + tau) * 2 + 1], br = Bb[((dir * 64 + n) * 16 + q) * 2], bi = Bb[((dir * 64 + n) * 16 + q) * 2 + 1];
        WS5[i] = f2bf(ri == 0 ? wr * br - wi * bi : wr * bi + wi * br); }
}
__device__ __forceinline__ void ph_s5scan(const P& p, int bx, int G) {
    if (threadIdx.x < 64) {
        const int n = threadIdx.x;
        for (int w = bx; w < 256; w += G) { const int b = w >> 6, g = (w >> 1) & 31, dir = w & 1, dg = dir * 32 + g;
            const float lr = p.in[9][dg * 64 + n], li = p.in[10][dg * 64 + n], step = expf(p.in[11][dg]); const float zr = 16.f * lr * step, zi = 16.f * li * step, ez = expf(zr);
            const float ar = ez * cosf(zi), ai = ez * sinf(zi);
            const bf16* sl = (const bf16*)(p.ws + WS_SL) + (size_t)g * NCHUNK_PAD * 256 + dir * 128 + 2 * n;
            bf16* hh = (bf16*)(p.ws + WS_UH) + (size_t)g * NCHUNK_PAD * 512 + 256 + dir * 128 + 2 * n;
            float sr = 0.f, si = 0.f;
            for (int jj = 0; jj < 16; jj += 8) { unsigned v[8];
#pragma unroll
                for (int u = 0; u < 8; ++u) { const int j = dir ? 15 - (jj + u) : jj + u; v[u] = *(const unsigned*)(sl + (size_t)(2048 + b * 16 + j) * 256); }
#pragma unroll
                for (int u = 0; u < 8; ++u) { const float x = __uint_as_float(v[u] << 16), y = __uint_as_float(v[u] & 0xffff0000u); const float nr = ar * sr - ai * si + x, ni = ar * si + ai * sr + y; sr = nr; si = ni; } }
            for (int kk = 0; kk < 512; kk += 8) { unsigned v[8];
#pragma unroll
                for (int u = 0; u < 8; ++u) { const int k = dir ? 511 - (kk + u) : kk + u; v[u] = *(const unsigned*)(sl + (size_t)(b * 512 + k) * 256); }
#pragma unroll
                for (int u = 0; u < 8; ++u) { const int k = dir ? 511 - (kk + u) : kk + u; *(unsigned*)(hh + (size_t)(b * 512 + k) * 512) = pk2(sr, si);
                    const float x = __uint_as_float(v[u] << 16), y = __uint_as_float(v[u] & 0xffff0000u); const float nr = ar * sr - ai * si + x, ni = ar * si + ai * sr + y; sr = nr; si = ni; } }
        }
    }
}

__global__ void __launch_bounds__(NWAVES * 64, 2) mk_fwd(P p, int ph_lo, int ph_hi) {
    extern __shared__ __attribute__((aligned(16))) unsigned char lds_raw[];
    LAS unsigned char* lds = (LAS unsigned char*)lds_raw;
    const int tid = threadIdx.x, G = gridDim.x, bx = blockIdx.x;
    const int vcu = (G % 8 == 0) ? (bx % 8) * (G / 8) + bx / 8 : bx;
    for (int u = tid; u < 64; u += NWAVES * 64) ((LAS unsigned*)(lds + LDSCTL_OFF))[u] = 0u;
    __syncthreads();
    unsigned* barw = (unsigned*)(p.ws + WS_CTL) + 4096;
    XcdBarrier bar; bar.bar = barw; bar.x = 0; bar.st = nullptr;
    if (ph_hi - ph_lo > 1) bar = xcd_barrier_post(barw, (volatile LAS unsigned*)(lds + LDSCTL_OFF) + 8);
#define IN(k) (ph_lo <= (k) && (k) < ph_hi)
#define SEAM(k) do { if (IN(k) && IN((k) + 1)) xcd_barrier(bar); } while (0)

    if (IN(0)) { ph_wconv(p, vcu, G, lds); __syncthreads(); if (bx >= G - 96) ph_mod(p, bx - (G - 96), 96, (float*)lds_raw); else if (bx >= G - 128) ph_s5tab(p, bx - (G - 128), (float*)lds_raw); ph_rope(p, bx, G); }
    SEAM(0);
    if (IN(1)) { ph_h1(p, bx, G); }
    SEAM(1);
    if (IN(2)) {
        pg8::GemmG g{(const char*)(p.ws + WS_H1), (const char*)(p.ws + WS_WIN), 128, (size_t)128 * 1024 * 2, (size_t)256 * 1024 * 2, 1024, 1024, nullptr, 0u};
        pg8::SchedProj S; S.init(G, bx);
        pg8::EpiProj E{(bf16*)(p.ws + WS_UH), (bf16*)(p.ws + WS_KB), (bf16*)(p.ws + WS_VB), (bf16*)(p.ws + WS_QB), (bf16*)(p.ws + WS_GT), p.in[20], p.in[21], (const float*)(p.ws + WS_ROPE)};
#ifdef DBG_ONEUNIT
        for (int i = 0; ; ++i) { pg8::Unit uu; if (!S.next(i, uu)) break; pg8::SchedOne s1{uu}; pg8::gemm_phase(lds + RING_OFF, g, pg8::AoRow{1024}, s1, E); }
#else
        pg8::gemm_phase(lds + RING_OFF, g, pg8::AoRow{1024}, S, E);
#endif
    }
    SEAM(2);
    if (IN(3)) {
        pg8::GemmG g{(const char*)(p.ws + WS_UH), (const char*)(p.ws + WS_WS5), 128, (size_t)128 * 512 * 2, (size_t)256 * 512 * 2, 256, 256, nullptr, 0u};
        pg8::SchedS5 S{9, G, bx};
        pg8::EpiSloc E{(bf16*)(p.ws + WS_SL)};
        pg8::gemm_phase(lds + RING_OFF, g, pg8::AoRow{512}, S, E);
    }
    SEAM(3);
    if (IN(4)) { ph_s5scan(p, bx, G); }
    SEAM(4);
    if (IN(5)) {
        pg8::GemmG g{(const char*)(p.ws + WS_UH), (const char*)(p.ws + WS_TCV), 128, (size_t)128 * 512 * 2, (size_t)256 * 512 * 2, 512, 512, nullptr, 0u};
        pg8::SchedS5 S{8, G, bx};
        pg8::EpiS5Y E{(bf16*)(p.ws + WS_SG)};
        pg8::gemm_phase(lds + RING_OFF, g, pg8::AoRow{512}, S, E);
    }
    SEAM(5);
    if (IN(6)) {
        const attn_body::AttnTensors AT{(const attn_body::bf16*)(p.ws + WS_QB), (const attn_body::bf16*)(p.ws + WS_KB), (const attn_body::bf16*)(p.ws + WS_VB), (attn_body::bf16*)(p.ws + WS_GO) + 512};
        const attn_body::StaticOrder S(G, bx);
        attn_body::attn_phase<attn_body::StaticOrder>((char*)lds_raw + RING_OFF, AT, S);
    }
    SEAM(6);
    if (IN(7)) {
        pg8::GemmG g{(const char*)(p.ws + WS_SG), (const char*)(p.ws + WS_WGLU), (size_t)4 * T * 32, (size_t)128 * 32, (size_t)256 * 32, 512, 512, nullptr, 0u};
        pg8::StaticOrder S; S.init(T, 512, G, bx);
        pg8::EpiGlu E{(const bf16*)(p.ws + WS_SG), p.in[18], (bf16*)(p.ws + WS_GO)};
        pg8::gemm_phase(lds + RING_OFF, g, pg8::AoGrp{}, S, E);
    }
    SEAM(7);
    if (IN(8)) {
        pg8::StaticOrder S; S.init(T, 1024, G, bx);
        { pg8::GemmG g{(const char*)(p.ws + WS_GO), (const char*)(p.ws + WS_W12), 128, (size_t)128 * 1024 * 2, (size_t)256 * 1024 * 2, 1024, 512, nullptr, 0u};
          pg8::EpiMerge<0> E{(const bf16*)(p.ws + WS_GT), (float*)(p.ws + WS_M1), (bf16*)(p.ws + WS_MG)};
          pg8::gemm_phase(lds + RING_OFF, g, pg8::AoRow{1024}, S, E); }
        { pg8::GemmG g{(const char*)(p.ws + WS_GO) + 1024, (const char*)(p.ws + WS_W12) + 1024, 128, (size_t)128 * 1024 * 2, (size_t)256 * 1024 * 2, 1024, 512, nullptr, 0u};
          pg8::EpiMerge<1> E{(const bf16*)(p.ws + WS_GT), (float*)(p.ws + WS_M1), (bf16*)(p.ws + WS_MG)};
          pg8::gemm_phase(lds + RING_OFF, g, pg8::AoRow{1024}, S, E); }
    }
    SEAM(8);
    if (IN(9)) {
        pg8::GemmG g{(const char*)(p.ws + WS_MG), (const char*)(p.ws + WS_WOUT), 128, (size_t)128 * 1024 * 2, (size_t)256 * 1024 * 2, 1024, 1024, nullptr, 0u};
        pg8::StaticOrder S; S.init(T, 1024, G, bx);
        pg8::EpiOut E{p.in[0], (const float*)(p.ws + WS_MOD), (float*)(p.ws + WS_XM)};
        pg8::gemm_phase(lds + RING_OFF, g, pg8::AoRow{1024}, S, E);
    }
    SEAM(9);
    if (IN(10)) { ph_route_a(p, bx, G, (float*)lds_raw); }
    SEAM(10);
    if (IN(11)) { ph_route_b(p, bx, G, (int*)lds_raw); }
    SEAM(11);
    if (IN(12) || IN(13)) {
        const int* TILE_E = (const int*)(p.ws + WS_TILE); LAS int* lt = (LAS int*)(lds + LDS_TILE_OFF);
        for (int i = tid; i < 1024; i += NWAVES * 64) lt[i] = TILE_E[i];
        __syncthreads();
    }
    if (IN(12)) {
        const LAS int* lt = (const LAS int*)(lds + LDS_TILE_OFF);
        pg8::GemmG g{(const char*)(p.ws + WS_H2), (const char*)(p.ws + WS_WGU), 128, 0, 0, 1024, 1024, (const int*)(p.ws + WS_SLOTTOK), 2048u};
        pg8::SchedMoE S{lt, lt[1023], 8, G, bx};
        pg8::EpiGU E{p.in[27], (bf16*)(p.ws + WS_ACT)};
        pg8::gemm_phase<pg8::EpiGU, pg8::SchedMoE, pg8::AoRow, true>(lds + RING_OFF, g, pg8::AoRow{1024}, S, E);
    }
    SEAM(12);
    if (IN(13)) {
        const LAS int* lt = (const LAS int*)(lds + LDS_TILE_OFF);
        pg8::GemmG g{(const char*)(p.ws + WS_ACT), (const char*)(p.ws + WS_WD), 128, (size_t)128 * 1024 * 2, (size_t)256 * 1024 * 2, 1024, 1024, nullptr, 0u};
        pg8::SchedMoE S{lt, lt[1023], 4, G, bx};
        pg8::EpiDown E{p.in[29], (const float*)(p.ws + WS_SLOTGATE), (bf16*)(p.ws + WS_YB)};
        pg8::gemm_phase(lds + RING_OFF, g, pg8::AoRow{1024}, S, E);
    }
    SEAM(13);
    if (IN(14)) { ph_final(p, bx, G); }
#undef IN
#undef SEAM
}

template <bool DUAL, class AF, class BF, class EF>
__device__ __forceinline__ void gemm_simple_tile(int m0, int n0, int K, const AF& af, const BF& bf, const EF& ef) {
    __shared__ float As[16][68]; __shared__ float Bs[16][64]; __shared__ float Bs2[DUAL ? 16 : 1][64];
    const int tid = threadIdx.x, ty = tid >> 4, tx = tid & 15;
    float acc[4][4], acc2[4][4];
#pragma unroll
    for (int i = 0; i < 4; ++i)
#pragma unroll
        for (int j = 0; j < 4; ++j) { acc[i][j] = 0.f; acc2[i][j] = 0.f; }
    for (int k0 = 0; k0 < K; k0 += 16) {
        { const int r = tid >> 2, kk = (tid & 3) * 4;
#pragma unroll
          for (int q = 0; q < 4; ++q) As[kk + q][r] = af(m0 + r, k0 + kk + q); }
        { const int kk = tid >> 4, c = (tid & 15) * 4;
#pragma unroll
          for (int q = 0; q < 4; ++q) { Bs[kk][c + q] = bf(k0 + kk, n0 + c + q, 0); if (DUAL) Bs2[kk][c + q] = bf(k0 + kk, n0 + c + q, 1); } }
        __syncthreads();
#pragma unroll
        for (int kk = 0; kk < 16; ++kk) {
            const float4 a = *(const float4*)&As[kk][ty * 4]; const float4 b = *(const float4*)&Bs[kk][tx * 4];
            const float av[4] = {a.x, a.y, a.z, a.w}, bv[4] = {b.x, b.y, b.z, b.w};
#pragma unroll
            for (int i = 0; i < 4; ++i)
#pragma unroll
                for (int j = 0; j < 4; ++j) acc[i][j] += av[i] * bv[j];
            if (DUAL) { const float4 b2 = *(const float4*)&Bs2[kk][tx * 4]; const float b2v[4] = {b2.x, b2.y, b2.z, b2.w};
#pragma unroll
                for (int i = 0; i < 4; ++i)
#pragma unroll
                    for (int j = 0; j < 4; ++j) acc2[i][j] += av[i] * b2v[j]; }
        }
        __syncthreads();
    }
#pragma unroll
    for (int i = 0; i < 4; ++i)
#pragma unroll
        for (int j = 0; j < 4; ++j) ef(m0 + ty * 4 + i, n0 + tx * 4 + j, acc[i][j], acc2[i][j]);
}

__global__ void __launch_bounds__(256) k_win_naive(P p) {
    const size_t idx = (size_t)blockIdx.x * 256 + threadIdx.x; const int k = (int)(idx / DIN), n = (int)(idx % DIN);
    ((bf16*)(p.ws + WS_WIN))[(size_t)proj_perm(n) * 1024 + k] = f2bf(p.in[8][idx]);
}
#ifndef PROJ_DBG
#define PROJ_DBG 3
#endif
__global__ void __launch_bounds__(256) k_proj_naive(P p) {
    const int n0 = blockIdx.x * 64, m0 = blockIdx.y * 64;
    if (m0 >= T && n0 >= COL_Q) return;
    const bf16* H1 = (const bf16*)(p.ws + WS_H1); const float* W = p.in[8];
    bf16* UH = (bf16*)(p.ws + WS_UH); float* QKVF = (float*)(p.ws + WS_M1); bf16* GT = (bf16*)(p.ws + WS_GT);
    auto af = [=](int r, int k) { return bf2f(H1[(size_t)r * DM + k]); };
    auto bf = [=](int k, int c, int) { return W[(size_t)k * DIN + c]; };
    auto ef = [=](int r, int c, float a, float) {
        if (c < COL_K) { if (PROJ_DBG & 1) UH[((size_t)(c >> 4) * NCHUNK_PAD + (r >> 4)) * 512 + (r & 15) * 16 + (c & 15)] = f2bf(a); }
        else if (c < COL_GATE) QKVF[(size_t)r * 768 + (c - COL_K)] = a;
        else if (r < T) { if (PROJ_DBG & 2) GT[(size_t)r * 2048 + (c - COL_GATE)] = f2bf(sigmoidf(a)); }
    };
    gemm_simple_tile<false>(m0, n0, DM, af, bf, ef);
}
__global__ void __launch_bounds__(256) k_qkv_post(P p) {
    const int idx = blockIdx.x * 256 + threadIdx.x; const int r = idx / 12, s = idx % 12;
    if (r >= TR) return; if (r >= T && s >= 4) return;
    const float* QKVF = (const float*)(p.ws + WS_M1) + (size_t)r * 768; const float* R = (const float*)(p.ws + WS_ROPE);
    bf16* KB = (bf16*)(p.ws + WS_KB); bf16* VB = (bf16*)(p.ws + WS_VB); bf16* QB = (bf16*)(p.ws + WS_QB);
    int b, spos; const bool lat = r < T;
    if (lat) { b = r / SEQ; spos = LC + (r % SEQ); } else { b = (r - T) / LC; spos = (r - T) % LC; }
    if (s == 2 || s == 3) { const float* v = QKVF + 128 + (s - 2) * 64; bf16* o = VB + ((size_t)(b * 2 + (s - 2)) * SKV + spos) * 64; for (int d = 0; d < 64; ++d) o[d] = f2bf(v[d]); return; }
    const bool isq = s >= 4; const float* v = isq ? QKVF + 256 + (s - 4) * 64 : QKVF + s * 64; const float* gn = isq ? p.in[20] : p.in[21];
    float ss = 0.f; for (int d = 0; d < 64; ++d) ss += v[d] * v[d];
    const float rs = 1.f / sqrtf(ss * (1.f / 64.f) + EPS);
    bf16* o = isq ? QB + (size_t)r * 512 + (s - 4) * 64 : KB + ((size_t)(b * 2 + s) * SKV + spos) * 64;
    const float sc = isq ? C2 : 1.f;
    const int t = r % SEQ, rid = t / 64, cid = t % 64;
    for (int j = 0; j < 32; ++j) {
        float x1 = v[2 * j] * rs * gn[2 * j], x2 = v[2 * j + 1] * rs * gn[2 * j + 1];
        if (lat) { const float cs = j < 16 ? R[rid * 16 + j] : R[4096 + cid * 16 + (j - 16)], sn = j < 16 ? R[2048 + rid * 16 + j] : R[5120 + cid * 16 + (j - 16)];
            const float y1 = x1 * cs - x2 * sn, y2 = x1 * sn + x2 * cs; x1 = y1; x2 = y2; }
        o[2 * j] = f2bf(x1 * sc); o[2 * j + 1] = f2bf(x2 * sc);
    }
}
__global__ void __launch_bounds__(64) k_s5_naive(P p) {
    const int idx = blockIdx.x, b = idx >> 6, dir = (idx >> 5) & 1, g = idx & 31, n = threadIdx.x, lane = n;
    const int dg = dir * 32 + g;
    const float lr = p.in[9][dg * 64 + n], li = p.in[10][dg * 64 + n]; const float step = expf(p.in[11][dg]);
    const float zr = lr * step, zi = li * step, ez = expf(zr); const float lbr = ez * cosf(zi), lbi = ez * sinf(zi);
    const float nr = lbr - 1.f, ni = lbi, den = lr * lr + li * li; const float cr = (nr * lr + ni * li) / den, ci = (ni * lr - nr * li) / den;
    float Br[16], Bi[16], Cr[16], Ci[16];
#pragma unroll
    for (int q = 0; q < 16; ++q) { const float br = p.in[12][(dg * 64 + n) * 16 + q], bi = p.in[13][(dg * 64 + n) * 16 + q]; Br[q] = cr * br - ci * bi; Bi[q] = cr * bi + ci * br; }
#pragma unroll
    for (int q = 0; q < 16; ++q) { Cr[q] = p.in[14][(dg * 16 + q) * 64 + n]; Ci[q] = p.in[15][(dg * 16 + q) * 64 + n]; }
    const bf16* UH = (const bf16*)(p.ws + WS_UH); float* YS = (float*)(p.ws + WS_M1) + (size_t)dir * T * 512;
    float hr = 0.f, hi = 0.f;
    for (int st = 0; st < LC + SEQ; ++st) {
        int tokrow; const bool lat = st >= LC;
        if (dir == 0) tokrow = lat ? b * SEQ + (st - LC) : T + b * LC + st;
        else tokrow = lat ? b * SEQ + (SEQ - 1 - (st - LC)) : T + b * LC + (LC - 1 - st);
        const bf16* up = UH + ((size_t)g * NCHUNK_PAD + (tokrow >> 4)) * 512 + (tokrow & 15) * 16;
        float bur = 0.f, bui = 0.f;
#pragma unroll
        for (int q = 0; q < 16; ++q) { const float u = bf2f(up[q]); bur += Br[q] * u; bui += Bi[q] * u; }
        const float nhr = lbr * hr - lbi * hi + bur, nhi = lbr * hi + lbi * hr + bui; hr = nhr; hi = nhi;
        if (lat) {
            float y[16], y8[8], y4[4], y2[2], val;
#pragma unroll
            for (int q = 0; q < 16; ++q) y[q] = Cr[q] * hr - Ci[q] * hi;
            { const bool h = lane & 32;
#pragma unroll
              for (int i = 0; i < 8; ++i) { const float a = y[i], bq = y[i + 8]; const float send = h ? a : bq, keep = h ? bq : a; y8[i] = keep + __shfl_xor(send, 32); } }
            { const bool h = lane & 16;
#pragma unroll
              for (int i = 0; i < 4; ++i) { const float a = y8[i], bq = y8[i + 4]; const float send = h ? a : bq, keep = h ? bq : a; y4[i] = keep + __shfl_xor(send, 16); } }
            { const bool h = lane & 8;
#pragma unroll
              for (int i = 0; i < 2; ++i) { const float a = y4[i], bq = y4[i + 2]; const float send = h ? a : bq, keep = h ? bq : a; y2[i] = keep + __shfl_xor(send, 8); } }
            { const bool h = lane & 4; const float a = y2[0], bq = y2[1]; const float send = h ? a : bq, keep = h ? bq : a; val = keep + __shfl_xor(send, 4); }
            val += __shfl_xor(val, 2); val += __shfl_xor(val, 1);
            const int pp = ((lane >> 5) & 1) * 8 + ((lane >> 4) & 1) * 4 + ((lane >> 3) & 1) * 2 + ((lane >> 2) & 1);
            if ((lane & 3) == 0) YS[(size_t)tokrow * 512 + g * 16 + pp] = val;
        }
    }
}
__device__ __forceinline__ float gelu_tanh(float x) { const float u = 0.7978845608028654f * (x + 0.044715f * x * x * x); return 0.5f * x * (1.f + tanhf(u)); }
__global__ void __launch_bounds__(256) k_s5_post(P p) {
    const size_t idx = (size_t)blockIdx.x * 256 + threadIdx.x; const int r = (int)(idx >> 9), ch = (int)(idx & 511), g = ch >> 4, q = ch & 15;
    const bf16* UH = (const bf16*)(p.ws + WS_UH); const float* YS = (const float*)(p.ws + WS_M1); bf16* SG = (bf16*)(p.ws + WS_SG);
    const float u = bf2f(UH[((size_t)g * NCHUNK_PAD + (r >> 4)) * 512 + (r & 15) * 16 + q]);
    const float y = u * p.in[16][ch] + YS[(size_t)r * 512 + ch] + YS[(size_t)T * 512 + (size_t)r * 512 + ch];
    SG[((size_t)g * T + r) * 16 + q] = f2bf(gelu_tanh(y));
}
__global__ void __launch_bounds__(256) k_attn_naive(P p) {
    const int bh = blockIdx.y, b = bh >> 3, h = bh & 7, t = blockIdx.x * 256 + threadIdx.x, r = b * SEQ + t;
    const bf16* QB = (const bf16*)(p.ws + WS_QB) + (size_t)r * 512 + h * 64;
    const bf16* Kp = (const bf16*)(p.ws + WS_KB) + (size_t)(b * 2 + (h >> 2)) * SKV * 64; const bf16* Vp = (const bf16*)(p.ws + WS_VB) + (size_t)(b * 2 + (h >> 2)) * SKV * 64;
    float q[64], o[64];
#pragma unroll
    for (int d = 0; d < 64; ++d) { q[d] = bf2f(QB[d]); o[d] = 0.f; }
    float m = -1e30f, l = 0.f;
    for (int s = 0; s < SKV; ++s) {
        const uint4* kr = (const uint4*)(Kp + (size_t)s * 64); float sc = 0.f;
#pragma unroll
        for (int c = 0; c < 8; ++c) { const uint4 kk = kr[c]; const unsigned w[4] = {kk.x, kk.y, kk.z, kk.w};
#pragma unroll
            for (int e = 0; e < 4; ++e) { sc += q[c * 8 + 2 * e] * __uint_as_float(w[e] << 16); sc += q[c * 8 + 2 * e + 1] * __uint_as_float(w[e] & 0xffff0000u); } }
        const float mn = fmaxf(m, sc), al = exp2f(m - mn), pe = exp2f(sc - mn); l = l * al + pe; m = mn;
        const uint4* vr = (const uint4*)(Vp + (size_t)s * 64);
#pragma unroll
        for (int c = 0; c < 8; ++c) { const uint4 vv = vr[c]; const unsigned w[4] = {vv.x, vv.y, vv.z, vv.w};
#pragma unroll
            for (int e = 0; e < 4; ++e) { o[c * 8 + 2 * e] = o[c * 8 + 2 * e] * al + pe * __uint_as_float(w[e] << 16); o[c * 8 + 2 * e + 1] = o[c * 8 + 2 * e + 1] * al + pe * __uint_as_float(w[e] & 0xffff0000u); } }
    }
    bf16* O = (bf16*)(p.ws + WS_GO) + (size_t)r * 1024 + 512 + h * 64; const float il = 1.f / l;
#pragma unroll
    for (int d = 0; d < 64; ++d) O[d] = f2bf(o[d] * il);
}
__global__ void __launch_bounds__(256) k_glu_naive(P p) {
    const int n0 = blockIdx.x * 64, m0 = blockIdx.y * 64;
    const bf16* SG = (const bf16*)(p.ws + WS_SG); const float* W = p.in[17]; const float* bg = p.in[18]; bf16* GO = (bf16*)(p.ws + WS_GO);
    auto af = [=](int r, int k) { return bf2f(SG[((size_t)(k >> 4) * T + r) * 16 + (k & 15)]); };
    auto bf = [=](int k, int c, int) { return W[(size_t)k * 512 + c]; };
    auto ef = [=](int r, int c, float a, float) { const float s = bf2f(SG[((size_t)(c >> 4) * T + r) * 16 + (c & 15)]); GO[(size_t)r * 1024 + c] = f2bf(s * sigmoidf(a + bg[c])); };
    gemm_simple_tile<false>(m0, n0, 512, af, bf, ef);
}
__global__ void __launch_bounds__(256) k_m1_naive(P p) {
    const int n0 = blockIdx.x * 64, m0 = blockIdx.y * 64;
    const bf16* GO = (const bf16*)(p.ws + WS_GO); const float* W = p.in[19]; const bf16* GT = (const bf16*)(p.ws + WS_GT); float* M1 = (float*)(p.ws + WS_M1);
    auto af = [=](int r, int k) { return bf2f(GO[(size_t)r * 1024 + k]); };
    auto bf = [=](int k, int c, int) { return W[(size_t)k * 1024 + c]; };
    auto ef = [=](int r, int c, float a, float) { M1[(size_t)r * 1024 + c] = bf2f(GT[(size_t)r * 2048 + c]) * a; };
    gemm_simple_tile<false>(m0, n0, 512, af, bf, ef);
}
__global__ void __launch_bounds__(256) k_m2_naive(P p) {
    const int n0 = blockIdx.x * 64, m0 = blockIdx.y * 64;
    const bf16* GO = (const bf16*)(p.ws + WS_GO); const float* W = p.in[22]; const bf16* GT = (const bf16*)(p.ws + WS_GT); const float* M1 = (const float*)(p.ws + WS_M1); bf16* MG = (bf16*)(p.ws + WS_MG);
    auto af = [=](int r, int k) { return bf2f(GO[(size_t)r * 1024 + 512 + k]); };
    auto bf = [=](int k, int c, int) { return W[(size_t)k * 1024 + c]; };
    auto ef = [=](int r, int c, float a, float) { MG[(size_t)r * 1024 + c] = f2bf(M1[(size_t)r * 1024 + c] + bf2f(GT[(size_t)r * 2048 + 1024 + c]) * a); };
    gemm_simple_tile<false>(m0, n0, 512, af, bf, ef);
}
__global__ void __launch_bounds__(256) k_out_naive(P p) {
    const int n0 = blockIdx.x * 64, m0 = blockIdx.y * 64;
    const bf16* MG = (const bf16*)(p.ws + WS_MG); const float* W = p.in[23]; const float* mod = (const float*)(p.ws + WS_MOD); const float* x = p.in[0]; float* XM = (float*)(p.ws + WS_XM);
    auto af = [=](int r, int k) { return bf2f(MG[(size_t)r * 1024 + k]); };
    auto bf = [=](int k, int c, int) { return W[(size_t)k * 1024 + c]; };
    auto ef = [=](int r, int c, float a, float) { XM[(size_t)r * 1024 + c] = x[(size_t)r * 1024 + c] + mod[(r / SEQ) * NMOD + 2048 + c] * a; };
    gemm_simple_tile<false>(m0, n0, 1024, af, bf, ef);
}
__global__ void __launch_bounds__(256) k_gu_naive(P p) {
    const int n0 = blockIdx.x * 64, m0 = blockIdx.y * 64; const int* TILE_E = (const int*)(p.ws + WS_TILE);
    if ((m0 >> 8) >= TILE_E[1023]) return;
    const int e = TILE_E[m0 >> 8];
    const bf16* H2 = (const bf16*)(p.ws + WS_H2); const int* SLOT_TOK = (const int*)(p.ws + WS_SLOTTOK); bf16* ACT = (bf16*)(p.ws + WS_ACT);
    const float* W = p.in[26] + (size_t)e * 1024 * 2048; const float* bgu = p.in[27] + e * 2048;
    auto af = [=](int r, int k) { return bf2f(H2[(size_t)SLOT_TOK[r] * 1024 + k]); };
    auto bf = [=](int k, int c, int w) { return W[(size_t)k * 2048 + c + (w ? 1024 : 0)]; };
    auto ef = [=](int r, int c, float a, float a2) { const float gt = fminf(a + bgu[c], 7.f); const float up = fminf(fmaxf(a2 + bgu[1024 + c], -7.f), 7.f);
        ACT[(size_t)r * 1024 + c] = f2bf((up + 1.f) * (gt * sigmoidf(1.702f * gt))); };
    gemm_simple_tile<true>(m0, n0, 1024, af, bf, ef);
}
__global__ void __launch_bounds__(256) k_down_naive(P p) {
    const int n0 = blockIdx.x * 64, m0 = blockIdx.y * 64; const int* TILE_E = (const int*)(p.ws + WS_TILE);
    if ((m0 >> 8) >= TILE_E[1023]) return;
    const int e = TILE_E[m0 >> 8];
    const bf16* ACT = (const bf16*)(p.ws + WS_ACT); const float* SLOT_GATE = (const float*)(p.ws + WS_SLOTGATE); bf16* YB = (bf16*)(p.ws + WS_YB);
    const float* W = p.in[28] + (size_t)e * 1024 * 1024; const float* bd = p.in[29] + e * 1024;
    auto af = [=](int r, int k) { return bf2f(ACT[(size_t)r * 1024 + k]); };
    auto bf = [=](int k, int c, int) { return W[(size_t)k * 1024 + c]; };
    auto ef = [=](int r, int c, float a, float) { YB[(size_t)r * 1024 + c] = f2bf(SLOT_GATE[r] * (a + bd[c])); };
    gemm_simple_tile<false>(m0, n0, 1024, af, bf, ef);
}


extern "C" void kernel_launch(void* const* d_in, const int* in_sizes, int n_in, void* d_out, int out_size, void* d_ws, size_t ws_size, hipStream_t stream) {
    if (n_in != 31 || out_size != T * DM || ws_size < WS_END) { fprintf(stderr, "kernel_launch: unexpected shapes (n_in %d out %d ws %zu)\n", n_in, out_size, ws_size); return; }
    static int grid = 0;
    if (!grid) {
        int dev = 0, cus = 0, per_cu = 0;
        (void)hipGetDevice(&dev); (void)hipDeviceGetAttribute(&cus, hipDeviceAttributeMultiprocessorCount, dev);
        (void)hipFuncSetAttribute((const void*)mk_fwd, hipFuncAttributeMaxDynamicSharedMemorySize, LDS_BYTES);
        (void)hipOccupancyMaxActiveBlocksPerMultiprocessor(&per_cu, (const void*)mk_fwd, NWAVES * 64, LDS_BYTES);
        (void)hipGetLastError();
        if (cus != 256 || per_cu < 1) fprintf(stderr, "kernel_launch: note: %d CUs, occupancy query %d; this kernel is built for one 512-thread workgroup on each of 256 CUs\n", cus, per_cu);
        grid = 256;
    }
    P p{}; for (int i = 0; i < 31; ++i) p.in[i] = (const float*)d_in[i]; p.out = (float*)d_out; p.ws = (unsigned char*)d_ws;
    (void)hipMemsetAsync((char*)d_ws + WS_CTL, 0, 1 * MiB, stream);
    hipLaunchKernelGGL(mk_fwd, dim3(grid), dim3(NWAVES * 64), LDS_BYTES, stream, p, 0, 15);
}
```

```cpp
#include <hip/hip_runtime.h>
#include <cstdio>
#include <cstdint>

constexpr int NB = 4, SEQ = 8192, DM = 1024, LC = 256;
constexpr int T = NB * SEQ;
constexpr int TC = NB * LC;
constexpr int TR = T + TC;
constexpr int DIN = 3328, COL_K = 512, COL_V = 640, COL_Q = 768, COL_GATE = 1280;
constexpr int NMOD = 6 * DM;
constexpr int SKV = LC + SEQ;
constexpr int NE = 32;
constexpr int NSLOT_MAX = 139264;
constexpr int NCHUNK_PAD = 2304;
constexpr float EPS = 1e-6f;
constexpr float C2 = 0.125f * 1.4426950408889634f;

constexpr size_t MiB = 1u << 20;
constexpr size_t WS_CTL = 0;
constexpr size_t WS_MOD = 1 * MiB;
constexpr size_t WS_ROPE = 1 * MiB + 256 * 1024;
constexpr size_t WS_WCNT = 2 * MiB;
constexpr size_t WS_BCNT = 2 * MiB + 256 * 1024;
constexpr size_t WS_KD = 2 * MiB + 384 * 1024;
constexpr size_t WS_TILE = 2 * MiB + 512 * 1024;
constexpr size_t WS_WIN = 4 * MiB, WS_WGLU = 11 * MiB, WS_W12 = 12 * MiB, WS_WOUT = 14 * MiB;
constexpr size_t WS_TCV = 16 * MiB, WS_WS5 = 24 * MiB;
constexpr size_t WS_WGU = 32 * MiB, WS_WD = 160 * MiB;
constexpr size_t WS_SL = 733 * MiB;
constexpr size_t WS_TOPI = 28 * MiB, WS_TOPG = 28 * MiB + 512 * 1024, WS_TOKSLOT = 29 * MiB;
constexpr size_t WS_SLOTTOK = 29 * MiB + 512 * 1024, WS_SLOTGATE = 30 * MiB + 512 * 1024;
constexpr size_t WS_XM = 224 * MiB;
constexpr size_t WS_H2 = 352 * MiB;
constexpr size_t WS_H2S = 384 * MiB;
constexpr size_t WS_SLOTSA = 385 * MiB;
constexpr size_t WS_WGQ = 288 * MiB;
constexpr size_t WS_WGS = 3 * MiB;
constexpr size_t WS_H1 = 417 * MiB;
constexpr size_t WS_H1S = 451 * MiB;
constexpr size_t WS_WINS = 3 * MiB + 256 * 1024;
constexpr size_t WS_UH = 483 * MiB;
constexpr size_t WS_KB = 555 * MiB, WS_VB = 564 * MiB;
constexpr size_t WS_QB = 573 * MiB;
constexpr size_t WS_GT = 605 * MiB;
constexpr size_t WS_SG = 769 * MiB;
constexpr size_t WS_GO = 801 * MiB;
constexpr size_t WS_M1 = 865 * MiB;
constexpr size_t WS_MG = 417 * MiB;
constexpr size_t WS_ACT = 417 * MiB;
constexpr size_t WS_YB = 689 * MiB;
constexpr size_t WS_END = 993 * MiB;

typedef unsigned short bf16;
struct P { const float* in[31]; float* out; unsigned char* ws; };

__device__ __forceinline__ float bf2f(bf16 v) { return __uint_as_float(((unsigned)v) << 16); }
__device__ __forceinline__ bf16 f2bf(float f) { unsigned u = __float_as_uint(f); return (bf16)((u + 0x7fffu + ((u >> 16) & 1u)) >> 16); }
__device__ __forceinline__ unsigned pk2(float lo, float hi) { return (unsigned)f2bf(lo) | ((unsigned)f2bf(hi) << 16); }
__device__ __forceinline__ float wave_sum(float v) {
#pragma unroll
    for (int o = 1; o < 64; o <<= 1) v += __shfl_xor(v, o);
    return v;
}
__device__ __forceinline__ float sigmoidf(float v) { return 1.f / (1.f + expf(-v)); }

__device__ __forceinline__ void ph_mod(const P& p, int bid, int nb, float* lds) {
    float* s = lds; float* red = lds + 5 * 1024;
    const float* c = p.in[1]; const float* cc = p.in[3];
    for (int i = threadIdx.x; i < 5 * 1024; i += 512) { const float v = i < 4096 ? c[i] : cc[i - 4096]; s[i] = v / (1.f + expf(-v)); }
    __syncthreads();
    const float* w = p.in[4]; const float* bm = p.in[5]; float* mod = (float*)(p.ws + WS_MOD);
    const int jl = threadIdx.x & 63, ks = threadIdx.x >> 6;
    for (int it = bid; it < 96; it += nb) {
        const int j = it * 64 + jl;
        float a0 = 0.f, a1 = 0.f, a2 = 0.f, a3 = 0.f, a4 = 0.f;
        for (int k0 = ks * 128; k0 < ks * 128 + 128; k0 += 32) { float wv[32];
#pragma unroll
            for (int q = 0; q < 32; ++q) wv[q] = w[(size_t)(k0 + q) * NMOD + j];
#pragma unroll
            for (int q = 0; q < 32; ++q) { const int k = k0 + q; a0 += s[k] * wv[q]; a1 += s[1024 + k] * wv[q]; a2 += s[2048 + k] * wv[q]; a3 += s[3072 + k] * wv[q]; a4 += s[4096 + k] * wv[q]; }
        }
        red[(ks * 5 + 0) * 64 + jl] = a0; red[(ks * 5 + 1) * 64 + jl] = a1; red[(ks * 5 + 2) * 64 + jl] = a2; red[(ks * 5 + 3) * 64 + jl] = a3; red[(ks * 5 + 4) * 64 + jl] = a4;
        __syncthreads();
        if (threadIdx.x < 320) { const int r = threadIdx.x >> 6; float t = 0.f;
            for (int q = 0; q < 8; ++q) t += red[(q * 5 + r) * 64 + jl];
            mod[r * NMOD + j] = t + bm[j]; }
        __syncthreads();
    }
}
__device__ __forceinline__ void ph_rope(const P& p, int bid, int nb) {
    float* R = (float*)(p.ws + WS_ROPE);
    for (int i = bid * 512 + threadIdx.x; i < 192 * 16; i += nb * 512) {
        const int j = i & 15; const int pos = i >> 4;
        const float invf = powf(10000.f, -(float)j / 16.f);
        if (pos < 128) { const float a = (float)pos * invf; R[pos * 16 + j] = cosf(a); R[2048 + pos * 16 + j] = sinf(a); }
        else { const int cp = pos - 128; const float a = (float)cp * invf; R[4096 + cp * 16 + j] = cosf(a); R[5120 + cp * 16 + j] = sinf(a); }
    }
}
__device__ __forceinline__ void ph_h1_row(const float4 (&v)[4], const float4 (&gf)[4], const float4 (&sh)[4], signed char* orow, float* oscale, int lane) {
    float ss = 0.f;
#pragma unroll
    for (int j = 0; j < 4; ++j) ss += v[j].x * v[j].x + v[j].y * v[j].y + v[j].z * v[j].z + v[j].w * v[j].w;
    ss = wave_sum(ss); const float rs = 1.f / sqrtf(ss * (1.f / DM) + EPS); float h[4][4]; float am = 0.f;
#pragma unroll
    for (int j = 0; j < 4; ++j) { h[j][0] = v[j].x * rs * gf[j].x + sh[j].x; h[j][1] = v[j].y * rs * gf[j].y + sh[j].y; h[j][2] = v[j].z * rs * gf[j].z + sh[j].z; h[j][3] = v[j].w * rs * gf[j].w + sh[j].w;
        am = fmaxf(fmaxf(am, fmaxf(fabsf(h[j][0]), fabsf(h[j][1]))), fmaxf(fabsf(h[j][2]), fabsf(h[j][3]))); }
#pragma unroll
    for (int o = 1; o < 64; o <<= 1) am = fmaxf(am, __shfl_xor(am, o));
    const float inv = am > 0.f ? 127.f / am : 0.f;
#pragma unroll
    for (int j = 0; j < 4; ++j) { const int q0 = __float2int_rn(h[j][0] * inv), q1 = __float2int_rn(h[j][1] * inv), q2 = __float2int_rn(h[j][2] * inv), q3 = __float2int_rn(h[j][3] * inv);
        *(unsigned*)(orow + 4 * lane + 256 * j) = (unsigned)(q0 & 255) | ((unsigned)(q1 & 255) << 8) | ((unsigned)(q2 & 255) << 16) | ((unsigned)(q3 & 255) << 24); }
    if (lane == 0) *oscale = am * (1.f / 127.f);
}
__device__ __forceinline__ void ph_h1(const P& p, int bid, int nb) {
    const int lane = threadIdx.x & 63, wave = threadIdx.x >> 6, gw = bid * 8 + wave, ngw = nb * 8;
    const float* g = p.in[6]; const float* mod = (const float*)(p.ws + WS_MOD); signed char* H1 = (signed char*)(p.ws + WS_H1); float* H1S = (float*)(p.ws + WS_H1S);
    const int rpw = T / ngw;
    float4 gf[4], sh[4], v[4], v1[4], v2[4];
#define H1_MOD(mrow) do { _Pragma("unroll") for (int j = 0; j < 4; ++j) { const int col = 4 * lane + 256 * j; const float4 gg = *(const float4*)(g + col), sc = *(const float4*)(mod + (mrow) * NMOD + 1024 + col); \
        sh[j] = *(const float4*)(mod + (mrow) * NMOD + col); gf[j] = make_float4(gg.x * (1.f + sc.x), gg.y * (1.f + sc.y), gg.z * (1.f + sc.z), gg.w * (1.f + sc.w)); } } while (0)
#define H1_LOAD(V, xr) do { _Pragma("unroll") for (int j = 0; j < 4; ++j) V[j] = ((const float4*)(xr))[lane + 64 * j]; } while (0)
    const int r0 = gw * rpw; const float* x0 = p.in[0] + (size_t)r0 * DM;
    H1_LOAD(v, x0); H1_LOAD(v1, x0 + DM);
    H1_MOD(r0 / SEQ);
    for (int k = 0; k < rpw; ++k) {
        if (k + 2 < rpw) H1_LOAD(v2, x0 + (size_t)(k + 2) * DM);
        ph_h1_row(v, gf, sh, H1 + (size_t)(r0 + k) * DM, H1S + r0 + k, lane);
#pragma unroll
        for (int j = 0; j < 4; ++j) { v[j] = v1[j]; v1[j] = v2[j]; }
    }
    for (int rc = gw; rc < TC; rc += ngw) { H1_LOAD(v, p.in[2] + (size_t)rc * DM); H1_MOD(4); ph_h1_row(v, gf, sh, H1 + (size_t)(T + rc) * DM, H1S + T + rc, lane); }
#undef H1_LOAD
#undef H1_MOD
}
__device__ __forceinline__ void ph_wgquant(const P& p, int bid, int nb) {
    const int lane = threadIdx.x & 63, wave = threadIdx.x >> 6, gw = bid * 8 + wave, ngw = nb * 8;
    const bf16* WG = (const bf16*)(p.ws + WS_WGU); signed char* WQ = (signed char*)(p.ws + WS_WGQ); float* WS = (float*)(p.ws + WS_WGS);
    constexpr int NROWS = 32 * 2048; const int rpw = NROWS / ngw, r0 = gw * rpw;
    uint4 va[2], vb[2], vc[2];
#define WQ_LOAD(V, r) do { const uint4* s_ = (const uint4*)(WG + (size_t)(r) * 1024) + 2 * lane; V[0] = s_[0]; V[1] = s_[1]; } while (0)
    WQ_LOAD(va, r0); WQ_LOAD(vb, r0 + 1);
    for (int k = 0; k < rpw; ++k) { if (k + 2 < rpw) WQ_LOAD(vc, r0 + k + 2);
        const unsigned w[8] = {va[0].x, va[0].y, va[0].z, va[0].w, va[1].x, va[1].y, va[1].z, va[1].w}; float f[16]; float am = 0.f;
#pragma unroll
        for (int j = 0; j < 8; ++j) { f[2 * j] = __uint_as_float(w[j] << 16); f[2 * j + 1] = __uint_as_float(w[j] & 0xffff0000u); am = fmaxf(am, fmaxf(fabsf(f[2 * j]), fabsf(f[2 * j + 1]))); }
#pragma unroll
        for (int o = 1; o < 64; o <<= 1) am = fmaxf(am, __shfl_xor(am, o));
        const float inv = am > 0.f ? 127.f / am : 0.f; unsigned o4[4];
#pragma unroll
        for (int j = 0; j < 4; ++j) { const int q0 = __float2int_rn(f[4 * j] * inv), q1 = __float2int_rn(f[4 * j + 1] * inv), q2 = __float2int_rn(f[4 * j + 2] * inv), q3 = __float2int_rn(f[4 * j + 3] * inv);
            o4[j] = (unsigned)(q0 & 255) | ((unsigned)(q1 & 255) << 8) | ((unsigned)(q2 & 255) << 16) | ((unsigned)(q3 & 255) << 24); }
        *(uint4*)(WQ + (size_t)(r0 + k) * 1024 + 16 * lane) = make_uint4(o4[0], o4[1], o4[2], o4[3]);
        if (lane == 0) WS[r0 + k] = am * (1.f / 127.f);
        va[0] = vb[0]; va[1] = vb[1]; vb[0] = vc[0]; vb[1] = vc[1]; }
#undef WQ_LOAD
}
typedef short rt_bf16x8 __attribute__((ext_vector_type(8)));
typedef float rt_f32x4 __attribute__((ext_vector_type(4)));
typedef unsigned rt_u32x4 __attribute__((ext_vector_type(4)));
typedef float rt_f32x2 __attribute__((ext_vector_type(2))); typedef __bf16 rt_bf16x2 __attribute__((ext_vector_type(2)));
__device__ __forceinline__ unsigned rt_pk(float lo, float hi) { const rt_f32x2 v = {lo, hi}; const rt_bf16x2 b = __builtin_convertvector(v, rt_bf16x2); return __builtin_bit_cast(unsigned, b); }
__device__ __forceinline__ void ph_route_a(const P& p, int bid, int nb, float* ldsf) {
    typedef __attribute__((address_space(3))) unsigned char lds_b;
    lds_b* lds = (lds_b*)ldsf;
    const int tid = threadIdx.x, lane = tid & 63, wave = tid >> 6, gw = bid * 8 + wave;
    const int rpw = 16; const int r0 = gw * rpw, b = (bid * 8 * rpw) / SEQ;
    const float* rw = p.in[24]; const float* g = p.in[7]; const float* mod = (const float*)(p.ws + WS_MOD); const bf16* XM = (const bf16*)(p.ws + WS_XM);
    signed char* H2 = (signed char*)(p.ws + WS_H2); float* H2S = (float*)(p.ws + WS_H2S); int* TOPI = (int*)(p.ws + WS_TOPI); float* TOPG = (float*)(p.ws + WS_TOPG); int* WCNT = (int*)(p.ws + WS_WCNT);
    float* ggs = ldsf + 32768 + 2048; float* shs = ggs + 1024; float* biasp = ldsf + 32768 + 512; float* red = ldsf + 32768 + 1024;
    if (bid == 0) { for (int i = tid; i < 256; i += 512) ((unsigned*)(H2 + (size_t)T * DM))[i] = 0u; if (tid == 0) H2S[T] = 0.f; }
    for (int c = tid; c < 1024; c += 512) { ggs[c] = g[c] * (1.f + mod[b * NMOD + 4096 + c]); shs[c] = mod[b * NMOD + 3072 + c]; }
    __syncthreads();
    { const int e = tid & 31, part = tid >> 5;
      float a = 0.f;
#pragma unroll 8
      for (int k = part * 64; k < part * 64 + 64; ++k) a += shs[k] * rw[k * 32 + e];
      red[part * 32 + e] = a; }
    for (int it = tid; it < 4096; it += 512) { const int e = it & 31, c = it >> 5;
        float w[8];
#pragma unroll
        for (int j = 0; j < 8; ++j) w[j] = rw[(8 * c + j) * 32 + e] * ggs[8 * c + j];
        unsigned hi[4], lo[4];
#pragma unroll
        for (int j = 0; j < 4; ++j) { hi[j] = rt_pk(w[2 * j], w[2 * j + 1]); lo[j] = rt_pk(w[2 * j] - __uint_as_float(hi[j] << 16), w[2 * j + 1] - __uint_as_float(hi[j] & 0xffff0000u)); }
        const int off = (e * 1024 + ((c ^ (e & 15)) << 3)) * 2;
        *(__attribute__((address_space(3))) rt_u32x4*)(lds + off) = (rt_u32x4){hi[0], hi[1], hi[2], hi[3]};
        *(__attribute__((address_space(3))) rt_u32x4*)(lds + 65536 + off) = (rt_u32x4){lo[0], lo[1], lo[2], lo[3]}; }
    __syncthreads();
    if (tid < 32) { float a = p.in[25][tid]; for (int q = 0; q < 16; ++q) a += red[q * 32 + tid]; biasp[tid] = a; }
    __syncthreads();
    const int r = lane & 15, kq = lane >> 4;
    const bf16* xp = XM + (size_t)(r0 + r) * DM + 8 * kq;
    rt_f32x4 acc0 = {0.f, 0.f, 0.f, 0.f}, acc1 = {0.f, 0.f, 0.f, 0.f}; float ss = 0.f;
#pragma unroll 4
    for (int ks = 0; ks < 32; ++ks) {
        const rt_u32x4 xw = *(const rt_u32x4*)(xp + 32 * ks);
#pragma unroll
        for (int j = 0; j < 4; ++j) { const float a0 = __uint_as_float(xw[j] << 16), a1 = __uint_as_float(xw[j] & 0xffff0000u); ss += a0 * a0 + a1 * a1; }
        const rt_bf16x8 Ah = __builtin_bit_cast(rt_bf16x8, xw);
        const int c = 4 * ks + kq;
        const int o0 = (r * 1024 + ((c ^ r) << 3)) * 2, o1 = ((16 + r) * 1024 + ((c ^ r) << 3)) * 2;
        const rt_bf16x8 Bh0 = *(const __attribute__((address_space(3))) rt_bf16x8*)(lds + o0), Bl0 = *(const __attribute__((address_space(3))) rt_bf16x8*)(lds + 65536 + o0);
        const rt_bf16x8 Bh1 = *(const __attribute__((address_space(3))) rt_bf16x8*)(lds + o1), Bl1 = *(const __attribute__((address_space(3))) rt_bf16x8*)(lds + 65536 + o1);
        acc0 = __builtin_amdgcn_mfma_f32_16x16x32_bf16(Ah, Bh0, acc0, 0, 0, 0); acc1 = __builtin_amdgcn_mfma_f32_16x16x32_bf16(Ah, Bh1, acc1, 0, 0, 0);
        acc0 = __builtin_amdgcn_mfma_f32_16x16x32_bf16(Ah, Bl0, acc0, 0, 0, 0); acc1 = __builtin_amdgcn_mfma_f32_16x16x32_bf16(Ah, Bl1, acc1, 0, 0, 0);
    }
    ss += __shfl_xor(ss, 16); ss += __shfl_xor(ss, 32);
    const float rs = 1.f / sqrtf(ss * (1.f / DM) + EPS);
    const int e0 = r, e1 = 16 + r; const float bp0 = biasp[e0], bp1 = biasp[e1];
    float lg0[4], lg1[4];
#pragma unroll
    for (int q = 0; q < 4; ++q) { const float rst = __shfl(rs, 4 * kq + q); lg0[q] = acc0[q] * rst + bp0; lg1[q] = acc1[q] * rst + bp1; }
    float tv[4][4]; int ti[4][4]; int cnt0 = 0, cnt1 = 0;
#pragma unroll
    for (int k = 0; k < 4; ++k) {
#pragma unroll
        for (int q = 0; q < 4; ++q) { float m = lg0[q]; int mi = e0; if (lg1[q] > m) { m = lg1[q]; mi = e1; }
#pragma unroll
            for (int off = 1; off < 16; off <<= 1) { const float om = __shfl_xor(m, off); const int oi = __shfl_xor(mi, off); if (om > m || (om == m && oi < mi)) { m = om; mi = oi; } }
            tv[k][q] = m; ti[k][q] = mi; if (mi == e0) { lg0[q] = -INFINITY; ++cnt0; } if (mi == e1) { lg1[q] = -INFINITY; ++cnt1; } } }
    if (r == 0) {
#pragma unroll
        for (int q = 0; q < 4; ++q) { const int t = r0 + 4 * kq + q; const float x1 = expf(tv[1][q] - tv[0][q]), x2 = expf(tv[2][q] - tv[0][q]), x3 = expf(tv[3][q] - tv[0][q]); const float inv = 1.f / (1.f + x1 + x2 + x3);
            *(int4*)(TOPI + t * 4) = make_int4(ti[0][q], ti[1][q], ti[2][q], ti[3][q]); *(float4*)(TOPG + t * 4) = make_float4(inv, x1 * inv, x2 * inv, x3 * inv); } }
    cnt0 += __shfl_xor(cnt0, 16); cnt0 += __shfl_xor(cnt0, 32); cnt1 += __shfl_xor(cnt1, 16); cnt1 += __shfl_xor(cnt1, 32);
    if (kq == 0) { WCNT[gw * 32 + e0] = cnt0; WCNT[gw * 32 + e1] = cnt1; }
    { float4 gf[4], sf[4]; uint2 v[4], v1[4], v2[4];
#pragma unroll
      for (int j = 0; j < 4; ++j) { gf[j] = *(const float4*)(ggs + 4 * lane + 256 * j); sf[j] = *(const float4*)(shs + 4 * lane + 256 * j); }
      const bf16* x0 = XM + (size_t)r0 * DM;
#define RT_LOAD(V, xr) do { _Pragma("unroll") for (int j = 0; j < 4; ++j) V[j] = ((const uint2*)(xr))[lane + 64 * j]; } while (0)
      RT_LOAD(v, x0); RT_LOAD(v1, x0 + DM);
      for (int k = 0; k < 16; ++k) { if (k + 2 < 16) RT_LOAD(v2, x0 + (size_t)(k + 2) * DM);
          const float rk = __shfl(rs, k); float h[4][4]; float am = 0.f;
#pragma unroll
          for (int j = 0; j < 4; ++j) { const float a0 = __uint_as_float(v[j].x << 16), a1 = __uint_as_float(v[j].x & 0xffff0000u), a2 = __uint_as_float(v[j].y << 16), a3 = __uint_as_float(v[j].y & 0xffff0000u);
              h[j][0] = a0 * rk * gf[j].x + sf[j].x; h[j][1] = a1 * rk * gf[j].y + sf[j].y; h[j][2] = a2 * rk * gf[j].z + sf[j].z; h[j][3] = a3 * rk * gf[j].w + sf[j].w;
              am = fmaxf(fmaxf(am, fmaxf(fabsf(h[j][0]), fabsf(h[j][1]))), fmaxf(fabsf(h[j][2]), fabsf(h[j][3]))); }
#pragma unroll
          for (int o = 1; o < 64; o <<= 1) am = fmaxf(am, __shfl_xor(am, o));
          const float inv = am > 0.f ? 127.f / am : 0.f;
#pragma unroll
          for (int j = 0; j < 4; ++j) { const int q0 = __float2int_rn(h[j][0] * inv), q1 = __float2int_rn(h[j][1] * inv), q2 = __float2int_rn(h[j][2] * inv), q3 = __float2int_rn(h[j][3] * inv);
              *(unsigned*)(H2 + (size_t)(r0 + k) * DM + 4 * lane + 256 * j) = (unsigned)(q0 & 255) | ((unsigned)(q1 & 255) << 8) | ((unsigned)(q2 & 255) << 16) | ((unsigned)(q3 & 255) << 24); }
          if (lane == 0) H2S[r0 + k] = am * (1.f / 127.f);
#pragma unroll
          for (int j = 0; j < 4; ++j) { v[j] = v1[j]; v1[j] = v2[j]; } }
#undef RT_LOAD
    }
    __syncthreads();
    int* li = (int*)ldsf; if (kq == 0) { li[wave * 32 + e0] = cnt0; li[wave * 32 + e1] = cnt1; }
    __syncthreads();
    if (tid < 32) { int a = 0; for (int w = 0; w < 8; ++w) a += li[w * 32 + tid]; ((int*)(p.ws + WS_BCNT))[bid * 32 + tid] = a; }
}
__device__ __forceinline__ void ph_route_b(const P& p, int bid, int nb, int* ldsI) {
    int* partT = ldsI; int* partB = ldsI + 512; int* total = ldsI + 1024; int* before = ldsI + 1056; int* pstart = ldsI + 1088;
    const int* WCNT = (const int*)(p.ws + WS_WCNT); const int* TOPI = (const int*)(p.ws + WS_TOPI); const float* TOPG = (const float*)(p.ws + WS_TOPG);
    int* SLOT_TOK = (int*)(p.ws + WS_SLOTTOK); float* SLOT_GATE = (float*)(p.ws + WS_SLOTGATE); int* TOK_SLOT = (int*)(p.ws + WS_TOKSLOT); int* TILE_E = (int*)(p.ws + WS_TILE);
    const float* H2S = (const float*)(p.ws + WS_H2S); float* SLOT_SA = (float*)(p.ws + WS_SLOTSA);
    const int t = threadIdx.x, e = t & 31, part = t >> 5, gw0 = bid * 8, nwav = nb * 8, per = nb / 16;
    const int* BCNT = (const int*)(p.ws + WS_BCNT);
    int sT = 0, sB = 0;
    { int c[16];
#pragma unroll
      for (int q = 0; q < 16; ++q) c[q] = (q < per) ? BCNT[(part * per + q) * 32 + e] : 0;
#pragma unroll
      for (int q = 0; q < 16; ++q) { sT += c[q]; if (part * per + q < bid) sB += c[q]; } }
    partT[part * 32 + e] = sT; partB[part * 32 + e] = sB;
    __syncthreads();
    if (t < 32) { int a = 0, bsum = 0; for (int q = 0; q < 16; ++q) { a += partT[q * 32 + t]; bsum += partB[q * 32 + t]; } total[t] = a; before[t] = bsum; }
    __syncthreads();
    if (t == 0) { int acc = 0; for (int q = 0; q < 32; ++q) { pstart[q] = acc; acc += ((total[q] + 255) / 256) * 256; } pstart[32] = acc; }
    __syncthreads();
    const int lane = t & 63, wave = t >> 6, my_e = (lane >> 1) & 31, rpw = T / nwav;
    int base = pstart[my_e] + before[my_e];
    for (int w = 0; w < wave; ++w) base += WCNT[(gw0 + w) * 32 + my_e];
    int run = 0;
    const int rb0 = (gw0 + wave) * rpw;
    for (int r8 = 0; r8 < rpw; r8 += 8) { int4 tiv[8]; float4 tgv[8]; float sav[8];
#pragma unroll
        for (int q = 0; q < 8; ++q) { tiv[q] = *(const int4*)(TOPI + (rb0 + r8 + q) * 4); tgv[q] = *(const float4*)(TOPG + (rb0 + r8 + q) * 4); sav[q] = H2S[rb0 + r8 + q]; }
#pragma unroll
        for (int q = 0; q < 8; ++q) { const int r = rb0 + r8 + q;
            const int tia[4] = {tiv[q].x, tiv[q].y, tiv[q].z, tiv[q].w}; const float tga[4] = {tgv[q].x, tgv[q].y, tgv[q].z, tgv[q].w}; int sl[4];
#pragma unroll
            for (int k = 0; k < 4; ++k) { const int ek = tia[k]; sl[k] = __shfl(base + run, 2 * ek); if (my_e == ek) run++; }
            if (lane == 0) { SLOT_TOK[sl[0]] = r; SLOT_TOK[sl[1]] = r; SLOT_TOK[sl[2]] = r; SLOT_TOK[sl[3]] = r;
                SLOT_GATE[sl[0]] = tga[0]; SLOT_GATE[sl[1]] = tga[1]; SLOT_GATE[sl[2]] = tga[2]; SLOT_GATE[sl[3]] = tga[3]; *(int4*)(TOK_SLOT + r * 4) = make_int4(sl[0], sl[1], sl[2], sl[3]);
                SLOT_SA[sl[0]] = sav[q]; SLOT_SA[sl[1]] = sav[q]; SLOT_SA[sl[2]] = sav[q]; SLOT_SA[sl[3]] = sav[q]; } }
    }
    if (bid == 0) {
        for (int q = wave; q < 32; q += 8) { const int ps = pstart[q], pe = pstart[q + 1];
            for (int s = ps + total[q] + lane; s < pe; s += 64) { SLOT_TOK[s] = T; SLOT_GATE[s] = 0.f; SLOT_SA[s] = 0.f; }
            for (int tl = ps / 256 + lane; tl < pe / 256; tl += 64) TILE_E[tl] = q; }
        if (t == 0) TILE_E[1023] = pstart[32] / 256;
    }
}
__device__ __forceinline__ void ph_final(const P& p, int bid, int nb) {
    const int lane = threadIdx.x & 63, wave = threadIdx.x >> 6, gw = bid * 8 + wave, ngw = nb * 8;
    const float* gfin = p.in[30]; const float* mod = (const float*)(p.ws + WS_MOD); const bf16* XM = (const bf16*)(p.ws + WS_XM);
    const bf16* YB = (const bf16*)(p.ws + WS_YB); const int* TOK_SLOT = (const int*)(p.ws + WS_TOKSLOT);
    float4 gf[4];
#pragma unroll
    for (int j = 0; j < 4; ++j) gf[j] = *(const float4*)(gfin + 4 * lane + 256 * j);
    uint2 yc[4][4], yn[4][4]; uint2 xc[4], xn[4]; int4 sl1, sl2;
#define FIN_LOAD(Y, X, SL, R) do { const int sla_[4] = {SL.x, SL.y, SL.z, SL.w}; _Pragma("unroll") for (int j = 0; j < 4; ++j) { const int col = 4 * lane + 256 * j; \
        X[j] = *(const uint2*)(XM + (size_t)(R) * DM + col); _Pragma("unroll") for (int k = 0; k < 4; ++k) Y[k][j] = *(const uint2*)(YB + (size_t)sla_[k] * DM + col); } } while (0)
    int r = gw;
    sl1 = *(const int4*)(TOK_SLOT + r * 4);
    FIN_LOAD(yc, xc, sl1, r);
    if (r + ngw < T) sl1 = *(const int4*)(TOK_SLOT + (r + ngw) * 4);
    for (; r < T; r += ngw) {
        const int rn = r + ngw, rnn = rn + ngw;
        if (rnn < T) sl2 = *(const int4*)(TOK_SLOT + rnn * 4);
        if (rn < T) FIN_LOAD(yn, xn, sl1, rn);
        const int b = r / SEQ; float4 v[4]; float ss = 0.f;
#pragma unroll
        for (int j = 0; j < 4; ++j) { const int col = 4 * lane + 256 * j; float f0 = 0.f, f1 = 0.f, f2 = 0.f, f3 = 0.f;
#pragma unroll
            for (int k = 0; k < 4; ++k) { const uint2 y = yc[k][j];
                f0 += __uint_as_float(y.x << 16); f1 += __uint_as_float(y.x & 0xffff0000u); f2 += __uint_as_float(y.y << 16); f3 += __uint_as_float(y.y & 0xffff0000u); }
            const float4 g2 = *(const float4*)(mod + b * NMOD + 5120 + col);
            v[j].x = __uint_as_float(xc[j].x << 16) + g2.x * f0; v[j].y = __uint_as_float(xc[j].x & 0xffff0000u) + g2.y * f1; v[j].z = __uint_as_float(xc[j].y << 16) + g2.z * f2; v[j].w = __uint_as_float(xc[j].y & 0xffff0000u) + g2.w * f3;
            ss += v[j].x * v[j].x + v[j].y * v[j].y + v[j].z * v[j].z + v[j].w * v[j].w; }
        ss = wave_sum(ss); const float rs = 1.f / sqrtf(ss * (1.f / DM) + EPS);
#pragma unroll
        for (int j = 0; j < 4; ++j) { const int col = 4 * lane + 256 * j;
            *(float4*)(p.out + (size_t)r * DM + col) = make_float4(v[j].x * rs * gf[j].x, v[j].y * rs * gf[j].y, v[j].z * rs * gf[j].z, v[j].w * rs * gf[j].w); }
#pragma unroll
        for (int j = 0; j < 4; ++j) { xc[j] = xn[j];
#pragma unroll
            for (int k = 0; k < 4; ++k) yc[k][j] = yn[k][j]; }
        sl1 = sl2;
    }
#undef FIN_LOAD
}

namespace pg8 {
#define PG8_LAS __attribute__((address_space(3)))
typedef unsigned short bf16_t;
typedef short bf16x8 __attribute__((ext_vector_type(8)));
typedef float f32x4 __attribute__((ext_vector_type(4)));
typedef unsigned u32x4 __attribute__((ext_vector_type(4)));
typedef int i32x4 __attribute__((ext_vector_type(4)));
typedef unsigned u32x2 __attribute__((ext_vector_type(2)));
template <bool I8> struct AccT { typedef f32x4 type; }; template <> struct AccT<true> { typedef i32x4 type; };
constexpr int BM = 256, BK = 64, HALF = 128, HTB = HALF * BK * 2  , STAGE_BYTES = 8 * HTB, NXCD = 8, WGM = 8;

__host__ __device__ __forceinline__ int lds_byte(int r, int c) { const int st = (r >> 4) * 2 + (c >> 5), rr = r & 15, cc = c & 31, ob = rr * 64 + cc * 2; return st * 1024 + (ob ^ (((ob >> 9) & 1) << 5)); }
__host__ __device__ __forceinline__ void stage_rc(int b, int& R, int& C) { const int st = b / 1024, sb = b % 1024, swz = sb ^ (((sb >> 9) & 1) << 5); R = (st >> 1) * 16 + swz / 64; C = (st & 1) * 32 + (swz % 64) / 2; }
__host__ __device__ __forceinline__ int perm32(int rho) { const int n = rho >> 4, i = rho & 15; return 8 * (i >> 2) + 4 * n + (i & 3); }

struct Unit { int pm, pn; };
struct GemmG { const char* A; const char* Bt; size_t a_kstep, a_hstep, a_tstep; int ldb; int K; const int* gidx; unsigned g_row; };
struct AoRow { int lda; __device__ __forceinline__ unsigned operator()(int R, int C) const { return (unsigned)(R * lda + C) * 2u; } };
struct AoGrp { __device__ __forceinline__ unsigned operator()(int R, int C) const { return (unsigned)(((C >> 4) * T + R) * 16 + (C & 15)) * 2u; } };

struct StaticOrder {
    int nM, nN, nwg, G, c;
    __host__ __device__ void init(int M, int N, int G_, int c_) { nM = M / BM; nN = N / BM; nwg = nM * nN; G = G_; c = c_; }
    __host__ __device__ bool next(int i, Unit& u) const {
        const long L = (long)i * G + c; if (L >= nwg) return false;
        int wgid = (int)L; { const int q = nwg / NXCD, r = nwg % NXCD, xcd = wgid % NXCD, off = wgid / NXCD; wgid = (xcd < r ? xcd * (q + 1) : r * (q + 1) + (xcd - r) * q) + off; }
        const int nig = WGM * nN, gid = wgid / nig, fm = gid * WGM, gsz = (nM - fm) < WGM ? (nM - fm) : WGM;
        u.pm = fm + ((wgid % nig) % gsz); u.pn = (wgid % nig) / gsz; return true;
    }
};
typedef float f32x2_t __attribute__((ext_vector_type(2))); typedef __bf16 bf16x2_t __attribute__((ext_vector_type(2)));
__device__ __forceinline__ unsigned cvt_pk_bf16(float lo, float hi) { const f32x2_t v = {lo, hi}; const bf16x2_t b = __builtin_convertvector(v, bf16x2_t); return __builtin_bit_cast(unsigned, b); }
__device__ __forceinline__ u32x4 pack8(const f32x4 a, const f32x4 b) { u32x4 w; w.x = cvt_pk_bf16(a[0], a[1]); w.y = cvt_pk_bf16(a[2], a[3]); w.z = cvt_pk_bf16(b[0], b[1]); w.w = cvt_pk_bf16(b[2], b[3]); return w; }
__device__ __forceinline__ f32x4 unpack_lo(const u32x4 w) { return (f32x4){__uint_as_float(w.x << 16), __uint_as_float(w.x & 0xffff0000u), __uint_as_float(w.y << 16), __uint_as_float(w.y & 0xffff0000u)}; }
__device__ __forceinline__ f32x4 unpack_hi(const u32x4 w) { return (f32x4){__uint_as_float(w.z << 16), __uint_as_float(w.z & 0xffff0000u), __uint_as_float(w.w << 16), __uint_as_float(w.w & 0xffff0000u)}; }
__device__ __forceinline__ float fsig(float v) { return __builtin_amdgcn_rcpf(1.f + __builtin_amdgcn_exp2f(-1.4426950408889634f * v)); }
__device__ __forceinline__ f32x4 fsig4(const f32x4 v) { return (f32x4){fsig(v[0]), fsig(v[1]), fsig(v[2]), fsig(v[3])}; }

template <class Epi, class Sched, class AO, bool GATHER = false, bool ALIGN_EPI = true, bool I8 = false>
__device__ __forceinline__ void gemm_phase(PG8_LAS unsigned char* lds, const GemmG g, const AO& ao, const Sched& S, const Epi& E) {
    const int tid = threadIdx.x, wid = __builtin_amdgcn_readfirstlane(tid >> 6), lane = tid & 63, wr = wid >> 2, wc = wid & 3, fr = lane & 15, fq = lane >> 4;
    const int K = g.K, nt = K / BK;
    unsigned voffB[2]; unsigned oc[2][2], on[2][2]; int RA[2]; unsigned CA2[2];
#pragma unroll
    for (int i = 0; i < 2; ++i) { int R, C; stage_rc(tid * 16 + i * 8192, R, C); const int Rb = (R & ~31) + perm32(R & 31);
        voffB[i] = (unsigned)(Rb * g.ldb + C) * 2u; RA[i] = R; CA2[i] = (unsigned)C * 2u;
        if constexpr (!GATHER) { oc[0][i] = ao(R, C); oc[1][i] = oc[0][i] + (unsigned)g.a_hstep; on[0][i] = oc[0][i]; on[1][i] = oc[1][i]; } }
    const size_t kstepA = g.a_kstep, kstepB = (size_t)(BK * 2);
    const size_t hstepB = (size_t)HALF * g.ldb * 2, tstepB = 2 * hstepB;
    const unsigned ldsw = (unsigned)wid * 1024u;
    const int aoff = lds_byte(wr * 64 + fr, fq * 8), boff = lds_byte(wc * 32 + fr, fq * 8);
#define PG8_SA(b, h) (((b) * 2 + (h)) * HTB)
#define PG8_SB(b, h) ((4 + (b) * 2 + (h)) * HTB)
#define PG8_STAGE_B(bufoff, gbase) do { _Pragma("unroll") for (int _i = 0; _i < 2; ++_i) \
        __builtin_amdgcn_global_load_lds((const unsigned*)((const char*)(gbase) + voffB[_i]), (PG8_LAS unsigned*)(lds + (bufoff) + ldsw + _i * 8192), 16, 0, 0); } while (0)
#define PG8_STAGE_A(bufoff, gbase, OFFS, h) do { _Pragma("unroll") for (int _i = 0; _i < 2; ++_i) \
        __builtin_amdgcn_global_load_lds((const unsigned*)((const char*)(gbase) + OFFS[h][_i]), (PG8_LAS unsigned*)(lds + (bufoff) + ldsw + _i * 8192), 16, 0, 0); } while (0)
#define PG8_LDA(dst, b, h) do { _Pragma("unroll") for (int m = 0; m < 4; ++m) _Pragma("unroll") for (int k = 0; k < 2; ++k) dst[m][k] = *(const PG8_LAS bf16x8*)(lds + PG8_SA(b, h) + aoff + m * 2048 + k * 1024); } while (0)
#define PG8_LDB(dst, b, h) do { _Pragma("unroll") for (int n = 0; n < 2; ++n) _Pragma("unroll") for (int k = 0; k < 2; ++k) dst[n][k] = *(const PG8_LAS bf16x8*)(lds + PG8_SB(b, h) + boff + n * 2048 + k * 1024); } while (0)
#define PG8_MMA(ai, bj, At, Bt) do { __builtin_amdgcn_s_setprio(1); _Pragma("unroll") for (int m = 0; m < 4; ++m) _Pragma("unroll") for (int n = 0; n < 2; ++n) _Pragma("unroll") for (int k = 0; k < 2; ++k) { \
        if constexpr (I8) acc[ai][bj][m][n] = __builtin_bit_cast(acc_t, __builtin_amdgcn_mfma_i32_16x16x64_i8(__builtin_bit_cast(i32x4, Bt[n][k]), __builtin_bit_cast(i32x4, At[m][k]), __builtin_bit_cast(i32x4, acc[ai][bj][m][n]), 0, 0, 0)); \
        else acc[ai][bj][m][n] = __builtin_bit_cast(acc_t, __builtin_amdgcn_mfma_f32_16x16x32_bf16(Bt[n][k], At[m][k], __builtin_bit_cast(f32x4, acc[ai][bj][m][n]), 0, 0, 0)); } __builtin_amdgcn_s_setprio(0); } while (0)
#define PG8_WAIT_V(n) asm volatile("s_waitcnt vmcnt(" #n ")" ::: "memory")
#define PG8_WAIT_L(n) asm volatile("s_waitcnt lgkmcnt(" #n ")" ::: "memory")
#define PG8_BAR __builtin_amdgcn_s_barrier()
#define PG8_SCHED __builtin_amdgcn_sched_barrier(0)
#define PG8_GIDX(dst, u) do { _Pragma("unroll") for (int _h = 0; _h < 2; ++_h) _Pragma("unroll") for (int _i = 0; _i < 2; ++_i) \
        dst[_h][_i] = (unsigned)g.gidx[(u).pm * BM + _h * HALF + RA[_i]] * g.g_row + CA2[_i]; } while (0)
    Unit cur, nxt; int ui = 0;
    if (!S.next(0, cur)) return;
    typedef typename AccT<I8>::type acc_t;
    acc_t acc[2][2][4][2];
#pragma unroll
    for (int a = 0; a < 2; ++a)
#pragma unroll
        for (int b = 0; b < 2; ++b)
#pragma unroll
            for (int m = 0; m < 4; ++m)
#pragma unroll
                for (int n = 0; n < 2; ++n) acc[a][b][m][n] = (acc_t){0, 0, 0, 0};
    bf16x8 At[4][2], B0[2][2], B1[2][2];
    if constexpr (GATHER) { PG8_GIDX(oc, cur); }
    const char* cA = GATHER ? g.A : g.A + (size_t)cur.pm * g.a_tstep; const char* cB = g.Bt + (size_t)cur.pn * tstepB;
    PG8_STAGE_B(PG8_SB(0, 0), cB); PG8_STAGE_B(PG8_SB(0, 1), cB + hstepB); PG8_STAGE_A(PG8_SA(0, 0), cA, oc, 0); PG8_STAGE_A(PG8_SA(0, 1), cA, oc, 1);
    if (wr == 1) PG8_BAR;
    PG8_WAIT_V(2); PG8_BAR;
    PG8_STAGE_B(PG8_SB(1, 0), cB + kstepB); PG8_STAGE_A(PG8_SA(1, 0), cA + kstepA, oc, 0); PG8_STAGE_B(PG8_SB(1, 1), cB + hstepB + kstepB);
    PG8_WAIT_V(6); PG8_BAR;
    for (;;) {
        const bool has_next = S.next(ui + 1, nxt);
        if constexpr (GATHER) { if (has_next) { PG8_GIDX(on, nxt); } else {
#pragma unroll
            for (int _h = 0; _h < 2; ++_h)
#pragma unroll
                for (int _i = 0; _i < 2; ++_i) on[_h][_i] = oc[_h][_i]; } }
        const char* nA = GATHER ? g.A : (has_next ? g.A + (size_t)nxt.pm * g.a_tstep : cA); const char* nB = has_next ? g.Bt + (size_t)nxt.pn * tstepB : cB;
#pragma unroll 1
        for (int t = 0; t < nt; t += 2) {
            const bool last = (t == nt - 2);
            const char* a1 = cA + (size_t)(t + 1) * kstepA;
            const char* a2 = last ? nA : cA + (size_t)(t + 2) * kstepA; const char* b2 = last ? nB : cB + (size_t)(t + 2) * kstepB;
            const char* a3 = a2 + kstepA; const char* b3 = b2 + kstepB;
            unsigned o2[2][2];
#pragma unroll
            for (int _h = 0; _h < 2; ++_h)
#pragma unroll
                for (int _i = 0; _i < 2; ++_i) o2[_h][_i] = (GATHER && last) ? on[_h][_i] : oc[_h][_i];
            PG8_LDB(B0, 0, 0); PG8_LDB(B1, 0, 1); PG8_SCHED; PG8_LDA(At, 0, 0); PG8_STAGE_A(PG8_SA(1, 1), a1, oc, 1);
            PG8_WAIT_V(8); PG8_WAIT_L(0); PG8_BAR; PG8_MMA(0, 0, At, B0); PG8_MMA(0, 1, At, B1); PG8_BAR; PG8_SCHED;
            PG8_LDA(At, 0, 1); PG8_STAGE_B(PG8_SB(0, 0), b2); PG8_STAGE_B(PG8_SB(0, 1), b2 + hstepB); PG8_STAGE_A(PG8_SA(0, 0), a2, o2, 0);
            PG8_WAIT_V(8); PG8_WAIT_L(0); PG8_BAR; PG8_MMA(1, 0, At, B0); PG8_MMA(1, 1, At, B1); PG8_BAR; PG8_SCHED;
            PG8_LDB(B0, 1, 0); PG8_LDB(B1, 1, 1); PG8_SCHED; PG8_LDA(At, 1, 0); PG8_STAGE_A(PG8_SA(0, 1), a2, o2, 1);
            PG8_WAIT_V(8); PG8_WAIT_L(0); PG8_BAR; PG8_MMA(0, 0, At, B0); PG8_MMA(0, 1, At, B1); PG8_BAR; PG8_SCHED;
            PG8_LDA(At, 1, 1); PG8_STAGE_B(PG8_SB(1, 0), b3); PG8_STAGE_B(PG8_SB(1, 1), b3 + hstepB); PG8_STAGE_A(PG8_SA(1, 0), a3, o2, 0);
            PG8_WAIT_V(8); PG8_WAIT_L(0); PG8_BAR; PG8_MMA(1, 0, At, B0); PG8_MMA(1, 1, At, B1); PG8_BAR; PG8_SCHED;
        }
        if constexpr (ALIGN_EPI) { if (wr == 0) PG8_BAR; }
        E(acc, cur, wr, wc, fr, fq);
        if (!has_next) break;
#pragma unroll
        for (int a = 0; a < 2; ++a)
#pragma unroll
            for (int b = 0; b < 2; ++b)
#pragma unroll
                for (int m = 0; m < 4; ++m)
#pragma unroll
                    for (int n = 0; n < 2; ++n) acc[a][b][m][n] = (acc_t){0, 0, 0, 0};
        cur = nxt; cA = nA; cB = nB; ++ui;
#pragma unroll
        for (int _h = 0; _h < 2; ++_h)
#pragma unroll
            for (int _i = 0; _i < 2; ++_i) oc[_h][_i] = on[_h][_i];
        if constexpr (ALIGN_EPI) { if (wr == 1) PG8_BAR; }
    }
    PG8_WAIT_V(0);
    if constexpr (!ALIGN_EPI) { if (wr == 0) PG8_BAR; }
    PG8_BAR;
#undef PG8_SA
#undef PG8_SB
#undef PG8_STAGE_A
#undef PG8_STAGE_B
#undef PG8_LDA
#undef PG8_LDB
#undef PG8_MMA
#undef PG8_WAIT_V
#undef PG8_WAIT_L
#undef PG8_BAR
#undef PG8_SCHED
#undef PG8_GIDX
}

#define EPI_ROWS(ai, m) (u.pm * BM + (ai) * HALF + wr * 64 + (m) * 16 + fr)
struct EpiProj {
    bf16_t* UH; bf16_t* KB; bf16_t* VB; bf16_t* QB; unsigned char* GT; const float* qg; const float* kg; const float* rope; const float* sa; const float* sb;
    __device__ __forceinline__ void operator()(const i32x4 (&acci)[2][2][4][2], const Unit& u, int wr, int wc, int fr, int fq) const {
        asm volatile("" : "+v"(fr), "+v"(fq));
        const int pn = u.pn;
        const float* sbp = sb + pn * BM + wc * 32 + 8 * fq;
#define ACCF(ai, bj, m, n) (__builtin_convertvector(acci[ai][bj][m][n], f32x4) * (*(const f32x4*)(sbp + (bj) * HALF + 4 * (n)) * sa_r))
        if (pn < 2) {
#pragma unroll
            for (int ai = 0; ai < 2; ++ai)
#pragma unroll
                for (int m = 0; m < 4; ++m) { const int row = EPI_ROWS(ai, m); const float sa_r = sa[row];
#pragma unroll
                    for (int bj = 0; bj < 2; ++bj) { const int c0 = pn * 256 + bj * 128 + wc * 32 + 8 * fq;
                        *(u32x4*)(UH + ((size_t)(c0 >> 4) * NCHUNK_PAD + (row >> 4)) * 512 + (row & 15) * 16 + (c0 & 15)) = pack8(ACCF(ai, bj, m, 0), ACCF(ai, bj, m, 1)); } }
        } else if (pn < 5) {
            const bool isq = pn >= 3, isv = (pn == 2) && (wc >= 2), lat = u.pm < (T / BM);
            const float* gn = isq ? qg : kg;
            const float osc = isq ? C2 : 1.f;
#pragma unroll
            for (int ai = 0; ai < 2; ++ai)
#pragma unroll
                for (int m = 0; m < 4; ++m) { const int row = EPI_ROWS(ai, m); const float sa_r = sa[row];
                    int b, spos; if (lat) { b = row >> 13; spos = LC + (row & (SEQ - 1)); } else { const int rr = row - T; b = rr >> 8; spos = rr & (LC - 1); }
                    if (isv) {
                        bf16_t* o = VB + ((size_t)(b * 2 + (wc - 2)) * SKV + spos) * 64 + 8 * fq;
#pragma unroll
                        for (int bj = 0; bj < 2; ++bj) *(u32x4*)(o + 32 * bj) = pack8(ACCF(ai, bj, m, 0), ACCF(ai, bj, m, 1));
                    } else {
                        float ss = 0.f;
#pragma unroll
                        for (int bj = 0; bj < 2; ++bj)
#pragma unroll
                            for (int n = 0; n < 2; ++n) { const f32x4 x = ACCF(ai, bj, m, n); ss += (x[0] * x[0] + x[1] * x[1]) + (x[2] * x[2] + x[3] * x[3]); }
                        ss += __shfl_xor(ss, 16); ss += __shfl_xor(ss, 32);
                        const float rs = osc / sqrtf(ss * (1.f / 64.f) + EPS);
                        bf16_t* o = isq ? QB + (size_t)row * 512 + (4 * (pn - 3) + wc) * 64 + 8 * fq : KB + ((size_t)(b * 2 + wc) * SKV + spos) * 64 + 8 * fq;
                        const int t = row & (SEQ - 1), rid = t >> 6, cid = t & 63;
#pragma unroll
                        for (int bj = 0; bj < 2; ++bj) {
                            const f32x4 gv0 = *(const f32x4*)(gn + 32 * bj + 8 * fq), gv1 = *(const f32x4*)(gn + 32 * bj + 8 * fq + 4);
                            f32x4 y0 = ACCF(ai, bj, m, 0) * gv0 * rs, y1 = ACCF(ai, bj, m, 1) * gv1 * rs;
                            if (lat) { const float* rp = rope + (bj == 0 ? rid * 16 : 4096 + cid * 16) + 4 * fq; const f32x4 cs = *(const f32x4*)rp, sn = *(const f32x4*)(rp + (bj == 0 ? 2048 : 1024));
                                const f32x4 z0 = (f32x4){y0[0] * cs[0] - y0[1] * sn[0], y0[0] * sn[0] + y0[1] * cs[0], y0[2] * cs[1] - y0[3] * sn[1], y0[2] * sn[1] + y0[3] * cs[1]};
                                const f32x4 z1 = (f32x4){y1[0] * cs[2] - y1[1] * sn[2], y1[0] * sn[2] + y1[1] * cs[2], y1[2] * cs[3] - y1[3] * sn[3], y1[2] * sn[3] + y1[3] * cs[3]};
                                y0 = z0; y1 = z1; }
                            *(u32x4*)(o + 32 * bj) = pack8(y0, y1); }
                    } }
        } else {
#pragma unroll
            for (int ai = 0; ai < 2; ++ai)
#pragma unroll
                for (int m = 0; m < 4; ++m) { const int row = EPI_ROWS(ai, m); const float sa_r = sa[row];
#pragma unroll
                    for (int bj = 0; bj < 2; ++bj)
                        { const f32x4 s0 = fsig4(ACCF(ai, bj, m, 0)) * 255.f, s1 = fsig4(ACCF(ai, bj, m, 1)) * 255.f;
                          u32x2 w; w.x = (unsigned)__float2int_rn(s0[0]) | ((unsigned)__float2int_rn(s0[1]) << 8) | ((unsigned)__float2int_rn(s0[2]) << 16) | ((unsigned)__float2int_rn(s0[3]) << 24);
                          w.y = (unsigned)__float2int_rn(s1[0]) | ((unsigned)__float2int_rn(s1[1]) << 8) | ((unsigned)__float2int_rn(s1[2]) << 16) | ((unsigned)__float2int_rn(s1[3]) << 24);
                          *(u32x2*)(GT + (size_t)row * 2048 + (pn - 5) * 256 + bj * 128 + wc * 32 + 8 * fq) = w; } }
        }
    }
#undef ACCF
};
struct EpiGlu {
    const bf16_t* SG; const float* bias; bf16_t* GO;
    __device__ __forceinline__ void operator()(const f32x4 (&acc)[2][2][4][2], const Unit& u, int wr, int wc, int fr, int fq) const {
#pragma unroll
        for (int bj = 0; bj < 2; ++bj) { const int c0 = u.pn * BM + bj * HALF + wc * 32 + 8 * fq;
            const f32x4 b0 = *(const f32x4*)(bias + c0), b1 = *(const f32x4*)(bias + c0 + 4);
#pragma unroll
            for (int ai = 0; ai < 2; ++ai)
#pragma unroll
                for (int m = 0; m < 4; ++m) { const int row = EPI_ROWS(ai, m);
                    const u32x4 sw = *(const u32x4*)(SG + ((size_t)(c0 >> 4) * T + row) * 16 + (c0 & 15));
                    const f32x4 s0 = unpack_lo(sw), s1 = unpack_hi(sw);
                    *(u32x4*)(GO + (size_t)row * 1024 + c0) = pack8(s0 * fsig4(acc[ai][bj][m][0] + b0), s1 * fsig4(acc[ai][bj][m][1] + b1)); } }
    }
};
template <int MODE> struct EpiMerge {
    const unsigned char* GT; bf16_t* M1; bf16_t* MG;
    __device__ __forceinline__ void operator()(const f32x4 (&acc)[2][2][4][2], const Unit& u, int wr, int wc, int fr, int fq) const {
#pragma unroll
        for (int ai = 0; ai < 2; ++ai)
#pragma unroll
            for (int m = 0; m < 4; ++m) { const int row = EPI_ROWS(ai, m);
#pragma unroll
                for (int bj = 0; bj < 2; ++bj) { const int c0 = u.pn * BM + bj * HALF + wc * 32 + 8 * fq;
                    const u32x2 gw = *(const u32x2*)(GT + (size_t)row * 2048 + MODE * 1024 + c0);
                    const f32x4 g0 = (f32x4){(float)(gw.x & 255u), (float)((gw.x >> 8) & 255u), (float)((gw.x >> 16) & 255u), (float)(gw.x >> 24)} * (1.f / 255.f);
                    const f32x4 g1 = (f32x4){(float)(gw.y & 255u), (float)((gw.y >> 8) & 255u), (float)((gw.y >> 16) & 255u), (float)(gw.y >> 24)} * (1.f / 255.f);
                    const f32x4 v0 = g0 * acc[ai][bj][m][0], v1 = g1 * acc[ai][bj][m][1];
                    bf16_t* mp = M1 + (size_t)row * 1024 + c0;
                    if (MODE == 0) { *(u32x4*)mp = pack8(v0, v1); }
                    else { const u32x4 aw = *(const u32x4*)mp; *(u32x4*)(MG + (size_t)row * 1024 + c0) = pack8(unpack_lo(aw) + v0, unpack_hi(aw) + v1); } } }
    }
};
struct EpiOut {
    const float* x; const float* mod; bf16_t* XM;
    __device__ __forceinline__ void operator()(const f32x4 (&acc)[2][2][4][2], const Unit& u, int wr, int wc, int fr, int fq) const {
        const int b = (u.pm * BM) / SEQ;
#pragma unroll
        for (int bj = 0; bj < 2; ++bj) { const int c0 = u.pn * BM + bj * HALF + wc * 32 + 8 * fq;
            const f32x4 g0 = *(const f32x4*)(mod + b * NMOD + 2048 + c0), g1 = *(const f32x4*)(mod + b * NMOD + 2048 + c0 + 4);
#pragma unroll
            for (int ai = 0; ai < 2; ++ai)
#pragma unroll
                for (int m = 0; m < 4; ++m) { const size_t off = (size_t)EPI_ROWS(ai, m) * 1024 + c0;
                    const f32x4 x0 = *(const f32x4*)(x + off), x1 = *(const f32x4*)(x + off + 4);
                    *(u32x4*)(XM + off) = pack8(x0 + g0 * acc[ai][bj][m][0], x1 + g1 * acc[ai][bj][m][1]); } }
    }
};
struct EpiGU {
    const float* bgu; bf16_t* ACT;
    __device__ __forceinline__ void operator()(const f32x4 (&acc)[2][2][4][2], const Unit& u, int wr, int wc, int fr, int fq) const {
        const int e = u.pn >> 3, jc = (u.pn & 7) * 128 + wc * 32 + 8 * fq; const float* bp = bgu + e * 2048 + jc;
        const f32x4 bg0 = *(const f32x4*)bp, bg1 = *(const f32x4*)(bp + 4), bu0 = *(const f32x4*)(bp + 1024), bu1 = *(const f32x4*)(bp + 1028);
#pragma unroll
        for (int ai = 0; ai < 2; ++ai)
#pragma unroll
            for (int m = 0; m < 4; ++m) { const int row = EPI_ROWS(ai, m); f32x4 o[2];
#pragma unroll
                for (int n = 0; n < 2; ++n) { const f32x4 gt = acc[ai][0][m][n] + (n ? bg1 : bg0), up = acc[ai][1][m][n] + (n ? bu1 : bu0);
#pragma unroll
                    for (int j = 0; j < 4; ++j) { const float gq = fminf(gt[j], 7.f), uq = fminf(fmaxf(up[j], -7.f), 7.f); o[n][j] = (uq + 1.f) * (gq * fsig(1.702f * gq)); } }
                *(u32x4*)(ACT + (size_t)row * 1024 + jc) = pack8(o[0], o[1]); }
    }
};
struct EpiGU8 {
    const float* bgu; const float* sa; const float* sb; bf16_t* ACT;
    __device__ __forceinline__ void operator()(const i32x4 (&acc)[2][2][4][2], const Unit& u, int wr, int wc, int fr, int fq) const {
        const int e = u.pn >> 3, jl = wc * 32 + 8 * fq, jc = (u.pn & 7) * 128 + jl; const float* bp = bgu + e * 2048 + jc; const float* sp = sb + e * 2048 + (u.pn & 7) * 256 + jl;
        const f32x4 bg0 = *(const f32x4*)bp, bg1 = *(const f32x4*)(bp + 4), bu0 = *(const f32x4*)(bp + 1024), bu1 = *(const f32x4*)(bp + 1028);
        const f32x4 sg0 = *(const f32x4*)sp, sg1 = *(const f32x4*)(sp + 4), su0 = *(const f32x4*)(sp + 128), su1 = *(const f32x4*)(sp + 132);
        float sr[2][4];
#pragma unroll
        for (int ai = 0; ai < 2; ++ai)
#pragma unroll
            for (int m = 0; m < 4; ++m) sr[ai][m] = sa[EPI_ROWS(ai, m)];
#pragma unroll
        for (int ai = 0; ai < 2; ++ai)
#pragma unroll
            for (int m = 0; m < 4; ++m) { const int row = EPI_ROWS(ai, m); f32x4 o[2];
#pragma unroll
                for (int n = 0; n < 2; ++n) { const f32x4 sg = (n ? sg1 : sg0) * sr[ai][m], su = (n ? su1 : su0) * sr[ai][m];
#pragma unroll
                    for (int j = 0; j < 4; ++j) { const float gt = (float)acc[ai][0][m][n][j] * sg[j] + (n ? bg1 : bg0)[j], up = (float)acc[ai][1][m][n][j] * su[j] + (n ? bu1 : bu0)[j];
                        const float gq = fminf(gt, 7.f), uq = fminf(fmaxf(up, -7.f), 7.f); o[n][j] = (uq + 1.f) * (gq * fsig(1.702f * gq)); } }
                *(u32x4*)(ACT + (size_t)row * 1024 + jc) = pack8(o[0], o[1]); }
    }
};
struct EpiDown {
    const float* bd; const float* sgate; bf16_t* YB;
    __device__ __forceinline__ void operator()(const f32x4 (&acc)[2][2][4][2], const Unit& u, int wr, int wc, int fr, int fq) const {
        const int e = u.pn >> 2;
#pragma unroll
        for (int ai = 0; ai < 2; ++ai)
#pragma unroll
            for (int m = 0; m < 4; ++m) { const int row = EPI_ROWS(ai, m); const float gt = sgate[row];
#pragma unroll
                for (int bj = 0; bj < 2; ++bj) { const int c0 = (u.pn & 3) * BM + bj * HALF + wc * 32 + 8 * fq; const float* bp = bd + e * 1024 + c0;
                    const f32x4 b0 = *(const f32x4*)bp, b1 = *(const f32x4*)(bp + 4);
                    *(u32x4*)(YB + (size_t)row * 1024 + c0) = pack8((acc[ai][bj][m][0] + b0) * gt, (acc[ai][bj][m][1] + b1) * gt); } }
    }
};
struct EpiSloc {
    bf16_t* SL;
    __device__ __forceinline__ void operator()(const f32x4 (&acc)[2][2][4][2], const Unit& u, int wr, int wc, int fr, int fq) const {
#pragma unroll
        for (int ai = 0; ai < 2; ++ai)
#pragma unroll
            for (int m = 0; m < 4; ++m) { const int row = EPI_ROWS(ai, m);
#pragma unroll
                for (int bj = 0; bj < 2; ++bj) *(u32x4*)(SL + (size_t)row * 256 + bj * HALF + wc * 32 + 8 * fq) = pack8(acc[ai][bj][m][0], acc[ai][bj][m][1]); }
    }
};
struct EpiS5Y {
    bf16_t* SG;
    __device__ __forceinline__ f32x4 gelu4(const f32x4 x) const { f32x4 r;
#pragma unroll
        for (int j = 0; j < 4; ++j) { const float v = x[j], u2 = 1.5957691216057308f * (v + 0.044715f * v * v * v); r[j] = v * fsig(u2); } return r; }
    __device__ __forceinline__ void operator()(const f32x4 (&acc)[2][2][4][2], const Unit& u, int wr, int wc, int fr, int fq) const {
        const int grp = u.pn, mt = u.pm - 9 * grp;
#pragma unroll
        for (int ai = 0; ai < 2; ++ai)
#pragma unroll
            for (int m = 0; m < 4; ++m) { const int chunk = mt * BM + ai * HALF + wr * 64 + m * 16 + fr;
#pragma unroll
                for (int bj = 0; bj < 2; ++bj) { const int col = bj * HALF + wc * 32 + 8 * fq; const int tok = chunk * 16 + (col >> 4);
                    *(u32x4*)(SG + ((size_t)grp * T + tok) * 16 + (col & 15)) = pack8(gelu4(acc[ai][bj][m][0]), gelu4(acc[ai][bj][m][1])); } }
    }
};
#undef EPI_ROWS
struct SchedProj {
    StaticOrder so; int G, c;
    __device__ void init(int G_, int c_) { so.init(T, DIN, G_, c_); G = G_; c = c_; }
    __device__ bool next(int i, Unit& u) const { const int L = i * G + c; if (L < so.nwg) return so.next(i, u); const int r = L - so.nwg; if (r >= 12) return false; u.pm = T / BM + r / 3; u.pn = r % 3; return true; }
};
struct SchedS5 {
    int mper, G, c;
    __device__ bool next(int i, Unit& u) const { const int L = i * G + c; if (L >= 32 * mper) return false; const int grp = L / mper; u.pm = 9 * grp + (L % mper); u.pn = grp; return true; }
};
struct SchedMoE {
    const PG8_LAS int* tile_e; int ntiles, nN, G, c, rev;
    __device__ bool next(int i, Unit& u) const { const int L = i * G + c; if (L >= ntiles * nN) return false; u.pm = rev ? ntiles - 1 - L / nN : L / nN; u.pn = tile_e[u.pm] * nN + (L % nN); return true; }
};
}

#include <hip/hip_bf16.h>
#include <cmath>

namespace attn_body {
using bf16=__hip_bfloat16;
using bf16x8=__attribute__((ext_vector_type(8)))short;
using s16x4=__attribute__((ext_vector_type(4)))short;
using f32x16=__attribute__((ext_vector_type(16)))float;
using u32x4=__attribute__((ext_vector_type(4)))unsigned;
constexpr int D=64,QP=512,KP=64,OP=1024,ASEQ=8192,ASKV=8448;
constexpr int NW=8,QBLK=32,QB=QBLK*NW,KVBLK=64,NQB=ASEQ/QB;
constexpr int ATTN_UNIT_ROWS=QB;
__device__ __forceinline__ int crow(int r,int hi){return (r&3)+8*(r>>2)+4*hi;}
#define SBAR() __builtin_amdgcn_sched_barrier(0)
__device__ __forceinline__ void cmask(f32x16&p0,f32x16&p1,int jb,int qrel,int hi){
  const float NEG=-INFINITY; int kb=64*jb+4*hi;
  #pragma unroll
  for(int r=0;r<16;++r){int kv=kb+(r&3)+8*(r>>2); if(kv>qrel)p0[r]=NEG; if(kv+32>qrel)p1[r]=NEG;}
}

constexpr int NSLOT=3, SLOTB=8192;
constexpr int LDS_K=0, LDS_V=NSLOT*SLOTB, LDS_WS=2*NSLOT*SLOTB, LDS_OST=LDS_WS+NW*64*4, LDS_BYTES=LDS_OST+NW*4096;
constexpr float C2=0.125f*1.4426950408889634f;
__device__ __forceinline__ void glds16(const void*gsrc,unsigned lds_dst){unsigned keep;
  asm volatile("s_mov_b32 %0, m0\n\ts_mov_b32 m0, %2\n\ts_nop 0\n\tglobal_load_lds_dwordx4 %1, off\n\ts_mov_b32 m0, %0":"=&s"(keep):"v"(gsrc),"s"(lds_dst):"memory");}
__device__ __forceinline__ float max3f(float a,float b,float c){float r;asm("v_max3_f32 %0, %1, %2, %3":"=v"(r):"v"(a),"v"(b),"v"(c));return r;}
__device__ __forceinline__ float max2f(float a,float b){float r;asm("v_max_f32_e32 %0, %1, %2":"=v"(r):"v"(a),"v"(b));return r;}
__device__ __forceinline__ float fadd_s(float a,float b){float r;asm("v_add_f32_e32 %0, %1, %2":"=v"(r):"v"(a),"v"(b));return r;}
__device__ __forceinline__ float fsub_s(float a,float b){float r;asm("v_sub_f32_e32 %0, %1, %2":"=v"(r):"v"(a),"v"(b));return r;}
typedef float f32x2_t __attribute__((ext_vector_type(2))); typedef __bf16 bf16x2_t __attribute__((ext_vector_type(2)));
__device__ __forceinline__ unsigned cvtpk_s(float lo,float hi){f32x2_t v={lo,hi};bf16x2_t b=__builtin_convertvector(v,bf16x2_t);return __builtin_bit_cast(unsigned,b);}
#define WAIT_BAR(N) asm volatile("s_waitcnt vmcnt(" #N ") lgkmcnt(0)\n\ts_barrier":::"memory")

__device__ __forceinline__ void qkt(f32x16&p0,f32x16&p1,const char*Kslot,const bf16x8*qr,const f32x16&negm,int r32,int hi){
  const char*kb=Kslot+hi*1024+r32*16;
  #pragma unroll
  for(int d0=0;d0<4;++d0){
    const bf16x8 b0=*reinterpret_cast<const bf16x8*>(kb+d0*2048);
    const bf16x8 b1=*reinterpret_cast<const bf16x8*>(kb+d0*2048+512);
    if(d0==0){p0=__builtin_amdgcn_mfma_f32_32x32x16_bf16(b0,qr[0],negm,0,0,0);p1=__builtin_amdgcn_mfma_f32_32x32x16_bf16(b1,qr[0],negm,0,0,0);}
    else{p0=__builtin_amdgcn_mfma_f32_32x32x16_bf16(b0,qr[d0],p0,0,0,0);p1=__builtin_amdgcn_mfma_f32_32x32x16_bf16(b1,qr[d0],p1,0,0,0);}}
}
typedef __attribute__((address_space(3))) const char* lds_cptr;
typedef short v4i16_t __attribute__((ext_vector_type(4)));
__device__ __forceinline__ void kload8(bf16x8*kf,lds_cptr kp){
  kf[0]=*(const __attribute__((address_space(3))) bf16x8*)(kp);      kf[1]=*(const __attribute__((address_space(3))) bf16x8*)(kp+512);
  kf[2]=*(const __attribute__((address_space(3))) bf16x8*)(kp+2048); kf[3]=*(const __attribute__((address_space(3))) bf16x8*)(kp+2560);
  kf[4]=*(const __attribute__((address_space(3))) bf16x8*)(kp+4096); kf[5]=*(const __attribute__((address_space(3))) bf16x8*)(kp+4608);
  kf[6]=*(const __attribute__((address_space(3))) bf16x8*)(kp+6144); kf[7]=*(const __attribute__((address_space(3))) bf16x8*)(kp+6656);
}
__device__ __forceinline__ void kload2(bf16x8*kf,lds_cptr kp,int j){ kf[2*j]=*(const __attribute__((address_space(3))) bf16x8*)(kp+j*2048); kf[2*j+1]=*(const __attribute__((address_space(3))) bf16x8*)(kp+j*2048+512); }
__device__ __forceinline__ s16x4 vtr(lds_cptr p){ return __builtin_bit_cast(s16x4,__builtin_amdgcn_ds_read_tr16_b64_v4i16((__attribute__((address_space(3))) v4i16_t*)p)); }
__device__ __forceinline__ float rowmax(const f32x16&p0,const f32x16&p1){
  float a=max3f(p0[0],p0[1],p1[0]),b=max3f(p0[2],p0[3],p1[1]);a=max3f(a,p1[2],p1[3]);
  #pragma unroll
  for(int r=4;r<16;r+=4){a=max3f(a,p0[r],p0[r+1]);b=max3f(b,p0[r+2],p0[r+3]);a=max3f(a,p1[r],p1[r+1]);b=max3f(b,p1[r+2],p1[r+3]);}
  const float m=max2f(a,b);
  auto rr=__builtin_amdgcn_permlane32_swap(__float_as_uint(m),__float_as_uint(m),false,false);
  return max2f(__uint_as_float(rr[0]),__uint_as_float(rr[1]));
}
__device__ __forceinline__ void pv(f32x16*o,int vb,bf16x8 pa0,bf16x8 pa1,bf16x8 pa2,bf16x8 pa3){
  #pragma unroll
  for(int d0=0;d0<2;++d0){s16x4 lo[4],hi[4];
    #pragma unroll
    for(int ks=0;ks<4;++ks){
      asm volatile("ds_read_b64_tr_b16 %0,%1 offset:%c2":"=&v"(lo[ks]):"v"(vb),"i"(d0*4096+ks*1024):"memory");
      asm volatile("ds_read_b64_tr_b16 %0,%1 offset:%c2":"=&v"(hi[ks]):"v"(vb),"i"(d0*4096+ks*1024+512):"memory");}
    asm volatile("s_waitcnt lgkmcnt(0)":::"memory");SBAR();
    #define PK(k) (bf16x8){lo[k][0],lo[k][1],lo[k][2],lo[k][3],hi[k][0],hi[k][1],hi[k][2],hi[k][3]}
    o[d0]=__builtin_amdgcn_mfma_f32_32x32x16_bf16(pa0,PK(0),o[d0],0,0,0);
    o[d0]=__builtin_amdgcn_mfma_f32_32x32x16_bf16(pa1,PK(1),o[d0],0,0,0);
    o[d0]=__builtin_amdgcn_mfma_f32_32x32x16_bf16(pa2,PK(2),o[d0],0,0,0);
    o[d0]=__builtin_amdgcn_mfma_f32_32x32x16_bf16(pa3,PK(3),o[d0],0,0,0);
    #undef PK
  }
}

#ifndef ATTN_STORE16
#define ATTN_STORE16(p,v) (*(u32x4*)(p)=(v))
#endif
template<int THRL> __device__ __forceinline__ void attn_unit(int b,int h,int qb,const bf16*Q,const bf16*__restrict__ K,const bf16*__restrict__ V,bf16*O,char*shm,float mref){
  const int tid=threadIdx.x,lane=tid&63,r32=lane&31,hi=lane>>5; const int wid=__builtin_amdgcn_readfirstlane(tid>>6);
  const long rowbase=(long)b*ASEQ; const int q0=qb*QB;
  const bf16*Qw=Q+(rowbase+q0+wid*QBLK)*QP+h*D;
  const bf16*Kh=K+(long)(b*2+(h>>2))*ASKV*KP,*Vh=V+(long)(b*2+(h>>2))*ASKV*KP;
  const unsigned lds0=(unsigned)(uintptr_t)shm;
  float*wsf=(float*)(shm+LDS_WS)+wid*64;
  const bf16*ksrc=Kh+(long)lane*KP+wid*8;
  const bf16*vsrc=Vh+(long)(16*(wid&3)+(lane>>2))*KP+(wid>>2)*32+(lane&3)*8;
  const unsigned kdst=lds0+LDS_K+wid*1024, vdst=lds0+LDS_V+wid*1024;
  #define DMA_K(t,slot) glds16(ksrc+(long)(t)*KVBLK*KP,(unsigned)__builtin_amdgcn_readfirstlane(kdst+(slot)))
  #define DMA_V(t,slot) glds16(vsrc+(long)(t)*KVBLK*KP,(unsigned)__builtin_amdgcn_readfirstlane(vdst+(slot)))
  const int vb0=(int)(lds0+LDS_V)+((lane>>4)&1)*32+(lane&3)*8+(4*hi+((lane&15)>>2))*64;
  const char*Kbase=shm+LDS_K; bf16x8 kf[8];
  const lds_cptr shm3=(lds_cptr)shm; const lds_cptr kp0=shm3+LDS_K+hi*1024+r32*16; const lds_cptr vp0=shm3+LDS_V+((lane>>4)&1)*32+(lane&3)*8+(4*hi+((lane&15)>>2))*64;
  const int NT=ASKV/KVBLK;
  DMA_K(0,0);DMA_V(0,0);DMA_K(1,SLOTB);
  bf16x8 qr[4];
  #pragma unroll
  for(int d0=0;d0<4;++d0)qr[d0]=*reinterpret_cast<const bf16x8*>(&Qw[(long)r32*QP+d0*16+hi*8]);
  float l_reg=0.f;f32x16 o[2];o[0]=f32x16{};o[1]=f32x16{};f32x16 negm;
  _Pragma("unroll") for(int r=0;r<16;++r)negm[r]=-mref; asm volatile("":"+v"(negm));
  const int qrel=wid*QBLK+r32;
  #define CMASK(P0,P1,t) do{}while(0)
  #define START(P0,P1) do{ _Pragma("unroll") for(int r=0;r<16;++r)P0[r]=__builtin_amdgcn_exp2f(P0[r]); }while(0)
  #define RESC() do{}while(0)
  f32x16 pA0,pA1,pB0,pB1;
  int sl_prev=0,sl_cur=0,sl_next=SLOTB;
  #define ROT() do{sl_prev=sl_cur;sl_cur=sl_next;sl_next=(sl_next==(NSLOT-1)*SLOTB)?0:sl_next+SLOTB;}while(0)
  DMA_K(2,2*SLOTB);
  WAIT_BAR(3);
  qkt(pA0,pA1,Kbase,qr,negm,r32,hi);asm volatile("s_nop 15\n\ts_nop 7":"+v"(pA0),"+v"(pA1));CMASK(pA0,pA1,0);
  START(pA0,pA1);
  _Pragma("unroll") for(int r=0;r<16;++r)pA1[r]=__builtin_amdgcn_exp2f(pA1[r]);
  WAIT_BAR(0);
  DMA_K(3,0);DMA_V(1,SLOTB);
  ROT();
  kload8(kf,kp0+sl_cur);
  WAIT_BAR(2);
  s16x4 vlo[8],vhi[8]; u32x4 pw0,pw1,pw2,pw3;
  #define PKW(P,B) cvtpk_s(P[B],P[B+1])
  #define PAF(k) __builtin_bit_cast(bf16x8,pw##k)
  #define VFR(i) (bf16x8){vlo[i][0],vlo[i][1],vlo[i][2],vlo[i][3],vhi[i][0],vhi[i][1],vhi[i][2],vhi[i][3]}
  #define PIN(x) asm volatile("":"+v"(x))
  #define MX3(a,b,c) __builtin_fmaxf(__builtin_fmaxf((a),(b)),(c))
  #define GAPA(MF,A0,A1,A2,A3,W0,W1,PW) do{ MF; sacc+=A0; sacc+=A1; sacc+=A2; sacc+=A3; PIN(sacc); W0; W1; PIN(PW); SBAR(); }while(0)
  #define EX(v) __builtin_amdgcn_exp2f(v)
  #define GAPB(MF,X,B) do{ MF; X[B]=EX(X[B]); X[B+1]=EX(X[B+1]); X[B+2]=EX(X[B+2]); X[B+3]=EX(X[B+3]); PIN(X); SBAR(); }while(0)
  #define VRD(i) do{ vlo[i]=vtr(vp_+(((i)>>2)*4096+((i)&3)*1024)); vhi[i]=vtr(vp_+(((i)>>2)*4096+((i)&3)*1024+512)); }while(0)
  #define KRD(G,j) do{ if(G){ kload2(kf,kp0+sl_next,j); SBAR(); } }while(0)
  #define STEP(C0,C1,P0,P1,t,GK,GV,GL) do{ SBAR(); \
    const lds_cptr vp_=vp0+sl_prev; \
    VRD(0); SBAR(); float sacc=(P0[0]+P0[1]); \
    GAPA(C0=__builtin_amdgcn_mfma_f32_32x32x16_bf16(kf[0],qr[0],negm,0,0,0), P0[2],P0[3],P0[4],P0[5],     pw0[0]=PKW(P0,0), pw0[1]=PKW(P0,2), pw0); \
    VRD(4); SBAR(); GAPA(C1=__builtin_amdgcn_mfma_f32_32x32x16_bf16(kf[1],qr[0],negm,0,0,0), P0[6],P0[7],P0[8],P0[9],     pw0[2]=PKW(P0,4), pw0[3]=PKW(P0,6), pw0); \
    VRD(1); SBAR(); GAPA(C0=__builtin_amdgcn_mfma_f32_32x32x16_bf16(kf[2],qr[1],C0,0,0,0),   P0[10],P0[11],P0[12],P0[13], pw1[0]=PKW(P0,8), pw1[1]=PKW(P0,10), pw1); \
    VRD(5); SBAR(); GAPA(C1=__builtin_amdgcn_mfma_f32_32x32x16_bf16(kf[3],qr[1],C1,0,0,0),   P0[14],P0[15],P1[0],P1[1],   pw1[2]=PKW(P0,12),pw1[3]=PKW(P0,14), pw1); \
    VRD(2); SBAR(); GAPA(C0=__builtin_amdgcn_mfma_f32_32x32x16_bf16(kf[4],qr[2],C0,0,0,0),   P1[2],P1[3],P1[4],P1[5],     pw2[0]=PKW(P1,0), pw2[1]=PKW(P1,2), pw2); \
    VRD(6); SBAR(); GAPA(C1=__builtin_amdgcn_mfma_f32_32x32x16_bf16(kf[5],qr[2],C1,0,0,0),   P1[6],P1[7],P1[8],P1[9],     pw2[2]=PKW(P1,4), pw2[3]=PKW(P1,6), pw2); \
    VRD(3); SBAR(); GAPA(C0=__builtin_amdgcn_mfma_f32_32x32x16_bf16(kf[6],qr[3],C0,0,0,0),   P1[10],P1[11],P1[12],P1[13], pw3[0]=PKW(P1,8), pw3[1]=PKW(P1,10), pw3); \
    VRD(7); SBAR(); GAPA(C1=__builtin_amdgcn_mfma_f32_32x32x16_bf16(kf[7],qr[3],C1,0,0,0),   P1[14],P1[15],0.f,0.f,       pw3[2]=PKW(P1,12),pw3[3]=PKW(P1,14), pw3); \
    l_reg+=sacc; \
    if(GK){DMA_K((t)+3,sl_cur);} if(GV){DMA_V((t)+1,sl_next);} \
    CMASK(C0,C1,t); \
    SBAR(); \
    GAPB(o[0]=__builtin_amdgcn_mfma_f32_32x32x16_bf16(PAF(0),VFR(0),o[0],0,0,0), C0,0); \
    GAPB(o[1]=__builtin_amdgcn_mfma_f32_32x32x16_bf16(PAF(0),VFR(4),o[1],0,0,0), C0,4); \
    KRD(GL,0); GAPB(o[0]=__builtin_amdgcn_mfma_f32_32x32x16_bf16(PAF(1),VFR(1),o[0],0,0,0), C0,8); \
    KRD(GL,1); GAPB(o[1]=__builtin_amdgcn_mfma_f32_32x32x16_bf16(PAF(1),VFR(5),o[1],0,0,0), C0,12); \
    KRD(GL,2); GAPB(o[0]=__builtin_amdgcn_mfma_f32_32x32x16_bf16(PAF(2),VFR(2),o[0],0,0,0), C1,0); \
    KRD(GL,3); GAPB(o[1]=__builtin_amdgcn_mfma_f32_32x32x16_bf16(PAF(2),VFR(6),o[1],0,0,0), C1,4); \
    GAPB(o[0]=__builtin_amdgcn_mfma_f32_32x32x16_bf16(PAF(3),VFR(3),o[0],0,0,0), C1,8); \
    GAPB(o[1]=__builtin_amdgcn_mfma_f32_32x32x16_bf16(PAF(3),VFR(7),o[1],0,0,0), C1,12); \
    }while(0)
  int t=1;
  #undef CMASK
  #define CMASK(P0,P1,t) do{}while(0)
  for(;t+5<NT;t+=2){
    STEP(pB0,pB1,pA0,pA1,t,true,true,true);     WAIT_BAR(2); RESC(); ROT();
    STEP(pA0,pA1,pB0,pB1,t+1,true,true,true);   WAIT_BAR(2); RESC(); ROT();
  }
  #undef CMASK
  #define CMASK(P0,P1,t) do{}while(0)
  #define ENDW(tt) do{ if((tt)+3<NT){WAIT_BAR(2);} else if((tt)+2<NT){WAIT_BAR(1);} else {WAIT_BAR(0);} }while(0)
  for(;t+1<NT;t+=2){
    STEP(pB0,pB1,pA0,pA1,t,(t+3<NT),(t+1<NT),(t+1<NT));       ENDW(t);   RESC(); ROT();
    STEP(pA0,pA1,pB0,pB1,t+1,(t+4<NT),(t+2<NT),(t+2<NT));     ENDW(t+1); RESC(); ROT();
  }
  STEP(pB0,pB1,pA0,pA1,NT-1,false,false,false); RESC();
  { float sacc=pB0[0]+pB0[1]; _Pragma("unroll") for(int r=2;r<16;++r)sacc+=pB0[r]; _Pragma("unroll") for(int r=0;r<16;++r)sacc+=pB1[r]; l_reg+=sacc;
    pw0=(u32x4){PKW(pB0,0),PKW(pB0,2),PKW(pB0,4),PKW(pB0,6)};pw1=(u32x4){PKW(pB0,8),PKW(pB0,10),PKW(pB0,12),PKW(pB0,14)};pw2=(u32x4){PKW(pB1,0),PKW(pB1,2),PKW(pB1,4),PKW(pB1,6)};pw3=(u32x4){PKW(pB1,8),PKW(pB1,10),PKW(pB1,12),PKW(pB1,14)};
    SBAR(); pv(o,vb0+sl_cur,PAF(0),PAF(1),PAF(2),PAF(3)); }
  #undef PKW
  #undef PAF
  #undef VFR
  #undef PIN
  #undef MX3
  #undef GAPA
  #undef GAPB
  #undef EX
  #undef VRD
  #undef KRD
  #undef STEP
  #undef ENDW
  {auto rr=__builtin_amdgcn_permlane32_swap(__float_as_uint(l_reg),__float_as_uint(l_reg),false,false);l_reg=__uint_as_float(rr[0])+__uint_as_float(rr[1]);}
  if(hi==0)wsf[32+r32]=l_reg;asm volatile("s_waitcnt lgkmcnt(0)":::"memory");
  float rli[16];
  #pragma unroll
  for(int r=0;r<16;++r)rli[r]=__builtin_amdgcn_rcpf(wsf[32+crow(r,hi)]);
  bf16*Ow=O+(rowbase+q0+wid*QBLK)*OP+h*D;
  { bf16*stg=(bf16*)(shm+LDS_OST)+wid*2048;
    #pragma unroll
    for(int r=0;r<16;++r){const int orow=crow(r,hi);
      #pragma unroll
      for(int d0=0;d0<2;++d0)stg[orow*64+d0*32+r32]=__float2bfloat16(o[d0][r]*rli[r]);}
    asm volatile("s_waitcnt lgkmcnt(0)":::"memory");
    #pragma unroll
    for(int i=0;i<4;++i){const int row=i*8+(lane>>3),ch=lane&7; const u32x4 v=*(const u32x4*)(stg+row*64+ch*8); ATTN_STORE16(Ow+(long)row*OP+ch*8,v);} }
  asm volatile("s_waitcnt lgkmcnt(0)\n\ts_barrier":::"memory");
  #undef DMA_K
  #undef DMA_V
  #undef CMASK
  #undef START
  #undef RESC
  #undef ROT
}
constexpr int ATTN_LDS_BYTES=LDS_BYTES;
struct AttnTensors { const bf16* Q; const bf16* K; const bf16* V; bf16* O; float mref; };
struct AttnUnit { int bh; int qb; };
struct StaticOrder {
  int vcu;
  __device__ __forceinline__ explicit StaticOrder(int grid,int block):vcu((block%8)*(grid/8)+block/8){}
  __device__ __forceinline__ bool next(int i,AttnUnit&u)const{ if(i>=4)return false; const int s=vcu&7; u.bh=vcu>>3; u.qb=(i==0)?s:(i==1)?15-s:(i==2)?16+s:31-s; return true; }
  __device__ __forceinline__ void a_ready(const AttnUnit&)const{}
  __device__ __forceinline__ void done(const AttnUnit&)const{}
};
template<class Sched,int THRL=8> __device__ __forceinline__ void attn_phase(char*lds,const AttnTensors&T,const Sched&S){
  AttnUnit u;
  for(int i=0;S.next(i,u);++i){ S.a_ready(u); attn_unit<THRL>(u.bh>>3,u.bh&7,u.qb,T.Q,T.K,T.V,T.O,lds,T.mref); S.done(u); }
}
#undef SBAR
#undef WAIT_BAR
}

#define LAS __attribute__((address_space(3)))

#define XB_TMO      128
#define XB_XCNT(j)  (256  + 64 * (j))
#define XB_XSUB(j)  (1280 + 64 * (j))
#define XB_XGEN(j)  (2304 + 64 * (j))
#define XB_TOP      3328
#define XB_TOPGEN   3392
#define XCD_BAR_WORDS 3456
#define XB_SPIN_CAP (1u << 18)

__device__ __forceinline__ unsigned xb_ld(unsigned* p)              { return __hip_atomic_load(p, __ATOMIC_RELAXED, __HIP_MEMORY_SCOPE_AGENT); }
__device__ __forceinline__ unsigned xb_add(unsigned* p, unsigned v) { return __hip_atomic_fetch_add(p, v, __ATOMIC_RELAXED, __HIP_MEMORY_SCOPE_AGENT); }
__device__ __forceinline__ unsigned xb_xcc_id() { return (unsigned)__builtin_amdgcn_s_getreg((3 << 11) | 20) & 0xFu; }
#define XB_SPIN(cond, bar) do { unsigned _sp = 0; while (cond) { __builtin_amdgcn_s_sleep(1); \
    if ((++_sp & 255u) == 0u) { if (xb_ld(&(bar)[XB_TMO])) break; if (_sp > XB_SPIN_CAP) { atomicAdd(&(bar)[XB_TMO], 1u); break; } } } } while (0)

struct XcdBarrier {
    unsigned* bar; unsigned x;
    volatile LAS unsigned* st;
};

__device__ __forceinline__ XcdBarrier xcd_barrier_post(unsigned* bar, volatile LAS unsigned* st) {
    XcdBarrier b; b.bar = bar; b.x = xb_xcc_id(); b.st = st;
    if (threadIdx.x == 0) (void)xb_add(&bar[XB_XCNT(b.x)], 1u);
    return b;
}
__device__ __forceinline__ void xcd_barrier_complete(unsigned* bar, unsigned x, unsigned& nloc, unsigned& nx) {
    const unsigned G = gridDim.x * gridDim.y * gridDim.z;
    unsigned sum, cnt, mine, sp = 0u;
    for (;;) {
        sum = 0u; cnt = 0u; mine = 0u;
#pragma unroll
        for (unsigned j = 0; j < 16; ++j) { const unsigned c = xb_ld(&bar[XB_XCNT(j)]); sum += c; cnt += (c > 0u) ? 1u : 0u; mine = (j == x) ? c : mine; }
        if (sum == G) break;
        __builtin_amdgcn_s_sleep(1);
        if ((++sp & 255u) == 0u) { if (xb_ld(&bar[XB_TMO])) break; if (sp > XB_SPIN_CAP) { atomicAdd(&bar[XB_TMO], 1u); break; } }
    }
    nloc = mine > 0u ? mine : 1u; nx = cnt > 0u ? cnt : 1u;
}

__device__ __forceinline__ void xcd_barrier(const XcdBarrier& b) {
    asm volatile("s_waitcnt vmcnt(0)" ::: "memory");
    __syncthreads();
    if (threadIdx.x == 0) {
        unsigned* bar = b.bar;
        __builtin_amdgcn_s_waitcnt(0);
        unsigned nloc = b.st[0], nx = b.st[1];
        if (nloc == 0u) { xcd_barrier_complete(bar, b.x, nloc, nx); b.st[0] = nloc; b.st[1] = nx; }
        const unsigned old = xb_add(&bar[XB_XSUB(b.x)], 1u);
        const unsigned gen = old / nloc;
        if (old + 1u == (gen + 1u) * nloc) {
            __builtin_amdgcn_fence(__ATOMIC_RELEASE, "agent");
            asm volatile("s_waitcnt vmcnt(0)" ::: "memory");
            const unsigned og = xb_add(&bar[XB_TOP], 1u);
            const unsigned tg = og / nx;
            if (og + 1u == (tg + 1u) * nx) xb_add(&bar[XB_TOPGEN], 1u);
            else XB_SPIN(xb_ld(&bar[XB_TOPGEN]) == tg, bar);
            __builtin_amdgcn_fence(__ATOMIC_ACQUIRE, "agent");
            xb_add(&bar[XB_XGEN(b.x)], 1u);
            asm volatile("s_waitcnt vmcnt(0)" ::: "memory");
        } else {
            XB_SPIN(xb_ld(&bar[XB_XGEN(b.x)]) == gen, bar);
            __builtin_amdgcn_fence(__ATOMIC_ACQUIRE, "agent");
            asm volatile("s_waitcnt vmcnt(0)" ::: "memory");
        }
    }
    __syncthreads();
}

#undef LAS

constexpr int NWAVES = 8;
constexpr int RING_OFF = 0, RING_BYTES = 131072;
constexpr int LDSCTL_OFF = RING_BYTES;
constexpr int LDS_TILE_OFF = LDSCTL_OFF + 4096;
constexpr int LDS_BYTES = 147456;
#define LAS __attribute__((address_space(3)))
#define GAS __attribute__((address_space(1)))
typedef unsigned v4u __attribute__((ext_vector_type(4)));

__device__ __forceinline__ int proj_perm(int n) {
    if (n < COL_K || n >= COL_GATE) return n;
    if (n < COL_Q) { const int r = n - COL_K, hs = r >> 6, d = r & 63; return COL_K + 128 * (d >> 5) + 32 * hs + (d & 31); }
    const int r = n - COL_Q, h = r >> 6, d = r & 63; return COL_Q + 256 * (h >> 2) + 128 * (d >> 5) + 32 * (h & 3) + (d & 31);
}
__device__ __forceinline__ int gu_perm(int c) { const int jc = c & 1023, up = c >> 10; return 256 * (jc >> 7) + 128 * up + (jc & 127); }
typedef float wc_f32x4 __attribute__((ext_vector_type(4)));
struct WcMat { const float* W; bf16* WT; int N, ldk, koff, mode, local; };
__device__ __forceinline__ WcMat wc_decode(const P& p, int it) {
    constexpr int I_GLU = 8 * 2, I_SSM = 8 * 4, I_D1 = 16 * 4;
    int r = it; WcMat m;
    if (r < 32 * I_D1) { const int e = r / I_D1; m = WcMat{p.in[28] + (size_t)e * 1024 * 1024, (bf16*)(p.ws + WS_WD) + (size_t)e * 1024 * 1024, 1024, 1024, 0, 0, r % I_D1}; return m; } r -= 32 * I_D1;
    if (r < I_GLU) { m = WcMat{p.in[17], (bf16*)(p.ws + WS_WGLU), 512, 512, 0, 0, r}; return m; } r -= I_GLU;
    if (r < I_SSM) { m = WcMat{p.in[19], (bf16*)(p.ws + WS_W12), 1024, 1024, 0, 0, r}; return m; } r -= I_SSM;
    if (r < I_SSM) { m = WcMat{p.in[22], (bf16*)(p.ws + WS_W12), 1024, 1024, 512, 0, r}; return m; } r -= I_SSM;
    m = WcMat{p.in[23], (bf16*)(p.ws + WS_WOUT), 1024, 1024, 0, 0, r}; return m;
}
#define WQ_LOAD(V, item) do { const bool gu_ = (item) < 2048; const int e_ = (item) >> 6, sn_ = gu_ ? (item) & 63 : (item) - 2048; const int N_ = gu_ ? 2048 : DIN; \
        const float* src_ = (gu_ ? p.in[26] + (size_t)e_ * 1024 * 2048 : p.in[8]) + (size_t)(t >> 3) * N_ + 32 * sn_ + 4 * (t & 7); \
        _Pragma("unroll") for (int i_ = 0; i_ < 16; ++i_) V[i_] = *(const wc_f32x4*)(src_ + (size_t)(64 * i_) * N_); } while (0)
__device__ __forceinline__ void wq_proc(const P& p, const wc_f32x4 (&v)[16], int item, LAS unsigned char* lds) {
    const bool gu = item < 2048; const int t = threadIdx.x, e = item >> 6, sn = gu ? item & 63 : item - 2048;
    LAS unsigned* cmax = (LAS unsigned*)(lds + 65536);
    if (t < 32) cmax[t] = 0u;
    __syncthreads();
    wc_f32x4 m4 = {0.f, 0.f, 0.f, 0.f};
#pragma unroll
    for (int i = 0; i < 16; ++i) { m4[0] = fmaxf(m4[0], fabsf(v[i][0])); m4[1] = fmaxf(m4[1], fabsf(v[i][1])); m4[2] = fmaxf(m4[2], fabsf(v[i][2])); m4[3] = fmaxf(m4[3], fabsf(v[i][3]));
        const unsigned lo = pk2(v[i][0], v[i][1]), hi = pk2(v[i][2], v[i][3]);
        typedef unsigned wc_u32x2 __attribute__((ext_vector_type(2))); *(LAS wc_u32x2*)(lds + (((t >> 3) + 64 * i) * 32 + 4 * (t & 7)) * 2) = (wc_u32x2){lo, hi}; }
#pragma unroll
    for (int j = 0; j < 4; ++j) __hip_atomic_fetch_max(cmax + 4 * (t & 7) + j, __float_as_uint(m4[j]), __ATOMIC_RELAXED, __HIP_MEMORY_SCOPE_WORKGROUP);
    __syncthreads();
    const int n = t & 31, cg = t >> 5; const float am = __uint_as_float(cmax[n]), inv = am > 0.f ? 127.f / am : 0.f;
    const int c0 = 32 * sn + n, drow = gu ? gu_perm(c0) : proj_perm(c0);
    signed char* dst = gu ? (signed char*)(p.ws + WS_WGQ) + ((size_t)e * 2048 + drow) * 1024 : (signed char*)(p.ws + WS_WIN) + (size_t)drow * 1024;
    if (cg == 0) { if (gu) ((float*)(p.ws + WS_WGS))[e * 2048 + drow] = am * (1.f / 127.f); else ((float*)(p.ws + WS_WINS))[drow] = am * (1.f / 127.f); }
#pragma unroll
    for (int j = 0; j < 4; ++j) { const int c = cg + 16 * j; unsigned o4[4];
#pragma unroll
        for (int w = 0; w < 4; ++w) { unsigned acc = 0u;
#pragma unroll
            for (int q = 0; q < 4; ++q) { const int k = 16 * c + 4 * w + q; const float x = __uint_as_float((unsigned)(*(const LAS unsigned short*)(lds + (k * 32 + n) * 2)) << 16);
                int qi = __float2int_rn(x * inv); qi = qi > 127 ? 127 : (qi < -127 ? -127 : qi);
                acc |= ((unsigned)(qi & 255)) << (8 * q); }
            o4[w] = acc; }
        *(uint4*)(dst + 16 * c) = make_uint4(o4[0], o4[1], o4[2], o4[3]); }
    __syncthreads();
}
#define WC_LOAD(V, M) do { const int nblk_ = M.N >> 8, kb_ = M.local / nblk_, nb_ = M.local - kb_ * nblk_; const float* src_ = M.W + (size_t)(64 * kb_ + wave) * M.N + 256 * nb_ + 4 * lane; \
        _Pragma("unroll") for (int i_ = 0; i_ < 8; ++i_) V[i_] = *(const wc_f32x4*)(src_ + (size_t)(8 * i_) * M.N); } while (0)
#define WC_PROC(V, M, buf) do { const int nblk_ = M.N >> 8, kb_ = M.local / nblk_, nb_ = M.local - kb_ * nblk_, k0_ = 64 * kb_, n0_ = 256 * nb_; LAS float* scr_ = (LAS float*)(lds + (buf) * 65536); \
        _Pragma("unroll") for (int i_ = 0; i_ < 8; ++i_) { const int row_ = wave + 8 * i_; *(LAS wc_f32x4*)(scr_ + row_ * 256 + ((4 * lane) ^ (((row_ >> 3) & 7) << 2))) = V[i_]; } \
        __syncthreads(); const int c_ = lane & 7; \
        _Pragma("unroll") for (int j_ = 0; j_ < 4; ++j_) { const int n_ = 64 * j_ + 8 * wave + (lane >> 3); const LAS float* s_ = scr_ + (8 * c_) * 256 + (n_ ^ (c_ << 2)); \
            v4u o_; o_.x = pk2(s_[0 * 256], s_[1 * 256]); o_.y = pk2(s_[2 * 256], s_[3 * 256]); o_.z = pk2(s_[4 * 256], s_[5 * 256]); o_.w = pk2(s_[6 * 256], s_[7 * 256]); \
            const int dr_ = M.mode == 1 ? proj_perm(n0_ + n_) : M.mode == 2 ? gu_perm(n0_ + n_) : n0_ + n_; \
            *(v4u*)(M.WT + (size_t)dr_ * M.ldk + M.koff + k0_ + 8 * c_) = o_; } } while (0)
__device__ __forceinline__ int wc_next(int& r, int bx, int total) {
    for (;;) { const int ph = r % 10, per = r / 10; const int base = per * 2272 + (ph == 0 ? 0 : ph == 1 ? 96 : ph == 2 ? 288 : 480 + (ph - 3) * 256); int rank;
        ++r;
        if (ph == 0) { if (bx < 160) continue; rank = bx - 160; } else if (ph < 3) { if (bx < 64) continue; rank = bx - 64; } else rank = bx;
        const int c = base + rank; return c < total ? c : -1; }
}
__device__ __forceinline__ void ph_wconv(const P& p, int bx, LAS unsigned char* lds) {
    const int lane = threadIdx.x & 63, wave = threadIdx.x >> 6;
    constexpr int NSTRIP = 32 * 64 + 104, NTILE = 32 * 64 + 8 * 2 + 2 * 8 * 4 + 16 * 4, TOTAL = NSTRIP + NTILE;
    int r = 0; const int t = threadIdx.x;
    int it = wc_next(r, bx, TOTAL);
    { wc_f32x4 sa[16], sb[16];
      if (it >= 0 && it < NSTRIP) WQ_LOAD(sa, it);
      while (it >= 0 && it < NSTRIP) {
          const int i2 = wc_next(r, bx, TOTAL);
          if (i2 >= 0 && i2 < NSTRIP) WQ_LOAD(sb, i2);
          wq_proc(p, sa, it, lds);
          it = i2; if (!(it >= 0 && it < NSTRIP)) break;
          const int i3 = wc_next(r, bx, TOTAL);
          if (i3 >= 0 && i3 < NSTRIP) WQ_LOAD(sa, i3);
          wq_proc(p, sb, it, lds);
          it = i3; } }
    wc_f32x4 wa[8], wb[8]; WcMat ma, mb;
    int ia = it;
    if (ia >= 0) { ma = wc_decode(p, ia - NSTRIP); WC_LOAD(wa, ma); }
    while (ia >= 0) {
        const int ib = wc_next(r, bx, TOTAL);
        if (ib >= 0) { mb = wc_decode(p, ib - NSTRIP); WC_LOAD(wb, mb); }
        WC_PROC(wa, ma, 0);
        if (ib < 0) break;
        ia = wc_next(r, bx, TOTAL);
        if (ia >= 0) { ma = wc_decode(p, ia - NSTRIP); WC_LOAD(wa, ma); }
        WC_PROC(wb, mb, 1);
    }
}
#undef WC_LOAD
#undef WC_PROC
#undef WQ_LOAD

__device__ __forceinline__ void ph_s5tab(const P& p, int g, int dir, float* L) {
    float* pw = L; float* Bb = L + 2176; float* Cc = Bb + 2048; float* Kt = Cc + 2048;
    const int tid = threadIdx.x, dg = dir * 32 + g;
    const float step = expf(p.in[11][dg]);
    for (int i = tid; i < 64 * 17; i += 512) { const int n = i / 17, tau = i - n * 17; const float zr = p.in[9][dg * 64 + n] * step, zi = p.in[10][dg * 64 + n] * step;
        const float e = expf(zr * (float)tau), a = zi * (float)tau; float sn, cs; sincosf(a, &sn, &cs); pw[i * 2] = e * cs; pw[i * 2 + 1] = e * sn; }
    for (int i = tid; i < 1024; i += 512) { const int n = i >> 4, q = i & 15; const float lr = p.in[9][dg * 64 + n], li = p.in[10][dg * 64 + n]; const float zr = lr * step, zi = li * step, e = expf(zr);
        float sn, cs; sincosf(zi, &sn, &cs); const float nr = e * cs - 1.f, ni = e * sn, den = lr * lr + li * li; const float cr = (nr * lr + ni * li) / den, ci = (ni * lr - nr * li) / den;
        const float br = p.in[12][(dg * 64 + n) * 16 + q], bi = p.in[13][(dg * 64 + n) * 16 + q]; Bb[i * 2] = cr * br - ci * bi; Bb[i * 2 + 1] = cr * bi + ci * br; }
    for (int i = tid; i < 1024; i += 512) { Cc[i * 2] = p.in[14][dg * 1024 + i]; Cc[i * 2 + 1] = p.in[15][dg * 1024 + i]; }
    __syncthreads();
    typedef float f2 __attribute__((ext_vector_type(2)));
    { const int tau = tid >> 5, pp = (tid >> 1) & 15, q0 = (tid & 1) * 8;
      float a[8] = {0.f, 0.f, 0.f, 0.f, 0.f, 0.f, 0.f, 0.f};
#pragma unroll 4
      for (int n = 0; n < 64; ++n) { const f2 c = *(const f2*)(Cc + (pp * 64 + n) * 2), w = *(const f2*)(pw + (n * 17 + tau) * 2); const float zr = c.x * w.x - c.y * w.y, zi = c.x * w.y + c.y * w.x;
#pragma unroll
          for (int q = 0; q < 8; ++q) { const f2 bq = *(const f2*)(Bb + (n * 16 + q0 + q) * 2); a[q] += zr * bq.x - zi * bq.y; } }
#pragma unroll
      for (int q = 0; q < 8; ++q) Kt[(tau * 16 + pp) * 16 + q0 + q] = a[q]; }
    __syncthreads();
    if (tid < 256) ((float*)(p.ws + WS_KD))[dg * 256 + tid] = Kt[tid];
    bf16* TCV = (bf16*)(p.ws + WS_TCV) + (size_t)g * 256 * 512;
    for (int i = tid; i < 256 * 256; i += 512) { const int row = i >> 8, k = i & 255, ii = row >> 4, pp = row & 15, j = k >> 4, q = k & 15;
        if (dir == 0 ? (j < ii) : (j > ii)) TCV[row * 512 + k] = f2bf(Kt[((dir == 0 ? ii - j : j - ii) * 16 + pp) * 16 + q]); }
    for (int i = tid; i < 256 * 128; i += 512) { const int row = i >> 7, kk = i & 127, ii = row >> 4, pp = row & 15, n = kk >> 1, ri = kk & 1, tau = dir == 0 ? ii + 1 : 16 - ii;
        const f2 c = *(const f2*)(Cc + (pp * 64 + n) * 2), w = *(const f2*)(pw + (n * 17 + tau) * 2);
        TCV[row * 512 + 256 + dir * 128 + kk] = f2bf(ri == 0 ? (c.x * w.x - c.y * w.y) : -(c.x * w.y + c.y * w.x)); }
    bf16* WS5 = (bf16*)(p.ws + WS_WS5) + (size_t)g * 256 * 256 + (size_t)dir * 128 * 256;
    for (int i = tid; i < 128 * 256; i += 512) { const int row = i >> 8, k = i & 255, n = row >> 1, ri = row & 1, ii = k >> 4, q = k & 15, tau = dir == 0 ? 15 - ii : ii;
        const f2 w = *(const f2*)(pw + (n * 17 + tau) * 2), bq = *(const f2*)(Bb + (n * 16 + q) * 2);
        WS5[i] = f2bf(ri == 0 ? w.x * bq.x - w.y * bq.y : w.x * bq.y + w.y * bq.x); }
}
__device__ __forceinline__ void ph_s5diag(const P& p, int g) {
    const float* KD = (const float*)(p.ws + WS_KD); bf16* TCV = (bf16*)(p.ws + WS_TCV) + (size_t)g * 256 * 512;
    for (int i = threadIdx.x; i < 4096; i += 512) { const int ii = i >> 8, pp = (i >> 4) & 15, q = i & 15;
        const float v = KD[g * 256 + pp * 16 + q] + KD[(32 + g) * 256 + pp * 16 + q] + (pp == q ? p.in[16][g * 16 + pp] : 0.f);
        TCV[(ii * 16 + pp) * 512 + ii * 16 + q] = f2bf(v); }
}
__device__ __forceinline__ void ph_s5scan(const P& p, int bx, int G, float* L) {
    const int n = threadIdx.x & 63, s = threadIdx.x >> 6;
    for (int w = bx; w < 256; w += G) { const int b = w >> 6, g = (w >> 1) & 31, dir = w & 1, dg = dir * 32 + g;
        const float lr = p.in[9][dg * 64 + n], li = p.in[10][dg * 64 + n], step = expf(p.in[11][dg]); const float zr = 16.f * lr * step, zi = 16.f * li * step, ez = expf(zr);
        float sn_, cs_; sincosf(zi, &sn_, &cs_); const float ar = ez * cs_, ai = ez * sn_;
        const float ez64 = expf(64.f * zr); sincosf(64.f * zi, &sn_, &cs_); const float Ar = ez64 * cs_, Ai = ez64 * sn_;
        const bf16* sl = (const bf16*)(p.ws + WS_SL) + (size_t)g * NCHUNK_PAD * 256 + dir * 128 + 2 * n;
        bf16* hh = (bf16*)(p.ws + WS_UH) + (size_t)g * NCHUNK_PAD * 512 + 256 + dir * 128 + 2 * n;
        const int k0 = dir ? 511 - 64 * s : 64 * s; const long inc = dir ? -1 : 1;
        const bf16* pc = sl + (size_t)(2048 + b * 16 + (dir ? 15 : 0)) * 256; const bf16* ps = sl + (size_t)(b * 512 + k0) * 256; bf16* ph = hh + (size_t)(b * 512 + k0) * 512;
        unsigned vc[16], v[64];
#pragma unroll
        for (int u = 0; u < 16; ++u) { vc[u] = *(const unsigned*)pc; pc += inc * 256; asm volatile("" : "+v"(pc)); }
#pragma unroll
        for (int u = 0; u < 64; ++u) { v[u] = *(const unsigned*)ps; ps += inc * 256; asm volatile("" : "+v"(ps)); }
        float c0r = 0.f, c0i = 0.f;
#pragma unroll
        for (int u = 0; u < 16; ++u) { const float x = __uint_as_float(vc[u] << 16), y = __uint_as_float(vc[u] & 0xffff0000u); const float nr = ar * c0r - ai * c0i + x, ni = ar * c0i + ai * c0r + y; c0r = nr; c0i = ni; }
        float sr = 0.f, si = 0.f;
#pragma unroll
        for (int u = 0; u < 64; ++u) { const float x = __uint_as_float(v[u] << 16), y = __uint_as_float(v[u] & 0xffff0000u); const float nr = ar * sr - ai * si + x, ni = ar * si + ai * sr + y; sr = nr; si = ni; }
        L[(s * 64 + n) * 2] = sr; L[(s * 64 + n) * 2 + 1] = si;
        __syncthreads();
        sr = c0r; si = c0i;
        for (int t = 0; t < s; ++t) { const float x = L[(t * 64 + n) * 2], y = L[(t * 64 + n) * 2 + 1]; const float nr = Ar * sr - Ai * si + x, ni = Ar * si + Ai * sr + y; sr = nr; si = ni; }
#pragma unroll
        for (int u = 0; u < 64; ++u) { *(unsigned*)ph = pk2(sr, si); ph += inc * 512; asm volatile("" : "+v"(ph));
            const float x = __uint_as_float(v[u] << 16), y = __uint_as_float(v[u] & 0xffff0000u); const float nr = ar * sr - ai * si + x, ni = ar * si + ai * sr + y; sr = nr; si = ni; }
        __syncthreads();
    }
}

__global__ void __launch_bounds__(NWAVES * 64, 2) mk_fwd(P p, int ph_lo, int ph_hi) {
    extern __shared__ __attribute__((aligned(16))) unsigned char lds_raw[];
    LAS unsigned char* lds = (LAS unsigned char*)lds_raw;
    const int tid = threadIdx.x, G = gridDim.x, bx = blockIdx.x;
    const int vcu = (G % 8 == 0) ? (bx % 8) * (G / 8) + bx / 8 : bx;
    for (int u = tid; u < 64; u += NWAVES * 64) ((LAS unsigned*)(lds + LDSCTL_OFF))[u] = 0u;
    __syncthreads();
    unsigned* barw = (unsigned*)(p.ws + WS_CTL) + 4096;
    XcdBarrier bar; bar.bar = barw; bar.x = 0; bar.st = nullptr;
    if (ph_hi - ph_lo > 1) bar = xcd_barrier_post(barw, (volatile LAS unsigned*)(lds + LDSCTL_OFF) + 8);
#define IN(k) (ph_lo <= (k) && (k) < ph_hi)
#define PH(k) if (IN(k))
#define SEAM(k) do { if (IN(k) && IN((k) + 1)) xcd_barrier(bar); } while (0)

    PH(0) { if (bx < 64) ph_s5tab(p, bx >> 1, bx & 1, (float*)lds_raw); else if (bx < 160) ph_mod(p, bx - 64, 96, (float*)lds_raw); ph_rope(p, bx, G); __syncthreads(); ph_wconv(p, bx, lds); }
    SEAM(0);
    PH(1) { ph_h1(p, bx, G); if (bx < 32) ph_s5diag(p, bx); }
    SEAM(1);
    PH(2) {
        pg8::GemmG g{(const char*)(p.ws + WS_H1), (const char*)(p.ws + WS_WIN), 128, (size_t)128 * 1024, (size_t)256 * 1024, 512, 512, nullptr, 0u};
        pg8::SchedProj S; S.init(G, bx);
        pg8::EpiProj E{(bf16*)(p.ws + WS_UH), (bf16*)(p.ws + WS_KB), (bf16*)(p.ws + WS_VB), (bf16*)(p.ws + WS_QB), (unsigned char*)(p.ws + WS_GT), p.in[20], p.in[21], (const float*)(p.ws + WS_ROPE),
                       (const float*)(p.ws + WS_H1S), (const float*)(p.ws + WS_WINS)};
        pg8::gemm_phase<pg8::EpiProj, pg8::SchedProj, pg8::AoRow, false, true, true>(lds + RING_OFF, g, pg8::AoRow{512}, S, E);
    }
    SEAM(2);
    PH(3) {
        pg8::GemmG g{(const char*)(p.ws + WS_UH), (const char*)(p.ws + WS_WS5), 128, (size_t)128 * 512 * 2, (size_t)256 * 512 * 2, 256, 256, nullptr, 0u};
        pg8::SchedS5 S{9, G, bx};
        pg8::EpiSloc E{(bf16*)(p.ws + WS_SL)};
        pg8::gemm_phase(lds + RING_OFF, g, pg8::AoRow{512}, S, E);
    }
    SEAM(3);
    PH(4) { ph_s5scan(p, bx, G, (float*)lds_raw); }
    SEAM(4);
    PH(5) {
        pg8::GemmG g{(const char*)(p.ws + WS_UH), (const char*)(p.ws + WS_TCV), 128, (size_t)128 * 512 * 2, (size_t)256 * 512 * 2, 512, 512, nullptr, 0u};
        pg8::SchedS5 S{8, G, bx};
        pg8::EpiS5Y E{(bf16*)(p.ws + WS_SG)};
        pg8::gemm_phase(lds + RING_OFF, g, pg8::AoRow{512}, S, E);
    }
    PH(6) {
        float gq = 0.f, gk = 0.f;
        for (int d = 0; d < 64; ++d) { gq = fmaxf(gq, fabsf(p.in[20][d])); gk = fmaxf(gk, fabsf(p.in[21][d])); }
        const float mref = 64.f * C2 * gq * gk * 1.02f + 0.05f;
        const attn_body::AttnTensors AT{(const attn_body::bf16*)(p.ws + WS_QB), (const attn_body::bf16*)(p.ws + WS_KB), (const attn_body::bf16*)(p.ws + WS_VB), (attn_body::bf16*)(p.ws + WS_GO) + 512, mref};
        const attn_body::StaticOrder S(G, bx);
        attn_body::attn_phase<attn_body::StaticOrder>((char*)lds_raw + RING_OFF, AT, S);
    }
    SEAM(6);
    PH(7) {
        pg8::GemmG g{(const char*)(p.ws + WS_SG), (const char*)(p.ws + WS_WGLU), (size_t)4 * T * 32, (size_t)128 * 32, (size_t)256 * 32, 512, 512, nullptr, 0u};
        pg8::StaticOrder S; S.init(T, 512, G, bx);
        pg8::EpiGlu E{(const bf16*)(p.ws + WS_SG), p.in[18], (bf16*)(p.ws + WS_GO)};
        pg8::gemm_phase(lds + RING_OFF, g, pg8::AoGrp{}, S, E);
    }
    SEAM(7);
    PH(8) {
        pg8::StaticOrder S; S.init(T, 1024, G, bx);
        { pg8::GemmG g{(const char*)(p.ws + WS_GO), (const char*)(p.ws + WS_W12), 128, (size_t)128 * 1024 * 2, (size_t)256 * 1024 * 2, 1024, 512, nullptr, 0u};
          pg8::EpiMerge<0> E{(const unsigned char*)(p.ws + WS_GT), (bf16*)(p.ws + WS_M1), (bf16*)(p.ws + WS_MG)};
          pg8::gemm_phase(lds + RING_OFF, g, pg8::AoRow{1024}, S, E); }
        { pg8::GemmG g{(const char*)(p.ws + WS_GO) + 1024, (const char*)(p.ws + WS_W12) + 1024, 128, (size_t)128 * 1024 * 2, (size_t)256 * 1024 * 2, 1024, 512, nullptr, 0u};
          pg8::EpiMerge<1> E{(const unsigned char*)(p.ws + WS_GT), (bf16*)(p.ws + WS_M1), (bf16*)(p.ws + WS_MG)};
          pg8::gemm_phase(lds + RING_OFF, g, pg8::AoRow{1024}, S, E); }
    }
    SEAM(8);
    PH(9) {
        pg8::GemmG g{(const char*)(p.ws + WS_MG), (const char*)(p.ws + WS_WOUT), 128, (size_t)128 * 1024 * 2, (size_t)256 * 1024 * 2, 1024, 1024, nullptr, 0u};
        pg8::StaticOrder S; S.init(T, 1024, G, bx);
        pg8::EpiOut E{p.in[0], (const float*)(p.ws + WS_MOD), (bf16*)(p.ws + WS_XM)};
        pg8::gemm_phase(lds + RING_OFF, g, pg8::AoRow{1024}, S, E);
    }
    SEAM(9);
    PH(10) { ph_route_a(p, bx, G, (float*)lds_raw); }
    SEAM(10);
    PH(11) { ph_route_b(p, bx, G, (int*)lds_raw); }
    SEAM(11);
    if (IN(12) || IN(13)) {
        const int* TILE_E = (const int*)(p.ws + WS_TILE); LAS int* lt = (LAS int*)(lds + LDS_TILE_OFF);
        for (int i = tid; i < 1024; i += NWAVES * 64) lt[i] = TILE_E[i];
        __syncthreads();
    }
    PH(12) {
        const LAS int* lt = (const LAS int*)(lds + LDS_TILE_OFF);
        pg8::GemmG g{(const char*)(p.ws + WS_H2), (const char*)(p.ws + WS_WGQ), 128, 0, 0, 512, 512, (const int*)(p.ws + WS_SLOTTOK), 1024u};
        pg8::SchedMoE S{lt, lt[1023], 8, G, bx, 0};
        pg8::EpiGU8 E{p.in[27], (const float*)(p.ws + WS_SLOTSA), (const float*)(p.ws + WS_WGS), (bf16*)(p.ws + WS_ACT)};
        pg8::gemm_phase<pg8::EpiGU8, pg8::SchedMoE, pg8::AoRow, true, true, true>(lds + RING_OFF, g, pg8::AoRow{512}, S, E);
    }
    SEAM(12);
    PH(13) {
        const LAS int* lt = (const LAS int*)(lds + LDS_TILE_OFF);
        pg8::GemmG g{(const char*)(p.ws + WS_ACT), (const char*)(p.ws + WS_WD), 128, (size_t)128 * 1024 * 2, (size_t)256 * 1024 * 2, 1024, 1024, nullptr, 0u};
        pg8::SchedMoE S{lt, lt[1023], 4, G, bx, 1};
        pg8::EpiDown E{p.in[29], (const float*)(p.ws + WS_SLOTGATE), (bf16*)(p.ws + WS_YB)};
        pg8::gemm_phase(lds + RING_OFF, g, pg8::AoRow{1024}, S, E);
    }
    SEAM(13);
    PH(14) { ph_final(p, bx, G); }
#undef IN
#undef PH
#undef SEAM
}

extern "C" void kernel_launch(void* const* d_in, const int* in_sizes, int n_in, void* d_out, int out_size, void* d_ws, size_t ws_size, hipStream_t stream) {
    if (n_in != 31 || out_size != T * DM || ws_size < WS_END) { fprintf(stderr, "kernel_launch: unexpected shapes (n_in %d out %d ws %zu)\n", n_in, out_size, ws_size); return; }
    static int grid = 0;
    if (!grid) {
        int dev = 0, cus = 0, per_cu = 0;
        (void)hipGetDevice(&dev); (void)hipDeviceGetAttribute(&cus, hipDeviceAttributeMultiprocessorCount, dev);
        (void)hipFuncSetAttribute((const void*)mk_fwd, hipFuncAttributeMaxDynamicSharedMemorySize, LDS_BYTES);
        (void)hipOccupancyMaxActiveBlocksPerMultiprocessor(&per_cu, (const void*)mk_fwd, NWAVES * 64, LDS_BYTES);
        (void)hipGetLastError();
        if (cus != 256 || per_cu < 1) fprintf(stderr, "kernel_launch: note: %d CUs, occupancy query %d; this kernel is built for one 512-thread workgroup on each of 256 CUs\n", cus, per_cu);
        grid = 256;
    }
    P p{}; for (int i = 0; i < 31; ++i) p.in[i] = (const float*)d_in[i]; p.out = (float*)d_out; p.ws = (unsigned char*)d_ws;
    (void)hipMemsetAsync((char*)d_ws + WS_CTL, 0, 1 * MiB, stream);
    hipLaunchKernelGGL(mk_fwd, dim3(grid), dim3(NWAVES * 64), LDS_BYTES, stream, p, 0, 15);
}
```

```cpp
#include <hip/hip_runtime.h>
#include <cstdio>
#include <cstdint>

constexpr int NB = 4, SEQ = 8192, DM = 1024, LC = 256;
constexpr int T = NB * SEQ;
constexpr int TC = NB * LC;
constexpr int TR = T + TC;
constexpr int DIN = 3328, COL_K = 512, COL_V = 640, COL_Q = 768, COL_GATE = 1280;
constexpr int NMOD = 6 * DM;
constexpr int SKV = LC + SEQ;
constexpr int NE = 32;
constexpr int NSLOT_MAX = 139264;
constexpr int NCHUNK_PAD = 2304;
constexpr float EPS = 1e-6f;
constexpr float C2 = 0.125f * 1.4426950408889634f;

constexpr size_t MiB = 1u << 20;
constexpr size_t WS_CTL = 0;
constexpr size_t WS_MOD = 1 * MiB;
constexpr size_t WS_ROPE = 1 * MiB + 256 * 1024;
constexpr size_t WS_WCNT = 2 * MiB;
constexpr size_t WS_BCNT = 2 * MiB + 256 * 1024;
constexpr size_t WS_KD = 2 * MiB + 384 * 1024;
constexpr size_t WS_TILE = 2 * MiB + 512 * 1024;
constexpr size_t WS_WIN = 4 * MiB, WS_WGLU = 11 * MiB, WS_W12 = 12 * MiB, WS_WOUT = 14 * MiB;
constexpr size_t WS_TCV = 16 * MiB, WS_WS5 = 24 * MiB;
constexpr size_t WS_WGU = 32 * MiB, WS_WD = 160 * MiB;
constexpr size_t WS_SL = 733 * MiB;
constexpr size_t WS_TOPI = 28 * MiB, WS_TOPG = 28 * MiB + 512 * 1024, WS_TOKSLOT = 29 * MiB;
constexpr size_t WS_SLOTTOK = 29 * MiB + 512 * 1024, WS_SLOTGATE = 30 * MiB + 512 * 1024;
constexpr size_t WS_XM = 224 * MiB;
constexpr size_t WS_H2 = 352 * MiB;
constexpr size_t WS_H2S = 384 * MiB;
constexpr size_t WS_SLOTSA = 385 * MiB;
constexpr size_t WS_WGQ = 288 * MiB;
constexpr size_t WS_WGS = 3 * MiB;
constexpr size_t WS_H1 = 417 * MiB;
constexpr size_t WS_H1S = 451 * MiB;
constexpr size_t WS_WINS = 3 * MiB + 256 * 1024;
constexpr size_t WS_UH = 483 * MiB;
constexpr size_t WS_KB = 555 * MiB, WS_VB = 564 * MiB;
constexpr size_t WS_QB = 573 * MiB;
constexpr size_t WS_GT = 605 * MiB;
constexpr size_t WS_SG = 769 * MiB;
constexpr size_t WS_GO = 801 * MiB;
constexpr size_t WS_M1 = 865 * MiB;
constexpr size_t WS_MG = 417 * MiB;
constexpr size_t WS_ACT = 417 * MiB;
constexpr size_t WS_YB = 689 * MiB;
constexpr size_t WS_END = 993 * MiB;

typedef unsigned short bf16;
struct P { const float* in[31]; float* out; unsigned char* ws; };

__device__ __forceinline__ float bf2f(bf16 v) { return __uint_as_float(((unsigned)v) << 16); }
__device__ __forceinline__ bf16 f2bf(float f) { unsigned u = __float_as_uint(f); return (bf16)((u + 0x7fffu + ((u >> 16) & 1u)) >> 16); }
__device__ __forceinline__ unsigned pk2(float lo, float hi) { return (unsigned)f2bf(lo) | ((unsigned)f2bf(hi) << 16); }
__device__ __forceinline__ float wave_sum(float v) {
#pragma unroll
    for (int o = 1; o < 64; o <<= 1) v += __shfl_xor(v, o);
    return v;
}
__device__ __forceinline__ float sigmoidf(float v) { return 1.f / (1.f + expf(-v)); }

__device__ __forceinline__ void ph_mod(const P& p, int bid, int nb, float* lds) {
    float* s = lds; float* red = lds + 5 * 1024;
    const float* c = p.in[1]; const float* cc = p.in[3];
    for (int i = threadIdx.x; i < 5 * 1024; i += 512) { const float v = i < 4096 ? c[i] : cc[i - 4096]; s[i] = v / (1.f + expf(-v)); }
    __syncthreads();
    const float* w = p.in[4]; const float* bm = p.in[5]; float* mod = (float*)(p.ws + WS_MOD);
    const int jl = threadIdx.x & 63, ks = threadIdx.x >> 6;
    for (int it = bid; it < 96; it += nb) {
        const int j = it * 64 + jl;
        float a0 = 0.f, a1 = 0.f, a2 = 0.f, a3 = 0.f, a4 = 0.f;
        for (int k0 = ks * 128; k0 < ks * 128 + 128; k0 += 32) { float wv[32];
#pragma unroll
            for (int q = 0; q < 32; ++q) wv[q] = w[(size_t)(k0 + q) * NMOD + j];
#pragma unroll
            for (int q = 0; q < 32; ++q) { const int k = k0 + q; a0 += s[k] * wv[q]; a1 += s[1024 + k] * wv[q]; a2 += s[2048 + k] * wv[q]; a3 += s[3072 + k] * wv[q]; a4 += s[4096 + k] * wv[q]; }
        }
        red[(ks * 5 + 0) * 64 + jl] = a0; red[(ks * 5 + 1) * 64 + jl] = a1; red[(ks * 5 + 2) * 64 + jl] = a2; red[(ks * 5 + 3) * 64 + jl] = a3; red[(ks * 5 + 4) * 64 + jl] = a4;
        __syncthreads();
        if (threadIdx.x < 320) { const int r = threadIdx.x >> 6; float t = 0.f;
            for (int q = 0; q < 8; ++q) t += red[(q * 5 + r) * 64 + jl];
            mod[r * NMOD + j] = t + bm[j]; }
        __syncthreads();
    }
}
__device__ __forceinline__ void ph_rope(const P& p, int bid, int nb) {
    float* R = (float*)(p.ws + WS_ROPE);
    for (int i = bid * 512 + threadIdx.x; i < 192 * 16; i += nb * 512) {
        const int j = i & 15; const int pos = i >> 4;
        const float invf = powf(10000.f, -(float)j / 16.f);
        if (pos < 128) { const float a = (float)pos * invf; R[pos * 16 + j] = cosf(a); R[2048 + pos * 16 + j] = sinf(a); }
        else { const int cp = pos - 128; const float a = (float)cp * invf; R[4096 + cp * 16 + j] = cosf(a); R[5120 + cp * 16 + j] = sinf(a); }
    }
}
__device__ __forceinline__ void ph_h1_row(const float4 (&v)[4], const float4 (&gf)[4], const float4 (&sh)[4], signed char* orow, float* oscale, int lane) {
    float ss = 0.f;
#pragma unroll
    for (int j = 0; j < 4; ++j) ss += v[j].x * v[j].x + v[j].y * v[j].y + v[j].z * v[j].z + v[j].w * v[j].w;
    ss = wave_sum(ss); const float rs = 1.f / sqrtf(ss * (1.f / DM) + EPS); float h[4][4]; float am = 0.f;
#pragma unroll
    for (int j = 0; j < 4; ++j) { h[j][0] = v[j].x * rs * gf[j].x + sh[j].x; h[j][1] = v[j].y * rs * gf[j].y + sh[j].y; h[j][2] = v[j].z * rs * gf[j].z + sh[j].z; h[j][3] = v[j].w * rs * gf[j].w + sh[j].w;
        am = fmaxf(fmaxf(am, fmaxf(fabsf(h[j][0]), fabsf(h[j][1]))), fmaxf(fabsf(h[j][2]), fabsf(h[j][3]))); }
#pragma unroll
    for (int o = 1; o < 64; o <<= 1) am = fmaxf(am, __shfl_xor(am, o));
    const float inv = am > 0.f ? 127.f / am : 0.f;
#pragma unroll
    for (int j = 0; j < 4; ++j) { const int q0 = __float2int_rn(h[j][0] * inv), q1 = __float2int_rn(h[j][1] * inv), q2 = __float2int_rn(h[j][2] * inv), q3 = __float2int_rn(h[j][3] * inv);
        *(unsigned*)(orow + 4 * lane + 256 * j) = (unsigned)(q0 & 255) | ((unsigned)(q1 & 255) << 8) | ((unsigned)(q2 & 255) << 16) | ((unsigned)(q3 & 255) << 24); }
    if (lane == 0) *oscale = am * (1.f / 127.f);
}
__device__ __forceinline__ void ph_h1(const P& p, int bid, int nb) {
    const int lane = threadIdx.x & 63, wave = threadIdx.x >> 6, gw = bid * 8 + wave, ngw = nb * 8;
    const float* g = p.in[6]; const float* mod = (const float*)(p.ws + WS_MOD); signed char* H1 = (signed char*)(p.ws + WS_H1); float* H1S = (float*)(p.ws + WS_H1S);
    const int rpw = T / ngw;
    float4 gf[4], sh[4], v[4], v1[4], v2[4];
#define H1_MOD(mrow) do { _Pragma("unroll") for (int j = 0; j < 4; ++j) { const int col = 4 * lane + 256 * j; const float4 gg = *(const float4*)(g + col), sc = *(const float4*)(mod + (mrow) * NMOD + 1024 + col); \
        sh[j] = *(const float4*)(mod + (mrow) * NMOD + col); gf[j] = make_float4(gg.x * (1.f + sc.x), gg.y * (1.f + sc.y), gg.z * (1.f + sc.z), gg.w * (1.f + sc.w)); } } while (0)
#define H1_LOAD(V, xr) do { _Pragma("unroll") for (int j = 0; j < 4; ++j) V[j] = ((const float4*)(xr))[lane + 64 * j]; } while (0)
    const int r0 = gw * rpw; const float* x0 = p.in[0] + (size_t)r0 * DM;
    H1_LOAD(v, x0); H1_LOAD(v1, x0 + DM);
    H1_MOD(r0 / SEQ);
    for (int k = 0; k < rpw; ++k) {
        if (k + 2 < rpw) H1_LOAD(v2, x0 + (size_t)(k + 2) * DM);
        ph_h1_row(v, gf, sh, H1 + (size_t)(r0 + k) * DM, H1S + r0 + k, lane);
#pragma unroll
        for (int j = 0; j < 4; ++j) { v[j] = v1[j]; v1[j] = v2[j]; }
    }
    for (int rc = gw; rc < TC; rc += ngw) { H1_LOAD(v, p.in[2] + (size_t)rc * DM); H1_MOD(4); ph_h1_row(v, gf, sh, H1 + (size_t)(T + rc) * DM, H1S + T + rc, lane); }
#undef H1_LOAD
#undef H1_MOD
}
__device__ __forceinline__ void ph_wgquant(const P& p, int bid, int nb) {
    const int lane = threadIdx.x & 63, wave = threadIdx.x >> 6, gw = bid * 8 + wave, ngw = nb * 8;
    const bf16* WG = (const bf16*)(p.ws + WS_WGU); signed char* WQ = (signed char*)(p.ws + WS_WGQ); float* WS = (float*)(p.ws + WS_WGS);
    constexpr int NROWS = 32 * 2048; const int rpw = NROWS / ngw, r0 = gw * rpw;
    uint4 va[2], vb[2], vc[2];
#define WQ_LOAD(V, r) do { const uint4* s_ = (const uint4*)(WG + (size_t)(r) * 1024) + 2 * lane; V[0] = s_[0]; V[1] = s_[1]; } while (0)
    WQ_LOAD(va, r0); WQ_LOAD(vb, r0 + 1);
    for (int k = 0; k < rpw; ++k) { if (k + 2 < rpw) WQ_LOAD(vc, r0 + k + 2);
        const unsigned w[8] = {va[0].x, va[0].y, va[0].z, va[0].w, va[1].x, va[1].y, va[1].z, va[1].w}; float f[16]; float am = 0.f;
#pragma unroll
        for (int j = 0; j < 8; ++j) { f[2 * j] = __uint_as_float(w[j] << 16); f[2 * j + 1] = __uint_as_float(w[j] & 0xffff0000u); am = fmaxf(am, fmaxf(fabsf(f[2 * j]), fabsf(f[2 * j + 1]))); }
#pragma unroll
        for (int o = 1; o < 64; o <<= 1) am = fmaxf(am, __shfl_xor(am, o));
        const float inv = am > 0.f ? 127.f / am : 0.f; unsigned o4[4];
#pragma unroll
        for (int j = 0; j < 4; ++j) { const int q0 = __float2int_rn(f[4 * j] * inv), q1 = __float2int_rn(f[4 * j + 1] * inv), q2 = __float2int_rn(f[4 * j + 2] * inv), q3 = __float2int_rn(f[4 * j + 3] * inv);
            o4[j] = (unsigned)(q0 & 255) | ((unsigned)(q1 & 255) << 8) | ((unsigned)(q2 & 255) << 16) | ((unsigned)(q3 & 255) << 24); }
        *(uint4*)(WQ + (size_t)(r0 + k) * 1024 + 16 * lane) = make_uint4(o4[0], o4[1], o4[2], o4[3]);
        if (lane == 0) WS[r0 + k] = am * (1.f / 127.f);
        va[0] = vb[0]; va[1] = vb[1]; vb[0] = vc[0]; vb[1] = vc[1]; }
#undef WQ_LOAD
}
typedef short rt_bf16x8 __attribute__((ext_vector_type(8)));
typedef float rt_f32x4 __attribute__((ext_vector_type(4)));
typedef unsigned rt_u32x4 __attribute__((ext_vector_type(4)));
typedef float rt_f32x2 __attribute__((ext_vector_type(2))); typedef __bf16 rt_bf16x2 __attribute__((ext_vector_type(2)));
__device__ __forceinline__ unsigned rt_pk(float lo, float hi) { const rt_f32x2 v = {lo, hi}; const rt_bf16x2 b = __builtin_convertvector(v, rt_bf16x2); return __builtin_bit_cast(unsigned, b); }
__device__ __forceinline__ void ph_route_a(const P& p, int bid, int nb, float* ldsf) {
    typedef __attribute__((address_space(3))) unsigned char lds_b;
    lds_b* lds = (lds_b*)ldsf;
    const int tid = threadIdx.x, lane = tid & 63, wave = tid >> 6, gw = bid * 8 + wave;
    const int rpw = 16; const int r0 = gw * rpw, b = (bid * 8 * rpw) / SEQ;
    const float* rw = p.in[24]; const float* g = p.in[7]; const float* mod = (const float*)(p.ws + WS_MOD); const bf16* XM = (const bf16*)(p.ws + WS_XM);
    signed char* H2 = (signed char*)(p.ws + WS_H2); float* H2S = (float*)(p.ws + WS_H2S); int* TOPI = (int*)(p.ws + WS_TOPI); float* TOPG = (float*)(p.ws + WS_TOPG); int* WCNT = (int*)(p.ws + WS_WCNT);
    float* ggs = ldsf + 32768 + 2048; float* shs = ggs + 1024; float* biasp = ldsf + 32768 + 512; float* red = ldsf + 32768 + 1024;
    if (bid == 0) { for (int i = tid; i < 256; i += 512) ((unsigned*)(H2 + (size_t)T * DM))[i] = 0u; if (tid == 0) H2S[T] = 0.f; }
    for (int c = tid; c < 1024; c += 512) { ggs[c] = g[c] * (1.f + mod[b * NMOD + 4096 + c]); shs[c] = mod[b * NMOD + 3072 + c]; }
    __syncthreads();
    { const int e = tid & 31, part = tid >> 5;
      float a = 0.f;
#pragma unroll 8
      for (int k = part * 64; k < part * 64 + 64; ++k) a += shs[k] * rw[k * 32 + e];
      red[part * 32 + e] = a; }
    for (int it = tid; it < 4096; it += 512) { const int e = it & 31, c = it >> 5;
        float w[8];
#pragma unroll
        for (int j = 0; j < 8; ++j) w[j] = rw[(8 * c + j) * 32 + e] * ggs[8 * c + j];
        unsigned hi[4], lo[4];
#pragma unroll
        for (int j = 0; j < 4; ++j) { hi[j] = rt_pk(w[2 * j], w[2 * j + 1]); lo[j] = rt_pk(w[2 * j] - __uint_as_float(hi[j] << 16), w[2 * j + 1] - __uint_as_float(hi[j] & 0xffff0000u)); }
        const int off = (e * 1024 + ((c ^ (e & 15)) << 3)) * 2;
        *(__attribute__((address_space(3))) rt_u32x4*)(lds + off) = (rt_u32x4){hi[0], hi[1], hi[2], hi[3]};
        *(__attribute__((address_space(3))) rt_u32x4*)(lds + 65536 + off) = (rt_u32x4){lo[0], lo[1], lo[2], lo[3]}; }
    __syncthreads();
    if (tid < 32) { float a = p.in[25][tid]; for (int q = 0; q < 16; ++q) a += red[q * 32 + tid]; biasp[tid] = a; }
    __syncthreads();
    const int r = lane & 15, kq = lane >> 4;
    const bf16* xp = XM + (size_t)(r0 + r) * DM + 8 * kq;
    rt_f32x4 acc0 = {0.f, 0.f, 0.f, 0.f}, acc1 = {0.f, 0.f, 0.f, 0.f}; float ss = 0.f;
#pragma unroll 4
    for (int ks = 0; ks < 32; ++ks) {
        const rt_u32x4 xw = *(const rt_u32x4*)(xp + 32 * ks);
#pragma unroll
        for (int j = 0; j < 4; ++j) { const float a0 = __uint_as_float(xw[j] << 16), a1 = __uint_as_float(xw[j] & 0xffff0000u); ss += a0 * a0 + a1 * a1; }
        const rt_bf16x8 Ah = __builtin_bit_cast(rt_bf16x8, xw);
        const int c = 4 * ks + kq;
        const int o0 = (r * 1024 + ((c ^ r) << 3)) * 2, o1 = ((16 + r) * 1024 + ((c ^ r) << 3)) * 2;
        const rt_bf16x8 Bh0 = *(const __attribute__((address_space(3))) rt_bf16x8*)(lds + o0), Bl0 = *(const __attribute__((address_space(3))) rt_bf16x8*)(lds + 65536 + o0);
        const rt_bf16x8 Bh1 = *(const __attribute__((address_space(3))) rt_bf16x8*)(lds + o1), Bl1 = *(const __attribute__((address_space(3))) rt_bf16x8*)(lds + 65536 + o1);
        acc0 = __builtin_amdgcn_mfma_f32_16x16x32_bf16(Ah, Bh0, acc0, 0, 0, 0); acc1 = __builtin_amdgcn_mfma_f32_16x16x32_bf16(Ah, Bh1, acc1, 0, 0, 0);
        acc0 = __builtin_amdgcn_mfma_f32_16x16x32_bf16(Ah, Bl0, acc0, 0, 0, 0); acc1 = __builtin_amdgcn_mfma_f32_16x16x32_bf16(Ah, Bl1, acc1, 0, 0, 0);
    }
    ss += __shfl_xor(ss, 16); ss += __shfl_xor(ss, 32);
    const float rs = 1.f / sqrtf(ss * (1.f / DM) + EPS);
    const int e0 = r, e1 = 16 + r; const float bp0 = biasp[e0], bp1 = biasp[e1];
    float lg0[4], lg1[4];
#pragma unroll
    for (int q = 0; q < 4; ++q) { const float rst = __shfl(rs, 4 * kq + q); lg0[q] = acc0[q] * rst + bp0; lg1[q] = acc1[q] * rst + bp1; }
    float tv[4][4]; int ti[4][4]; int cnt0 = 0, cnt1 = 0;
#pragma unroll
    for (int k = 0; k < 4; ++k) {
#pragma unroll
        for (int q = 0; q < 4; ++q) { float m = lg0[q]; int mi = e0; if (lg1[q] > m) { m = lg1[q]; mi = e1; }
#pragma unroll
            for (int off = 1; off < 16; off <<= 1) { const float om = __shfl_xor(m, off); const int oi = __shfl_xor(mi, off); if (om > m || (om == m && oi < mi)) { m = om; mi = oi; } }
            tv[k][q] = m; ti[k][q] = mi; if (mi == e0) { lg0[q] = -INFINITY; ++cnt0; } if (mi == e1) { lg1[q] = -INFINITY; ++cnt1; } } }
    if (r == 0) {
#pragma unroll
        for (int q = 0; q < 4; ++q) { const int t = r0 + 4 * kq + q; const float x1 = expf(tv[1][q] - tv[0][q]), x2 = expf(tv[2][q] - tv[0][q]), x3 = expf(tv[3][q] - tv[0][q]); const float inv = 1.f / (1.f + x1 + x2 + x3);
            *(int4*)(TOPI + t * 4) = make_int4(ti[0][q], ti[1][q], ti[2][q], ti[3][q]); *(float4*)(TOPG + t * 4) = make_float4(inv, x1 * inv, x2 * inv, x3 * inv); } }
    cnt0 += __shfl_xor(cnt0, 16); cnt0 += __shfl_xor(cnt0, 32); cnt1 += __shfl_xor(cnt1, 16); cnt1 += __shfl_xor(cnt1, 32);
    if (kq == 0) { WCNT[gw * 32 + e0] = cnt0; WCNT[gw * 32 + e1] = cnt1; }
    { float4 gf[4], sf[4]; uint2 v[4], v1[4], v2[4];
#pragma unroll
      for (int j = 0; j < 4; ++j) { gf[j] = *(const float4*)(ggs + 4 * lane + 256 * j); sf[j] = *(const float4*)(shs + 4 * lane + 256 * j); }
      const bf16* x0 = XM + (size_t)r0 * DM;
#define RT_LOAD(V, xr) do { _Pragma("unroll") for (int j = 0; j < 4; ++j) V[j] = ((const uint2*)(xr))[lane + 64 * j]; } while (0)
      RT_LOAD(v, x0); RT_LOAD(v1, x0 + DM);
      for (int k = 0; k < 16; ++k) { if (k + 2 < 16) RT_LOAD(v2, x0 + (size_t)(k + 2) * DM);
          const float rk = __shfl(rs, k); float h[4][4]; float am = 0.f;
#pragma unroll
          for (int j = 0; j < 4; ++j) { const float a0 = __uint_as_float(v[j].x << 16), a1 = __uint_as_float(v[j].x & 0xffff0000u), a2 = __uint_as_float(v[j].y << 16), a3 = __uint_as_float(v[j].y & 0xffff0000u);
              h[j][0] = a0 * rk * gf[j].x + sf[j].x; h[j][1] = a1 * rk * gf[j].y + sf[j].y; h[j][2] = a2 * rk * gf[j].z + sf[j].z; h[j][3] = a3 * rk * gf[j].w + sf[j].w;
              am = fmaxf(fmaxf(am, fmaxf(fabsf(h[j][0]), fabsf(h[j][1]))), fmaxf(fabsf(h[j][2]), fabsf(h[j][3]))); }
#pragma unroll
          for (int o = 1; o < 64; o <<= 1) am = fmaxf(am, __shfl_xor(am, o));
          const float inv = am > 0.f ? 127.f / am : 0.f;
#pragma unroll
          for (int j = 0; j < 4; ++j) { const int q0 = __float2int_rn(h[j][0] * inv), q1 = __float2int_rn(h[j][1] * inv), q2 = __float2int_rn(h[j][2] * inv), q3 = __float2int_rn(h[j][3] * inv);
              *(unsigned*)(H2 + (size_t)(r0 + k) * DM + 4 * lane + 256 * j) = (unsigned)(q0 & 255) | ((unsigned)(q1 & 255) << 8) | ((unsigned)(q2 & 255) << 16) | ((unsigned)(q3 & 255) << 24); }
          if (lane == 0) H2S[r0 + k] = am * (1.f / 127.f);
#pragma unroll
          for (int j = 0; j < 4; ++j) { v[j] = v1[j]; v1[j] = v2[j]; } }
#undef RT_LOAD
    }
    __syncthreads();
    int* li = (int*)ldsf; if (kq == 0) { li[wave * 32 + e0] = cnt0; li[wave * 32 + e1] = cnt1; }
    __syncthreads();
    if (tid < 32) { int a = 0; for (int w = 0; w < 8; ++w) a += li[w * 32 + tid]; ((int*)(p.ws + WS_BCNT))[bid * 32 + tid] = a; }
}
__device__ __forceinline__ void ph_route_b(const P& p, int bid, int nb, int* ldsI) {
    int* partT = ldsI; int* partB = ldsI + 512; int* total = ldsI + 1024; int* before = ldsI + 1056; int* pstart = ldsI + 1088;
    const int* WCNT = (const int*)(p.ws + WS_WCNT); const int* TOPI = (const int*)(p.ws + WS_TOPI); const float* TOPG = (const float*)(p.ws + WS_TOPG);
    int* SLOT_TOK = (int*)(p.ws + WS_SLOTTOK); float* SLOT_GATE = (float*)(p.ws + WS_SLOTGATE); int* TOK_SLOT = (int*)(p.ws + WS_TOKSLOT); int* TILE_E = (int*)(p.ws + WS_TILE);
    const float* H2S = (const float*)(p.ws + WS_H2S); float* SLOT_SA = (float*)(p.ws + WS_SLOTSA);
    const int t = threadIdx.x, e = t & 31, part = t >> 5, gw0 = bid * 8, nwav = nb * 8, per = nb / 16;
    const int* BCNT = (const int*)(p.ws + WS_BCNT);
    int sT = 0, sB = 0;
    { int c[16];
#pragma unroll
      for (int q = 0; q < 16; ++q) c[q] = (q < per) ? BCNT[(part * per + q) * 32 + e] : 0;
#pragma unroll
      for (int q = 0; q < 16; ++q) { sT += c[q]; if (part * per + q < bid) sB += c[q]; } }
    partT[part * 32 + e] = sT; partB[part * 32 + e] = sB;
    __syncthreads();
    if (t < 32) { int a = 0, bsum = 0; for (int q = 0; q < 16; ++q) { a += partT[q * 32 + t]; bsum += partB[q * 32 + t]; } total[t] = a; before[t] = bsum; }
    __syncthreads();
    if (t == 0) { int acc = 0; for (int q = 0; q < 32; ++q) { pstart[q] = acc; acc += ((total[q] + 255) / 256) * 256; } pstart[32] = acc; }
    __syncthreads();
    const int lane = t & 63, wave = t >> 6, my_e = (lane >> 1) & 31, rpw = T / nwav;
    int base = pstart[my_e] + before[my_e];
    for (int w = 0; w < wave; ++w) base += WCNT[(gw0 + w) * 32 + my_e];
    int run = 0;
    const int rb0 = (gw0 + wave) * rpw;
    for (int r8 = 0; r8 < rpw; r8 += 8) { int4 tiv[8]; float4 tgv[8]; float sav[8];
#pragma unroll
        for (int q = 0; q < 8; ++q) { tiv[q] = *(const int4*)(TOPI + (rb0 + r8 + q) * 4); tgv[q] = *(const float4*)(TOPG + (rb0 + r8 + q) * 4); sav[q] = H2S[rb0 + r8 + q]; }
#pragma unroll
        for (int q = 0; q < 8; ++q) { const int r = rb0 + r8 + q;
            const int tia[4] = {tiv[q].x, tiv[q].y, tiv[q].z, tiv[q].w}; const float tga[4] = {tgv[q].x, tgv[q].y, tgv[q].z, tgv[q].w}; int sl[4];
#pragma unroll
            for (int k = 0; k < 4; ++k) { const int ek = tia[k]; sl[k] = __shfl(base + run, 2 * ek); if (my_e == ek) run++; }
            if (lane == 0) { SLOT_TOK[sl[0]] = r; SLOT_TOK[sl[1]] = r; SLOT_TOK[sl[2]] = r; SLOT_TOK[sl[3]] = r;
                SLOT_GATE[sl[0]] = tga[0]; SLOT_GATE[sl[1]] = tga[1]; SLOT_GATE[sl[2]] = tga[2]; SLOT_GATE[sl[3]] = tga[3]; *(int4*)(TOK_SLOT + r * 4) = make_int4(sl[0], sl[1], sl[2], sl[3]);
                SLOT_SA[sl[0]] = sav[q]; SLOT_SA[sl[1]] = sav[q]; SLOT_SA[sl[2]] = sav[q]; SLOT_SA[sl[3]] = sav[q]; } }
    }
    if (bid == 0) {
        for (int q = wave; q < 32; q += 8) { const int ps = pstart[q], pe = pstart[q + 1];
            for (int s = ps + total[q] + lane; s < pe; s += 64) { SLOT_TOK[s] = T; SLOT_GATE[s] = 0.f; SLOT_SA[s] = 0.f; }
            for (int tl = ps / 256 + lane; tl < pe / 256; tl += 64) TILE_E[tl] = q; }
        if (t == 0) TILE_E[1023] = pstart[32] / 256;
    }
}
__device__ __forceinline__ void ph_final(const P& p, int bid, int nb) {
    const int lane = threadIdx.x & 63, wave = threadIdx.x >> 6, gw = bid * 8 + wave, ngw = nb * 8;
    const float* gfin = p.in[30]; const float* mod = (const float*)(p.ws + WS_MOD); const bf16* XM = (const bf16*)(p.ws + WS_XM);
    const bf16* YB = (const bf16*)(p.ws + WS_YB); const int* TOK_SLOT = (const int*)(p.ws + WS_TOKSLOT);
    float4 gf[4];
#pragma unroll
    for (int j = 0; j < 4; ++j) gf[j] = *(const float4*)(gfin + 4 * lane + 256 * j);
    uint2 yc[4][4], yn[4][4]; uint2 xc[4], xn[4]; int4 sl1, sl2;
#define FIN_LOAD(Y, X, SL, R) do { const int sla_[4] = {SL.x, SL.y, SL.z, SL.w}; _Pragma("unroll") for (int j = 0; j < 4; ++j) { const int col = 4 * lane + 256 * j; \
        X[j] = *(const uint2*)(XM + (size_t)(R) * DM + col); _Pragma("unroll") for (int k = 0; k < 4; ++k) Y[k][j] = *(const uint2*)(YB + (size_t)sla_[k] * DM + col); } } while (0)
    int r = gw;
    sl1 = *(const int4*)(TOK_SLOT + r * 4);
    FIN_LOAD(yc, xc, sl1, r);
    if (r + ngw < T) sl1 = *(const int4*)(TOK_SLOT + (r + ngw) * 4);
    for (; r < T; r += ngw) {
        const int rn = r + ngw, rnn = rn + ngw;
        if (rnn < T) sl2 = *(const int4*)(TOK_SLOT + rnn * 4);
        if (rn < T) FIN_LOAD(yn, xn, sl1, rn);
        const int b = r / SEQ; float4 v[4]; float ss = 0.f;
#pragma unroll
        for (int j = 0; j < 4; ++j) { const int col = 4 * lane + 256 * j; float f0 = 0.f, f1 = 0.f, f2 = 0.f, f3 = 0.f;
#pragma unroll
            for (int k = 0; k < 4; ++k) { const uint2 y = yc[k][j];
                f0 += __uint_as_float(y.x << 16); f1 += __uint_as_float(y.x & 0xffff0000u); f2 += __uint_as_float(y.y << 16); f3 += __uint_as_float(y.y & 0xffff0000u); }
            const float4 g2 = *(const float4*)(mod + b * NMOD + 5120 + col);
            v[j].x = __uint_as_float(xc[j].x << 16) + g2.x * f0; v[j].y = __uint_as_float(xc[j].x & 0xffff0000u) + g2.y * f1; v[j].z = __uint_as_float(xc[j].y << 16) + g2.z * f2; v[j].w = __uint_as_float(xc[j].y & 0xffff0000u) + g2.w * f3;
            ss += v[j].x * v[j].x + v[j].y * v[j].y + v[j].z * v[j].z + v[j].w * v[j].w; }
        ss = wave_sum(ss); const float rs = 1.f / sqrtf(ss * (1.f / DM) + EPS);
#pragma unroll
        for (int j = 0; j < 4; ++j) { const int col = 4 * lane + 256 * j;
            *(float4*)(p.out + (size_t)r * DM + col) = make_float4(v[j].x * rs * gf[j].x, v[j].y * rs * gf[j].y, v[j].z * rs * gf[j].z, v[j].w * rs * gf[j].w); }
#pragma unroll
        for (int j = 0; j < 4; ++j) { xc[j] = xn[j];
#pragma unroll
            for (int k = 0; k < 4; ++k) yc[k][j] = yn[k][j]; }
        sl1 = sl2;
    }
#undef FIN_LOAD
}

namespace pg8 {
#define PG8_LAS __attribute__((address_space(3)))
typedef unsigned short bf16_t;
typedef short bf16x8 __attribute__((ext_vector_type(8)));
typedef float f32x4 __attribute__((ext_vector_type(4)));
typedef unsigned u32x4 __attribute__((ext_vector_type(4)));
typedef int i32x4 __attribute__((ext_vector_type(4)));
typedef unsigned u32x2 __attribute__((ext_vector_type(2)));
template <bool I8> struct AccT { typedef f32x4 type; }; template <> struct AccT<true> { typedef i32x4 type; };
constexpr int BM = 256, BK = 64, HALF = 128, HTB = HALF * BK * 2  , STAGE_BYTES = 8 * HTB, NXCD = 8, WGM = 8;

__host__ __device__ __forceinline__ int lds_byte(int r, int c) { const int st = (r >> 4) * 2 + (c >> 5), rr = r & 15, cc = c & 31, ob = rr * 64 + cc * 2; return st * 1024 + (ob ^ (((ob >> 9) & 1) << 5)); }
__host__ __device__ __forceinline__ void stage_rc(int b, int& R, int& C) { const int st = b / 1024, sb = b % 1024, swz = sb ^ (((sb >> 9) & 1) << 5); R = (st >> 1) * 16 + swz / 64; C = (st & 1) * 32 + (swz % 64) / 2; }
__host__ __device__ __forceinline__ int perm32(int rho) { const int n = rho >> 4, i = rho & 15; return 8 * (i >> 2) + 4 * n + (i & 3); }

struct Unit { int pm, pn; };
struct GemmG { const char* A; const char* Bt; size_t a_kstep, a_hstep, a_tstep; int ldb; int K; const int* gidx; unsigned g_row; };
struct AoRow { int lda; __device__ __forceinline__ unsigned operator()(int R, int C) const { return (unsigned)(R * lda + C) * 2u; } };
struct AoGrp { __device__ __forceinline__ unsigned operator()(int R, int C) const { return (unsigned)(((C >> 4) * T + R) * 16 + (C & 15)) * 2u; } };

struct StaticOrder {
    int nM, nN, nwg, G, c;
    __host__ __device__ void init(int M, int N, int G_, int c_) { nM = M / BM; nN = N / BM; nwg = nM * nN; G = G_; c = c_; }
    __host__ __device__ bool next(int i, Unit& u) const {
        const long L = (long)i * G + c; if (L >= nwg) return false;
        int wgid = (int)L; { const int q = nwg / NXCD, r = nwg % NXCD, xcd = wgid % NXCD, off = wgid / NXCD; wgid = (xcd < r ? xcd * (q + 1) : r * (q + 1) + (xcd - r) * q) + off; }
        const int nig = WGM * nN, gid = wgid / nig, fm = gid * WGM, gsz = (nM - fm) < WGM ? (nM - fm) : WGM;
        u.pm = fm + ((wgid % nig) % gsz); u.pn = (wgid % nig) / gsz; return true;
    }
};
typedef float f32x2_t __attribute__((ext_vector_type(2))); typedef __bf16 bf16x2_t __attribute__((ext_vector_type(2)));
__device__ __forceinline__ unsigned cvt_pk_bf16(float lo, float hi) { const f32x2_t v = {lo, hi}; const bf16x2_t b = __builtin_convertvector(v, bf16x2_t); return __builtin_bit_cast(unsigned, b); }
__device__ __forceinline__ u32x4 pack8(const f32x4 a, const f32x4 b) { u32x4 w; w.x = cvt_pk_bf16(a[0], a[1]); w.y = cvt_pk_bf16(a[2], a[3]); w.z = cvt_pk_bf16(b[0], b[1]); w.w = cvt_pk_bf16(b[2], b[3]); return w; }
__device__ __forceinline__ f32x4 unpack_lo(const u32x4 w) { return (f32x4){__uint_as_float(w.x << 16), __uint_as_float(w.x & 0xffff0000u), __uint_as_float(w.y << 16), __uint_as_float(w.y & 0xffff0000u)}; }
__device__ __forceinline__ f32x4 unpack_hi(const u32x4 w) { return (f32x4){__uint_as_float(w.z << 16), __uint_as_float(w.z & 0xffff0000u), __uint_as_float(w.w << 16), __uint_as_float(w.w & 0xffff0000u)}; }
__device__ __forceinline__ float fsig(float v) { return __builtin_amdgcn_rcpf(1.f + __builtin_amdgcn_exp2f(-1.4426950408889634f * v)); }
__device__ __forceinline__ f32x4 fsig4(const f32x4 v) { return (f32x4){fsig(v[0]), fsig(v[1]), fsig(v[2]), fsig(v[3])}; }

template <class Epi, class Sched, class AO, bool GATHER = false, bool ALIGN_EPI = true, bool I8 = false>
__device__ __forceinline__ void gemm_phase(PG8_LAS unsigned char* lds, const GemmG g, const AO& ao, const Sched& S, const Epi& E) {
    const int tid = threadIdx.x, wid = __builtin_amdgcn_readfirstlane(tid >> 6), lane = tid & 63, wr = wid >> 2, wc = wid & 3, fr = lane & 15, fq = lane >> 4;
    const int K = g.K, nt = K / BK;
    unsigned voffB[2]; unsigned oc[2][2], on[2][2]; int RA[2]; unsigned CA2[2];
#pragma unroll
    for (int i = 0; i < 2; ++i) { int R, C; stage_rc(tid * 16 + i * 8192, R, C); const int Rb = (R & ~31) + perm32(R & 31);
        voffB[i] = (unsigned)(Rb * g.ldb + C) * 2u; RA[i] = R; CA2[i] = (unsigned)C * 2u;
        if constexpr (!GATHER) { oc[0][i] = ao(R, C); oc[1][i] = oc[0][i] + (unsigned)g.a_hstep; on[0][i] = oc[0][i]; on[1][i] = oc[1][i]; } }
    const size_t kstepA = g.a_kstep, kstepB = (size_t)(BK * 2);
    const size_t hstepB = (size_t)HALF * g.ldb * 2, tstepB = 2 * hstepB;
    const unsigned ldsw = (unsigned)wid * 1024u;
    const int aoff = lds_byte(wr * 64 + fr, fq * 8), boff = lds_byte(wc * 32 + fr, fq * 8);
#define PG8_SA(b, h) (((b) * 2 + (h)) * HTB)
#define PG8_SB(b, h) ((4 + (b) * 2 + (h)) * HTB)
#define PG8_STAGE_B(bufoff, gbase) do { _Pragma("unroll") for (int _i = 0; _i < 2; ++_i) \
        __builtin_amdgcn_global_load_lds((const unsigned*)((const char*)(gbase) + voffB[_i]), (PG8_LAS unsigned*)(lds + (bufoff) + ldsw + _i * 8192), 16, 0, 0); } while (0)
#define PG8_STAGE_A(bufoff, gbase, OFFS, h) do { _Pragma("unroll") for (int _i = 0; _i < 2; ++_i) \
        __builtin_amdgcn_global_load_lds((const unsigned*)((const char*)(gbase) + OFFS[h][_i]), (PG8_LAS unsigned*)(lds + (bufoff) + ldsw + _i * 8192), 16, 0, 0); } while (0)
#define PG8_LDA(dst, b, h) do { _Pragma("unroll") for (int m = 0; m < 4; ++m) _Pragma("unroll") for (int k = 0; k < 2; ++k) dst[m][k] = *(const PG8_LAS bf16x8*)(lds + PG8_SA(b, h) + aoff + m * 2048 + k * 1024); } while (0)
#define PG8_LDB(dst, b, h) do { _Pragma("unroll") for (int n = 0; n < 2; ++n) _Pragma("unroll") for (int k = 0; k < 2; ++k) dst[n][k] = *(const PG8_LAS bf16x8*)(lds + PG8_SB(b, h) + boff + n * 2048 + k * 1024); } while (0)
#define PG8_MMA(ai, bj, At, Bt) do { __builtin_amdgcn_s_setprio(1); _Pragma("unroll") for (int m = 0; m < 4; ++m) _Pragma("unroll") for (int n = 0; n < 2; ++n) _Pragma("unroll") for (int k = 0; k < 2; ++k) { \
        if constexpr (I8) acc[ai][bj][m][n] = __builtin_bit_cast(acc_t, __builtin_amdgcn_mfma_i32_16x16x64_i8(__builtin_bit_cast(i32x4, Bt[n][k]), __builtin_bit_cast(i32x4, At[m][k]), __builtin_bit_cast(i32x4, acc[ai][bj][m][n]), 0, 0, 0)); \
        else acc[ai][bj][m][n] = __builtin_bit_cast(acc_t, __builtin_amdgcn_mfma_f32_16x16x32_bf16(Bt[n][k], At[m][k], __builtin_bit_cast(f32x4, acc[ai][bj][m][n]), 0, 0, 0)); } __builtin_amdgcn_s_setprio(0); } while (0)
#define PG8_WAIT_V(n) asm volatile("s_waitcnt vmcnt(" #n ")" ::: "memory")
#define PG8_WAIT_L(n) asm volatile("s_waitcnt lgkmcnt(" #n ")" ::: "memory")
#define PG8_BAR __builtin_amdgcn_s_barrier()
#define PG8_SCHED __builtin_amdgcn_sched_barrier(0)
#define PG8_GIDX(dst, u) do { _Pragma("unroll") for (int _h = 0; _h < 2; ++_h) _Pragma("unroll") for (int _i = 0; _i < 2; ++_i) \
        dst[_h][_i] = (unsigned)g.gidx[(u).pm * BM + _h * HALF + RA[_i]] * g.g_row + CA2[_i]; } while (0)
    Unit cur, nxt; int ui = 0;
    if (!S.next(0, cur)) return;
    typedef typename AccT<I8>::type acc_t;
    acc_t acc[2][2][4][2];
#pragma unroll
    for (int a = 0; a < 2; ++a)
#pragma unroll
        for (int b = 0; b < 2; ++b)
#pragma unroll
            for (int m = 0; m < 4; ++m)
#pragma unroll
                for (int n = 0; n < 2; ++n) acc[a][b][m][n] = (acc_t){0, 0, 0, 0};
    bf16x8 At[4][2], B0[2][2], B1[2][2];
    if constexpr (GATHER) { PG8_GIDX(oc, cur); }
    const char* cA = GATHER ? g.A : g.A + (size_t)cur.pm * g.a_tstep; const char* cB = g.Bt + (size_t)cur.pn * tstepB;
    PG8_STAGE_B(PG8_SB(0, 0), cB); PG8_STAGE_B(PG8_SB(0, 1), cB + hstepB); PG8_STAGE_A(PG8_SA(0, 0), cA, oc, 0); PG8_STAGE_A(PG8_SA(0, 1), cA, oc, 1);
    if (wr == 1) PG8_BAR;
    PG8_WAIT_V(2); PG8_BAR;
    PG8_STAGE_B(PG8_SB(1, 0), cB + kstepB); PG8_STAGE_A(PG8_SA(1, 0), cA + kstepA, oc, 0); PG8_STAGE_B(PG8_SB(1, 1), cB + hstepB + kstepB);
    PG8_WAIT_V(6); PG8_BAR;
    for (;;) {
        const bool has_next = S.next(ui + 1, nxt);
        if constexpr (GATHER) { if (has_next) { PG8_GIDX(on, nxt); } else {
#pragma unroll
            for (int _h = 0; _h < 2; ++_h)
#pragma unroll
                for (int _i = 0; _i < 2; ++_i) on[_h][_i] = oc[_h][_i]; } }
        const char* nA = GATHER ? g.A : (has_next ? g.A + (size_t)nxt.pm * g.a_tstep : cA); const char* nB = has_next ? g.Bt + (size_t)nxt.pn * tstepB : cB;
#pragma unroll 1
        for (int t = 0; t < nt; t += 2) {
            const bool last = (t == nt - 2);
            const char* a1 = cA + (size_t)(t + 1) * kstepA;
            const char* a2 = last ? nA : cA + (size_t)(t + 2) * kstepA; const char* b2 = last ? nB : cB + (size_t)(t + 2) * kstepB;
            const char* a3 = a2 + kstepA; const char* b3 = b2 + kstepB;
            unsigned o2[2][2];
#pragma unroll
            for (int _h = 0; _h < 2; ++_h)
#pragma unroll
                for (int _i = 0; _i < 2; ++_i) o2[_h][_i] = (GATHER && last) ? on[_h][_i] : oc[_h][_i];
            PG8_LDB(B0, 0, 0); PG8_LDB(B1, 0, 1); PG8_SCHED; PG8_LDA(At, 0, 0); PG8_STAGE_A(PG8_SA(1, 1), a1, oc, 1);
            PG8_WAIT_V(8); PG8_WAIT_L(0); PG8_BAR; PG8_MMA(0, 0, At, B0); PG8_MMA(0, 1, At, B1); PG8_BAR; PG8_SCHED;
            PG8_LDA(At, 0, 1); PG8_STAGE_B(PG8_SB(0, 0), b2); PG8_STAGE_B(PG8_SB(0, 1), b2 + hstepB); PG8_STAGE_A(PG8_SA(0, 0), a2, o2, 0);
            PG8_WAIT_V(8); PG8_WAIT_L(0); PG8_BAR; PG8_MMA(1, 0, At, B0); PG8_MMA(1, 1, At, B1); PG8_BAR; PG8_SCHED;
            PG8_LDB(B0, 1, 0); PG8_LDB(B1, 1, 1); PG8_SCHED; PG8_LDA(At, 1, 0); PG8_STAGE_A(PG8_SA(0, 1), a2, o2, 1);
            PG8_WAIT_V(8); PG8_WAIT_L(0); PG8_BAR; PG8_MMA(0, 0, At, B0); PG8_MMA(0, 1, At, B1); PG8_BAR; PG8_SCHED;
            PG8_LDA(At, 1, 1); PG8_STAGE_B(PG8_SB(1, 0), b3); PG8_STAGE_B(PG8_SB(1, 1), b3 + hstepB); PG8_STAGE_A(PG8_SA(1, 0), a3, o2, 0);
            PG8_WAIT_V(8); PG8_WAIT_L(0); PG8_BAR; PG8_MMA(1, 0, At, B0); PG8_MMA(1, 1, At, B1); PG8_BAR; PG8_SCHED;
        }
        if constexpr (ALIGN_EPI) { if (wr == 0) PG8_BAR; }
        E(acc, cur, wr, wc, fr, fq);
        if (!has_next) break;
#pragma unroll
        for (int a = 0; a < 2; ++a)
#pragma unroll
            for (int b = 0; b < 2; ++b)
#pragma unroll
                for (int m = 0; m < 4; ++m)
#pragma unroll
                    for (int n = 0; n < 2; ++n) acc[a][b][m][n] = (acc_t){0, 0, 0, 0};
        cur = nxt; cA = nA; cB = nB; ++ui;
#pragma unroll
        for (int _h = 0; _h < 2; ++_h)
#pragma unroll
            for (int _i = 0; _i < 2; ++_i) oc[_h][_i] = on[_h][_i];
        if constexpr (ALIGN_EPI) { if (wr == 1) PG8_BAR; }
    }
    PG8_WAIT_V(0);
    if constexpr (!ALIGN_EPI) { if (wr == 0) PG8_BAR; }
    PG8_BAR;
#undef PG8_SA
#undef PG8_SB
#undef PG8_STAGE_A
#undef PG8_STAGE_B
#undef PG8_LDA
#undef PG8_LDB
#undef PG8_MMA
#undef PG8_WAIT_V
#undef PG8_WAIT_L
#undef PG8_BAR
#undef PG8_SCHED
#undef PG8_GIDX
}

#define EPI_ROWS(ai, m) (u.pm * BM + (ai) * HALF + wr * 64 + (m) * 16 + fr)
struct EpiProj {
    bf16_t* UH; bf16_t* KB; bf16_t* VB; bf16_t* QB; unsigned char* GT; const float* qg; const float* kg; const float* rope; const float* sa; const float* sb;
    __device__ __forceinline__ void operator()(const i32x4 (&acci)[2][2][4][2], const Unit& u, int wr, int wc, int fr, int fq) const {
        asm volatile("" : "+v"(fr), "+v"(fq));
        const int pn = u.pn;
        const float* sbp = sb + pn * BM + wc * 32 + 8 * fq;
#define ACCF(ai, bj, m, n) (__builtin_convertvector(acci[ai][bj][m][n], f32x4) * (*(const f32x4*)(sbp + (bj) * HALF + 4 * (n)) * sa_r))
        if (pn < 2) {
#pragma unroll
            for (int ai = 0; ai < 2; ++ai)
#pragma unroll
                for (int m = 0; m < 4; ++m) { const int row = EPI_ROWS(ai, m); const float sa_r = sa[row];
#pragma unroll
                    for (int bj = 0; bj < 2; ++bj) { const int c0 = pn * 256 + bj * 128 + wc * 32 + 8 * fq;
                        *(u32x4*)(UH + ((size_t)(c0 >> 4) * NCHUNK_PAD + (row >> 4)) * 512 + (row & 15) * 16 + (c0 & 15)) = pack8(ACCF(ai, bj, m, 0), ACCF(ai, bj, m, 1)); } }
        } else if (pn < 5) {
            const bool isq = pn >= 3, isv = (pn == 2) && (wc >= 2), lat = u.pm < (T / BM);
            const float* gn = isq ? qg : kg;
            const float osc = isq ? C2 : 1.f;
#pragma unroll
            for (int ai = 0; ai < 2; ++ai)
#pragma unroll
                for (int m = 0; m < 4; ++m) { const int row = EPI_ROWS(ai, m); const float sa_r = sa[row];
                    int b, spos; if (lat) { b = row >> 13; spos = LC + (row & (SEQ - 1)); } else { const int rr = row - T; b = rr >> 8; spos = rr & (LC - 1); }
                    if (isv) {
                        bf16_t* o = VB + ((size_t)(b * 2 + (wc - 2)) * SKV + spos) * 64 + 8 * fq;
#pragma unroll
                        for (int bj = 0; bj < 2; ++bj) *(u32x4*)(o + 32 * bj) = pack8(ACCF(ai, bj, m, 0), ACCF(ai, bj, m, 1));
                    } else {
                        float ss = 0.f;
#pragma unroll
                        for (int bj = 0; bj < 2; ++bj)
#pragma unroll
                            for (int n = 0; n < 2; ++n) { const f32x4 x = ACCF(ai, bj, m, n); ss += (x[0] * x[0] + x[1] * x[1]) + (x[2] * x[2] + x[3] * x[3]); }
                        ss += __shfl_xor(ss, 16); ss += __shfl_xor(ss, 32);
                        const float rs = osc / sqrtf(ss * (1.f / 64.f) + EPS);
                        bf16_t* o = isq ? QB + (size_t)row * 512 + (4 * (pn - 3) + wc) * 64 + 8 * fq : KB + ((size_t)(b * 2 + wc) * SKV + spos) * 64 + 8 * fq;
                        const int t = row & (SEQ - 1), rid = t >> 6, cid = t & 63;
#pragma unroll
                        for (int bj = 0; bj < 2; ++bj) {
                            const f32x4 gv0 = *(const f32x4*)(gn + 32 * bj + 8 * fq), gv1 = *(const f32x4*)(gn + 32 * bj + 8 * fq + 4);
                            f32x4 y0 = ACCF(ai, bj, m, 0) * gv0 * rs, y1 = ACCF(ai, bj, m, 1) * gv1 * rs;
                            if (lat) { const float* rp = rope + (bj == 0 ? rid * 16 : 4096 + cid * 16) + 4 * fq; const f32x4 cs = *(const f32x4*)rp, sn = *(const f32x4*)(rp + (bj == 0 ? 2048 : 1024));
                                const f32x4 z0 = (f32x4){y0[0] * cs[0] - y0[1] * sn[0], y0[0] * sn[0] + y0[1] * cs[0], y0[2] * cs[1] - y0[3] * sn[1], y0[2] * sn[1] + y0[3] * cs[1]};
                                const f32x4 z1 = (f32x4){y1[0] * cs[2] - y1[1] * sn[2], y1[0] * sn[2] + y1[1] * cs[2], y1[2] * cs[3] - y1[3] * sn[3], y1[2] * sn[3] + y1[3] * cs[3]};
                                y0 = z0; y1 = z1; }
                            *(u32x4*)(o + 32 * bj) = pack8(y0, y1); }
                    } }
        } else {
#pragma unroll
            for (int ai = 0; ai < 2; ++ai)
#pragma unroll
                for (int m = 0; m < 4; ++m) { const int row = EPI_ROWS(ai, m); const float sa_r = sa[row];
#pragma unroll
                    for (int bj = 0; bj < 2; ++bj)
                        { const f32x4 s0 = fsig4(ACCF(ai, bj, m, 0)) * 255.f, s1 = fsig4(ACCF(ai, bj, m, 1)) * 255.f;
                          u32x2 w; w.x = (unsigned)__float2int_rn(s0[0]) | ((unsigned)__float2int_rn(s0[1]) << 8) | ((unsigned)__float2int_rn(s0[2]) << 16) | ((unsigned)__float2int_rn(s0[3]) << 24);
                          w.y = (unsigned)__float2int_rn(s1[0]) | ((unsigned)__float2int_rn(s1[1]) << 8) | ((unsigned)__float2int_rn(s1[2]) << 16) | ((unsigned)__float2int_rn(s1[3]) << 24);
                          *(u32x2*)(GT + (size_t)row * 2048 + (pn - 5) * 256 + bj * 128 + wc * 32 + 8 * fq) = w; } }
        }
    }
#undef ACCF
};
struct EpiGlu {
    const bf16_t* SG; const float* bias; bf16_t* GO;
    __device__ __forceinline__ void operator()(const f32x4 (&acc)[2][2][4][2], const Unit& u, int wr, int wc, int fr, int fq) const {
#pragma unroll
        for (int bj = 0; bj < 2; ++bj) { const int c0 = u.pn * BM + bj * HALF + wc * 32 + 8 * fq;
            const f32x4 b0 = *(const f32x4*)(bias + c0), b1 = *(const f32x4*)(bias + c0 + 4);
#pragma unroll
            for (int ai = 0; ai < 2; ++ai)
#pragma unroll
                for (int m = 0; m < 4; ++m) { const int row = EPI_ROWS(ai, m);
                    const u32x4 sw = *(const u32x4*)(SG + ((size_t)(c0 >> 4) * T + row) * 16 + (c0 & 15));
                    const f32x4 s0 = unpack_lo(sw), s1 = unpack_hi(sw);
                    *(u32x4*)(GO + (size_t)row * 1024 + c0) = pack8(s0 * fsig4(acc[ai][bj][m][0] + b0), s1 * fsig4(acc[ai][bj][m][1] + b1)); } }
    }
};
template <int MODE> struct EpiMerge {
    const unsigned char* GT; bf16_t* M1; bf16_t* MG;
    __device__ __forceinline__ void operator()(const f32x4 (&acc)[2][2][4][2], const Unit& u, int wr, int wc, int fr, int fq) const {
#pragma unroll
        for (int ai = 0; ai < 2; ++ai)
#pragma unroll
            for (int m = 0; m < 4; ++m) { const int row = EPI_ROWS(ai, m);
#pragma unroll
                for (int bj = 0; bj < 2; ++bj) { const int c0 = u.pn * BM + bj * HALF + wc * 32 + 8 * fq;
                    const u32x2 gw = *(const u32x2*)(GT + (size_t)row * 2048 + MODE * 1024 + c0);
                    const f32x4 g0 = (f32x4){(float)(gw.x & 255u), (float)((gw.x >> 8) & 255u), (float)((gw.x >> 16) & 255u), (float)(gw.x >> 24)} * (1.f / 255.f);
                    const f32x4 g1 = (f32x4){(float)(gw.y & 255u), (float)((gw.y >> 8) & 255u), (float)((gw.y >> 16) & 255u), (float)(gw.y >> 24)} * (1.f / 255.f);
                    const f32x4 v0 = g0 * acc[ai][bj][m][0], v1 = g1 * acc[ai][bj][m][1];
                    bf16_t* mp = M1 + (size_t)row * 1024 + c0;
                    if (MODE == 0) { *(u32x4*)mp = pack8(v0, v1); }
                    else { const u32x4 aw = *(const u32x4*)mp; *(u32x4*)(MG + (size_t)row * 1024 + c0) = pack8(unpack_lo(aw) + v0, unpack_hi(aw) + v1); } } }
    }
};
struct EpiOut {
    const float* x; const float* mod; bf16_t* XM;
    __device__ __forceinline__ void operator()(const f32x4 (&acc)[2][2][4][2], const Unit& u, int wr, int wc, int fr, int fq) const {
        const int b = (u.pm * BM) / SEQ;
#pragma unroll
        for (int bj = 0; bj < 2; ++bj) { const int c0 = u.pn * BM + bj * HALF + wc * 32 + 8 * fq;
            const f32x4 g0 = *(const f32x4*)(mod + b * NMOD + 2048 + c0), g1 = *(const f32x4*)(mod + b * NMOD + 2048 + c0 + 4);
#pragma unroll
            for (int ai = 0; ai < 2; ++ai)
#pragma unroll
                for (int m = 0; m < 4; ++m) { const size_t off = (size_t)EPI_ROWS(ai, m) * 1024 + c0;
                    const f32x4 x0 = *(const f32x4*)(x + off), x1 = *(const f32x4*)(x + off + 4);
                    *(u32x4*)(XM + off) = pack8(x0 + g0 * acc[ai][bj][m][0], x1 + g1 * acc[ai][bj][m][1]); } }
    }
};
struct EpiGU {
    const float* bgu; bf16_t* ACT;
    __device__ __forceinline__ void operator()(const f32x4 (&acc)[2][2][4][2], const Unit& u, int wr, int wc, int fr, int fq) const {
        const int e = u.pn >> 3, jc = (u.pn & 7) * 128 + wc * 32 + 8 * fq; const float* bp = bgu + e * 2048 + jc;
        const f32x4 bg0 = *(const f32x4*)bp, bg1 = *(const f32x4*)(bp + 4), bu0 = *(const f32x4*)(bp + 1024), bu1 = *(const f32x4*)(bp + 1028);
#pragma unroll
        for (int ai = 0; ai < 2; ++ai)
#pragma unroll
            for (int m = 0; m < 4; ++m) { const int row = EPI_ROWS(ai, m); f32x4 o[2];
#pragma unroll
                for (int n = 0; n < 2; ++n) { const f32x4 gt = acc[ai][0][m][n] + (n ? bg1 : bg0), up = acc[ai][1][m][n] + (n ? bu1 : bu0);
#pragma unroll
                    for (int j = 0; j < 4; ++j) { const float gq = fminf(gt[j], 7.f), uq = fminf(fmaxf(up[j], -7.f), 7.f); o[n][j] = (uq + 1.f) * (gq * fsig(1.702f * gq)); } }
                *(u32x4*)(ACT + (size_t)row * 1024 + jc) = pack8(o[0], o[1]); }
    }
};
struct EpiGU8 {
    const float* bgu; const float* sa; const float* sb; bf16_t* ACT;
    __device__ __forceinline__ void operator()(const i32x4 (&acc)[2][2][4][2], const Unit& u, int wr, int wc, int fr, int fq) const {
        const int e = u.pn >> 3, jl = wc * 32 + 8 * fq, jc = (u.pn & 7) * 128 + jl; const float* bp = bgu + e * 2048 + jc; const float* sp = sb + e * 2048 + (u.pn & 7) * 256 + jl;
        const f32x4 bg0 = *(const f32x4*)bp, bg1 = *(const f32x4*)(bp + 4), bu0 = *(const f32x4*)(bp + 1024), bu1 = *(const f32x4*)(bp + 1028);
        const f32x4 sg0 = *(const f32x4*)sp, sg1 = *(const f32x4*)(sp + 4), su0 = *(const f32x4*)(sp + 128), su1 = *(const f32x4*)(sp + 132);
        float sr[2][4];
#pragma unroll
        for (int ai = 0; ai < 2; ++ai)
#pragma unroll
            for (int m = 0; m < 4; ++m) sr[ai][m] = sa[EPI_ROWS(ai, m)];
#pragma unroll
        for (int ai = 0; ai < 2; ++ai)
#pragma unroll
            for (int m = 0; m < 4; ++m) { const int row = EPI_ROWS(ai, m); f32x4 o[2];
#pragma unroll
                for (int n = 0; n < 2; ++n) { const f32x4 sg = (n ? sg1 : sg0) * sr[ai][m], su = (n ? su1 : su0) * sr[ai][m];
#pragma unroll
                    for (int j = 0; j < 4; ++j) { const float gt = (float)acc[ai][0][m][n][j] * sg[j] + (n ? bg1 : bg0)[j], up = (float)acc[ai][1][m][n][j] * su[j] + (n ? bu1 : bu0)[j];
                        const float gq = fminf(gt, 7.f), uq = fminf(fmaxf(up, -7.f), 7.f); o[n][j] = (uq + 1.f) * (gq * fsig(1.702f * gq)); } }
                *(u32x4*)(ACT + (size_t)row * 1024 + jc) = pack8(o[0], o[1]); }
    }
};
struct EpiDown {
    const float* bd; const float* sgate; bf16_t* YB;
    __device__ __forceinline__ void operator()(const f32x4 (&acc)[2][2][4][2], const Unit& u, int wr, int wc, int fr, int fq) const {
        const int e = u.pn >> 2;
#pragma unroll
        for (int ai = 0; ai < 2; ++ai)
#pragma unroll
            for (int m = 0; m < 4; ++m) { const int row = EPI_ROWS(ai, m); const float gt = sgate[row];
#pragma unroll
                for (int bj = 0; bj < 2; ++bj) { const int c0 = (u.pn & 3) * BM + bj * HALF + wc * 32 + 8 * fq; const float* bp = bd + e * 1024 + c0;
                    const f32x4 b0 = *(const f32x4*)bp, b1 = *(const f32x4*)(bp + 4);
                    *(u32x4*)(YB + (size_t)row * 1024 + c0) = pack8((acc[ai][bj][m][0] + b0) * gt, (acc[ai][bj][m][1] + b1) * gt); } }
    }
};
struct EpiSloc {
    bf16_t* SL;
    __device__ __forceinline__ void operator()(const f32x4 (&acc)[2][2][4][2], const Unit& u, int wr, int wc, int fr, int fq) const {
#pragma unroll
        for (int ai = 0; ai < 2; ++ai)
#pragma unroll
            for (int m = 0; m < 4; ++m) { const int row = EPI_ROWS(ai, m);
#pragma unroll
                for (int bj = 0; bj < 2; ++bj) *(u32x4*)(SL + (size_t)row * 256 + bj * HALF + wc * 32 + 8 * fq) = pack8(acc[ai][bj][m][0], acc[ai][bj][m][1]); }
    }
};
struct EpiS5Y {
    bf16_t* SG;
    __device__ __forceinline__ f32x4 gelu4(const f32x4 x) const { f32x4 r;
#pragma unroll
        for (int j = 0; j < 4; ++j) { const float v = x[j], u2 = 1.5957691216057308f * (v + 0.044715f * v * v * v); r[j] = v * fsig(u2); } return r; }
    __device__ __forceinline__ void operator()(const f32x4 (&acc)[2][2][4][2], const Unit& u, int wr, int wc, int fr, int fq) const {
        const int grp = u.pn, mt = u.pm - 9 * grp;
#pragma unroll
        for (int ai = 0; ai < 2; ++ai)
#pragma unroll
            for (int m = 0; m < 4; ++m) { const int chunk = mt * BM + ai * HALF + wr * 64 + m * 16 + fr;
#pragma unroll
                for (int bj = 0; bj < 2; ++bj) { const int col = bj * HALF + wc * 32 + 8 * fq; const int tok = chunk * 16 + (col >> 4);
                    *(u32x4*)(SG + ((size_t)grp * T + tok) * 16 + (col & 15)) = pack8(gelu4(acc[ai][bj][m][0]), gelu4(acc[ai][bj][m][1])); } }
    }
};
#undef EPI_ROWS
struct SchedProj {
    StaticOrder so; int G, c;
    __device__ void init(int G_, int c_) { so.init(T, DIN, G_, c_); G = G_; c = c_; }
    __device__ bool next(int i, Unit& u) const { const int L = i * G + c; if (L < so.nwg) return so.next(i, u); const int r = L - so.nwg; if (r >= 12) return false; u.pm = T / BM + r / 3; u.pn = r % 3; return true; }
};
struct SchedS5 {
    int mper, G, c;
    __device__ bool next(int i, Unit& u) const { const int L = i * G + c; if (L >= 32 * mper) return false; const int grp = L / mper; u.pm = 9 * grp + (L % mper); u.pn = grp; return true; }
};
struct SchedMoE {
    const PG8_LAS int* tile_e; int ntiles, nN, G, c, rev;
    __device__ bool next(int i, Unit& u) const {
        int tile, pn;
        if (nN == 4 && G == 256) {
            const int x = c & 7; pn = x & 3; tile = 64 * i + 32 * (x >> 2) + (c >> 3); if (tile >= ntiles) return false; }
        else { const int L = i * G + c; if (L >= ntiles * nN) return false; tile = L / nN; pn = L % nN; }
        u.pm = rev ? ntiles - 1 - tile : tile; u.pn = tile_e[u.pm] * nN + pn; return true; }
};
}

#include <hip/hip_bf16.h>
#include <cmath>

namespace attn_body {
using bf16=__hip_bfloat16;
using bf16x8=__attribute__((ext_vector_type(8)))short;
using s16x4=__attribute__((ext_vector_type(4)))short;
using f32x16=__attribute__((ext_vector_type(16)))float;
using u32x4=__attribute__((ext_vector_type(4)))unsigned;
constexpr int D=64,QP=512,KP=64,OP=1024,ASEQ=8192,ASKV=8448;
constexpr int NW=8,QBLK=32,QB=QBLK*NW,KVBLK=64,NQB=ASEQ/QB;
constexpr int ATTN_UNIT_ROWS=QB;
__device__ __forceinline__ int crow(int r,int hi){return (r&3)+8*(r>>2)+4*hi;}
#define SBAR() __builtin_amdgcn_sched_barrier(0)
__device__ __forceinline__ void cmask(f32x16&p0,f32x16&p1,int jb,int qrel,int hi){
  const float NEG=-INFINITY; int kb=64*jb+4*hi;
  #pragma unroll
  for(int r=0;r<16;++r){int kv=kb+(r&3)+8*(r>>2); if(kv>qrel)p0[r]=NEG; if(kv+32>qrel)p1[r]=NEG;}
}

constexpr int NSLOT=3, SLOTB=8192;
constexpr int LDS_K=0, LDS_V=NSLOT*SLOTB, LDS_WS=2*NSLOT*SLOTB, LDS_OST=LDS_WS+NW*64*4, LDS_BYTES=LDS_OST+NW*4096;
constexpr float C2=0.125f*1.4426950408889634f;
__device__ __forceinline__ void glds16(const void*gsrc,unsigned lds_dst){unsigned keep;
  asm volatile("s_mov_b32 %0, m0\n\ts_mov_b32 m0, %2\n\ts_nop 0\n\tglobal_load_lds_dwordx4 %1, off\n\ts_mov_b32 m0, %0":"=&s"(keep):"v"(gsrc),"s"(lds_dst):"memory");}
__device__ __forceinline__ float max3f(float a,float b,float c){float r;asm("v_max3_f32 %0, %1, %2, %3":"=v"(r):"v"(a),"v"(b),"v"(c));return r;}
__device__ __forceinline__ float max2f(float a,float b){float r;asm("v_max_f32_e32 %0, %1, %2":"=v"(r):"v"(a),"v"(b));return r;}
__device__ __forceinline__ float fadd_s(float a,float b){float r;asm("v_add_f32_e32 %0, %1, %2":"=v"(r):"v"(a),"v"(b));return r;}
__device__ __forceinline__ float fsub_s(float a,float b){float r;asm("v_sub_f32_e32 %0, %1, %2":"=v"(r):"v"(a),"v"(b));return r;}
typedef float f32x2_t __attribute__((ext_vector_type(2))); typedef __bf16 bf16x2_t __attribute__((ext_vector_type(2)));
__device__ __forceinline__ unsigned cvtpk_s(float lo,float hi){f32x2_t v={lo,hi};bf16x2_t b=__builtin_convertvector(v,bf16x2_t);return __builtin_bit_cast(unsigned,b);}
#define WAIT_BAR(N) asm volatile("s_waitcnt vmcnt(" #N ") lgkmcnt(0)\n\ts_barrier":::"memory")

__device__ __forceinline__ void qkt(f32x16&p0,f32x16&p1,const char*Kslot,const bf16x8*qr,const f32x16&negm,int r32,int hi){
  const char*kb=Kslot+hi*1024+r32*16;
  #pragma unroll
  for(int d0=0;d0<4;++d0){
    const bf16x8 b0=*reinterpret_cast<const bf16x8*>(kb+d0*2048);
    const bf16x8 b1=*reinterpret_cast<const bf16x8*>(kb+d0*2048+512);
    if(d0==0){p0=__builtin_amdgcn_mfma_f32_32x32x16_bf16(b0,qr[0],negm,0,0,0);p1=__builtin_amdgcn_mfma_f32_32x32x16_bf16(b1,qr[0],negm,0,0,0);}
    else{p0=__builtin_amdgcn_mfma_f32_32x32x16_bf16(b0,qr[d0],p0,0,0,0);p1=__builtin_amdgcn_mfma_f32_32x32x16_bf16(b1,qr[d0],p1,0,0,0);}}
}
typedef __attribute__((address_space(3))) const char* lds_cptr;
typedef short v4i16_t __attribute__((ext_vector_type(4)));
__device__ __forceinline__ void kload8(bf16x8*kf,lds_cptr kp){
  kf[0]=*(const __attribute__((address_space(3))) bf16x8*)(kp);      kf[1]=*(const __attribute__((address_space(3))) bf16x8*)(kp+512);
  kf[2]=*(const __attribute__((address_space(3))) bf16x8*)(kp+2048); kf[3]=*(const __attribute__((address_space(3))) bf16x8*)(kp+2560);
  kf[4]=*(const __attribute__((address_space(3))) bf16x8*)(kp+4096); kf[5]=*(const __attribute__((address_space(3))) bf16x8*)(kp+4608);
  kf[6]=*(const __attribute__((address_space(3))) bf16x8*)(kp+6144); kf[7]=*(const __attribute__((address_space(3))) bf16x8*)(kp+6656);
}
__device__ __forceinline__ void kload2(bf16x8*kf,lds_cptr kp,int j){ kf[2*j]=*(const __attribute__((address_space(3))) bf16x8*)(kp+j*2048); kf[2*j+1]=*(const __attribute__((address_space(3))) bf16x8*)(kp+j*2048+512); }
__device__ __forceinline__ s16x4 vtr(lds_cptr p){ return __builtin_bit_cast(s16x4,__builtin_amdgcn_ds_read_tr16_b64_v4i16((__attribute__((address_space(3))) v4i16_t*)p)); }
__device__ __forceinline__ float rowmax(const f32x16&p0,const f32x16&p1){
  float a=max3f(p0[0],p0[1],p1[0]),b=max3f(p0[2],p0[3],p1[1]);a=max3f(a,p1[2],p1[3]);
  #pragma unroll
  for(int r=4;r<16;r+=4){a=max3f(a,p0[r],p0[r+1]);b=max3f(b,p0[r+2],p0[r+3]);a=max3f(a,p1[r],p1[r+1]);b=max3f(b,p1[r+2],p1[r+3]);}
  const float m=max2f(a,b);
  auto rr=__builtin_amdgcn_permlane32_swap(__float_as_uint(m),__float_as_uint(m),false,false);
  return max2f(__uint_as_float(rr[0]),__uint_as_float(rr[1]));
}
__device__ __forceinline__ void pv(f32x16*o,int vb,bf16x8 pa0,bf16x8 pa1,bf16x8 pa2,bf16x8 pa3){
  #pragma unroll
  for(int d0=0;d0<2;++d0){s16x4 lo[4],hi[4];
    #pragma unroll
    for(int ks=0;ks<4;++ks){
      asm volatile("ds_read_b64_tr_b16 %0,%1 offset:%c2":"=&v"(lo[ks]):"v"(vb),"i"(d0*4096+ks*1024):"memory");
      asm volatile("ds_read_b64_tr_b16 %0,%1 offset:%c2":"=&v"(hi[ks]):"v"(vb),"i"(d0*4096+ks*1024+512):"memory");}
    asm volatile("s_waitcnt lgkmcnt(0)":::"memory");SBAR();
    #define PK(k) (bf16x8){lo[k][0],lo[k][1],lo[k][2],lo[k][3],hi[k][0],hi[k][1],hi[k][2],hi[k][3]}
    o[d0]=__builtin_amdgcn_mfma_f32_32x32x16_bf16(pa0,PK(0),o[d0],0,0,0);
    o[d0]=__builtin_amdgcn_mfma_f32_32x32x16_bf16(pa1,PK(1),o[d0],0,0,0);
    o[d0]=__builtin_amdgcn_mfma_f32_32x32x16_bf16(pa2,PK(2),o[d0],0,0,0);
    o[d0]=__builtin_amdgcn_mfma_f32_32x32x16_bf16(pa3,PK(3),o[d0],0,0,0);
    #undef PK
  }
}

#ifndef ATTN_STORE16
#define ATTN_STORE16(p,v) (*(u32x4*)(p)=(v))
#endif
template<int THRL> __device__ __forceinline__ void attn_unit(int b,int h,int qb,const bf16*Q,const bf16*__restrict__ K,const bf16*__restrict__ V,bf16*O,char*shm,float mref){
  const int tid=threadIdx.x,lane=tid&63,r32=lane&31,hi=lane>>5; const int wid=__builtin_amdgcn_readfirstlane(tid>>6);
  const long rowbase=(long)b*ASEQ; const int q0=qb*QB;
  const bf16*Qw=Q+(rowbase+q0+wid*QBLK)*QP+h*D;
  const bf16*Kh=K+(long)(b*2+(h>>2))*ASKV*KP,*Vh=V+(long)(b*2+(h>>2))*ASKV*KP;
  const unsigned lds0=(unsigned)(uintptr_t)shm;
  float*wsf=(float*)(shm+LDS_WS)+wid*64;
  const bf16*ksrc=Kh+(long)lane*KP+wid*8;
  const bf16*vsrc=Vh+(long)(16*(wid&3)+(lane>>2))*KP+(wid>>2)*32+(lane&3)*8;
  const unsigned kdst=lds0+LDS_K+wid*1024, vdst=lds0+LDS_V+wid*1024;
  #define DMA_K(t,slot) glds16(ksrc+(long)(t)*KVBLK*KP,(unsigned)__builtin_amdgcn_readfirstlane(kdst+(slot)))
  #define DMA_V(t,slot) glds16(vsrc+(long)(t)*KVBLK*KP,(unsigned)__builtin_amdgcn_readfirstlane(vdst+(slot)))
  const int vb0=(int)(lds0+LDS_V)+((lane>>4)&1)*32+(lane&3)*8+(4*hi+((lane&15)>>2))*64;
  const char*Kbase=shm+LDS_K; bf16x8 kf[8];
  const lds_cptr shm3=(lds_cptr)shm; const lds_cptr kp0=shm3+LDS_K+hi*1024+r32*16; const lds_cptr vp0=shm3+LDS_V+((lane>>4)&1)*32+(lane&3)*8+(4*hi+((lane&15)>>2))*64;
  const int NT=ASKV/KVBLK;
  DMA_K(0,0);DMA_V(0,0);DMA_K(1,SLOTB);
  bf16x8 qr[4];
  #pragma unroll
  for(int d0=0;d0<4;++d0)qr[d0]=*reinterpret_cast<const bf16x8*>(&Qw[(long)r32*QP+d0*16+hi*8]);
  float l_reg=0.f;f32x16 o[2];o[0]=f32x16{};o[1]=f32x16{};f32x16 negm;
  _Pragma("unroll") for(int r=0;r<16;++r)negm[r]=-mref; asm volatile("":"+v"(negm));
  const int qrel=wid*QBLK+r32;
  #define CMASK(P0,P1,t) do{}while(0)
  #define START(P0,P1) do{ _Pragma("unroll") for(int r=0;r<16;++r)P0[r]=__builtin_amdgcn_exp2f(P0[r]); }while(0)
  #define RESC() do{}while(0)
  f32x16 pA0,pA1,pB0,pB1;
  int sl_prev=0,sl_cur=0,sl_next=SLOTB;
  #define ROT() do{sl_prev=sl_cur;sl_cur=sl_next;sl_next=(sl_next==(NSLOT-1)*SLOTB)?0:sl_next+SLOTB;}while(0)
  DMA_K(2,2*SLOTB);
  WAIT_BAR(3);
  qkt(pA0,pA1,Kbase,qr,negm,r32,hi);asm volatile("s_nop 15\n\ts_nop 7":"+v"(pA0),"+v"(pA1));CMASK(pA0,pA1,0);
  START(pA0,pA1);
  _Pragma("unroll") for(int r=0;r<16;++r)pA1[r]=__builtin_amdgcn_exp2f(pA1[r]);
  WAIT_BAR(0);
  DMA_K(3,0);DMA_V(1,SLOTB);
  ROT();
  kload8(kf,kp0+sl_cur);
  WAIT_BAR(2);
  s16x4 vlo[8],vhi[8]; u32x4 pw0,pw1,pw2,pw3;
  #define PKW(P,B) cvtpk_s(P[B],P[B+1])
  #define PAF(k) __builtin_bit_cast(bf16x8,pw##k)
  #define VFR(i) (bf16x8){vlo[i][0],vlo[i][1],vlo[i][2],vlo[i][3],vhi[i][0],vhi[i][1],vhi[i][2],vhi[i][3]}
  #define PIN(x) asm volatile("":"+v"(x))
  #define MX3(a,b,c) __builtin_fmaxf(__builtin_fmaxf((a),(b)),(c))
  #define GAPA(MF,A0,A1,A2,A3,W0,W1,PW) do{ MF; sacc+=A0; sacc+=A1; sacc+=A2; sacc+=A3; PIN(sacc); W0; W1; PIN(PW); SBAR(); }while(0)
  #define EX(v) __builtin_amdgcn_exp2f(v)
  #define GAPB(MF,X,B) do{ MF; X[B]=EX(X[B]); X[B+1]=EX(X[B+1]); X[B+2]=EX(X[B+2]); X[B+3]=EX(X[B+3]); PIN(X); SBAR(); }while(0)
  #define VRD(i) do{ vlo[i]=vtr(vp_+(((i)>>2)*4096+((i)&3)*1024)); vhi[i]=vtr(vp_+(((i)>>2)*4096+((i)&3)*1024+512)); }while(0)
  #define KRD(G,j) do{ if(G){ kload2(kf,kp0+sl_next,j); SBAR(); } }while(0)
  #define STEP(C0,C1,P0,P1,t,GK,GV,GL) do{ SBAR(); \
    const lds_cptr vp_=vp0+sl_prev; \
    VRD(0); SBAR(); float sacc=(P0[0]+P0[1]); \
    GAPA(C0=__builtin_amdgcn_mfma_f32_32x32x16_bf16(kf[0],qr[0],negm,0,0,0), P0[2],P0[3],P0[4],P0[5],     pw0[0]=PKW(P0,0), pw0[1]=PKW(P0,2), pw0); \
    VRD(4); SBAR(); GAPA(C1=__builtin_amdgcn_mfma_f32_32x32x16_bf16(kf[1],qr[0],negm,0,0,0), P0[6],P0[7],P0[8],P0[9],     pw0[2]=PKW(P0,4), pw0[3]=PKW(P0,6), pw0); \
    VRD(1); SBAR(); GAPA(C0=__builtin_amdgcn_mfma_f32_32x32x16_bf16(kf[2],qr[1],C0,0,0,0),   P0[10],P0[11],P0[12],P0[13], pw1[0]=PKW(P0,8), pw1[1]=PKW(P0,10), pw1); \
    VRD(5); SBAR(); GAPA(C1=__builtin_amdgcn_mfma_f32_32x32x16_bf16(kf[3],qr[1],C1,0,0,0),   P0[14],P0[15],P1[0],P1[1],   pw1[2]=PKW(P0,12),pw1[3]=PKW(P0,14), pw1); \
    VRD(2); SBAR(); GAPA(C0=__builtin_amdgcn_mfma_f32_32x32x16_bf16(kf[4],qr[2],C0,0,0,0),   P1[2],P1[3],P1[4],P1[5],     pw2[0]=PKW(P1,0), pw2[1]=PKW(P1,2), pw2); \
    VRD(6); SBAR(); GAPA(C1=__builtin_amdgcn_mfma_f32_32x32x16_bf16(kf[5],qr[2],C1,0,0,0),   P1[6],P1[7],P1[8],P1[9],     pw2[2]=PKW(P1,4), pw2[3]=PKW(P1,6), pw2); \
    VRD(3); SBAR(); GAPA(C0=__builtin_amdgcn_mfma_f32_32x32x16_bf16(kf[6],qr[3],C0,0,0,0),   P1[10],P1[11],P1[12],P1[13], pw3[0]=PKW(P1,8), pw3[1]=PKW(P1,10), pw3); \
    VRD(7); SBAR(); GAPA(C1=__builtin_amdgcn_mfma_f32_32x32x16_bf16(kf[7],qr[3],C1,0,0,0),   P1[14],P1[15],0.f,0.f,       pw3[2]=PKW(P1,12),pw3[3]=PKW(P1,14), pw3); \
    l_reg+=sacc; \
    if(GK){DMA_K((t)+3,sl_cur);} if(GV){DMA_V((t)+1,sl_next);} \
    CMASK(C0,C1,t); \
    SBAR(); \
    GAPB(o[0]=__builtin_amdgcn_mfma_f32_32x32x16_bf16(PAF(0),VFR(0),o[0],0,0,0), C0,0); \
    GAPB(o[1]=__builtin_amdgcn_mfma_f32_32x32x16_bf16(PAF(0),VFR(4),o[1],0,0,0), C0,4); \
    KRD(GL,0); GAPB(o[0]=__builtin_amdgcn_mfma_f32_32x32x16_bf16(PAF(1),VFR(1),o[0],0,0,0), C0,8); \
    KRD(GL,1); GAPB(o[1]=__builtin_amdgcn_mfma_f32_32x32x16_bf16(PAF(1),VFR(5),o[1],0,0,0), C0,12); \
    KRD(GL,2); GAPB(o[0]=__builtin_amdgcn_mfma_f32_32x32x16_bf16(PAF(2),VFR(2),o[0],0,0,0), C1,0); \
    KRD(GL,3); GAPB(o[1]=__builtin_amdgcn_mfma_f32_32x32x16_bf16(PAF(2),VFR(6),o[1],0,0,0), C1,4); \
    GAPB(o[0]=__builtin_amdgcn_mfma_f32_32x32x16_bf16(PAF(3),VFR(3),o[0],0,0,0), C1,8); \
    GAPB(o[1]=__builtin_amdgcn_mfma_f32_32x32x16_bf16(PAF(3),VFR(7),o[1],0,0,0), C1,12); \
    }while(0)
  int t=1;
  #undef CMASK
  #define CMASK(P0,P1,t) do{}while(0)
  for(;t+5<NT;t+=2){
    STEP(pB0,pB1,pA0,pA1,t,true,true,true);     WAIT_BAR(2); RESC(); ROT();
    STEP(pA0,pA1,pB0,pB1,t+1,true,true,true);   WAIT_BAR(2); RESC(); ROT();
  }
  #undef CMASK
  #define CMASK(P0,P1,t) do{}while(0)
  #define ENDW(tt) do{ if((tt)+3<NT){WAIT_BAR(2);} else if((tt)+2<NT){WAIT_BAR(1);} else {WAIT_BAR(0);} }while(0)
  for(;t+1<NT;t+=2){
    STEP(pB0,pB1,pA0,pA1,t,(t+3<NT),(t+1<NT),(t+1<NT));       ENDW(t);   RESC(); ROT();
    STEP(pA0,pA1,pB0,pB1,t+1,(t+4<NT),(t+2<NT),(t+2<NT));     ENDW(t+1); RESC(); ROT();
  }
  STEP(pB0,pB1,pA0,pA1,NT-1,false,false,false); RESC();
  { float sacc=pB0[0]+pB0[1]; _Pragma("unroll") for(int r=2;r<16;++r)sacc+=pB0[r]; _Pragma("unroll") for(int r=0;r<16;++r)sacc+=pB1[r]; l_reg+=sacc;
    pw0=(u32x4){PKW(pB0,0),PKW(pB0,2),PKW(pB0,4),PKW(pB0,6)};pw1=(u32x4){PKW(pB0,8),PKW(pB0,10),PKW(pB0,12),PKW(pB0,14)};pw2=(u32x4){PKW(pB1,0),PKW(pB1,2),PKW(pB1,4),PKW(pB1,6)};pw3=(u32x4){PKW(pB1,8),PKW(pB1,10),PKW(pB1,12),PKW(pB1,14)};
    SBAR(); pv(o,vb0+sl_cur,PAF(0),PAF(1),PAF(2),PAF(3)); }
  #undef PKW
  #undef PAF
  #undef VFR
  #undef PIN
  #undef MX3
  #undef GAPA
  #undef GAPB
  #undef EX
  #undef VRD
  #undef KRD
  #undef STEP
  #undef ENDW
  {auto rr=__builtin_amdgcn_permlane32_swap(__float_as_uint(l_reg),__float_as_uint(l_reg),false,false);l_reg=__uint_as_float(rr[0])+__uint_as_float(rr[1]);}
  if(hi==0)wsf[32+r32]=l_reg;asm volatile("s_waitcnt lgkmcnt(0)":::"memory");
  float rli[16];
  #pragma unroll
  for(int r=0;r<16;++r)rli[r]=__builtin_amdgcn_rcpf(wsf[32+crow(r,hi)]);
  bf16*Ow=O+(rowbase+q0+wid*QBLK)*OP+h*D;
  { bf16*stg=(bf16*)(shm+LDS_OST)+wid*2048;
    #pragma unroll
    for(int r=0;r<16;++r){const int orow=crow(r,hi);
      #pragma unroll
      for(int d0=0;d0<2;++d0)stg[orow*64+d0*32+r32]=__float2bfloat16(o[d0][r]*rli[r]);}
    asm volatile("s_waitcnt lgkmcnt(0)":::"memory");
    #pragma unroll
    for(int i=0;i<4;++i){const int row=i*8+(lane>>3),ch=lane&7; const u32x4 v=*(const u32x4*)(stg+row*64+ch*8); ATTN_STORE16(Ow+(long)row*OP+ch*8,v);} }
  asm volatile("s_waitcnt lgkmcnt(0)\n\ts_barrier":::"memory");
  #undef DMA_K
  #undef DMA_V
  #undef CMASK
  #undef START
  #undef RESC
  #undef ROT
}
constexpr int ATTN_LDS_BYTES=LDS_BYTES;
struct AttnTensors { const bf16* Q; const bf16* K; const bf16* V; bf16* O; float mref; };
struct AttnUnit { int bh; int qb; };
struct StaticOrder {
  int vcu;
  __device__ __forceinline__ explicit StaticOrder(int grid,int block):vcu((block%8)*(grid/8)+block/8){}
  __device__ __forceinline__ bool next(int i,AttnUnit&u)const{ if(i>=4)return false; const int s=vcu&7; u.bh=vcu>>3; u.qb=(i==0)?s:(i==1)?15-s:(i==2)?16+s:31-s; return true; }
  __device__ __forceinline__ void a_ready(const AttnUnit&)const{}
  __device__ __forceinline__ void done(const AttnUnit&)const{}
};
template<class Sched,int THRL=8> __device__ __forceinline__ void attn_phase(char*lds,const AttnTensors&T,const Sched&S){
  AttnUnit u;
  for(int i=0;S.next(i,u);++i){ S.a_ready(u); attn_unit<THRL>(u.bh>>3,u.bh&7,u.qb,T.Q,T.K,T.V,T.O,lds,T.mref); S.done(u); }
}
#undef SBAR
#undef WAIT_BAR
}

#define LAS __attribute__((address_space(3)))

#define XB_TMO      128
#define XB_XCNT(j)  (256  + 64 * (j))
#define XB_XSUB(j)  (1280 + 64 * (j))
#define XB_XGEN(j)  (2304 + 64 * (j))
#define XB_TOP      3328
#define XB_TOPGEN   3392
#define XCD_BAR_WORDS 3456
#define XB_SPIN_CAP (1u << 18)

__device__ __forceinline__ unsigned xb_ld(unsigned* p)              { return __hip_atomic_load(p, __ATOMIC_RELAXED, __HIP_MEMORY_SCOPE_AGENT); }
__device__ __forceinline__ unsigned xb_add(unsigned* p, unsigned v) { return __hip_atomic_fetch_add(p, v, __ATOMIC_RELAXED, __HIP_MEMORY_SCOPE_AGENT); }
__device__ __forceinline__ unsigned xb_xcc_id() { return (unsigned)__builtin_amdgcn_s_getreg((3 << 11) | 20) & 0xFu; }
#define XB_SPIN(cond, bar) do { unsigned _sp = 0; while (cond) { __builtin_amdgcn_s_sleep(1); \
    if ((++_sp & 255u) == 0u) { if (xb_ld(&(bar)[XB_TMO])) break; if (_sp > XB_SPIN_CAP) { atomicAdd(&(bar)[XB_TMO], 1u); break; } } } } while (0)

struct XcdBarrier {
    unsigned* bar; unsigned x;
    volatile LAS unsigned* st;
};

__device__ __forceinline__ XcdBarrier xcd_barrier_post(unsigned* bar, volatile LAS unsigned* st) {
    XcdBarrier b; b.bar = bar; b.x = xb_xcc_id(); b.st = st;
    if (threadIdx.x == 0) (void)xb_add(&bar[XB_XCNT(b.x)], 1u);
    return b;
}
__device__ __forceinline__ void xcd_barrier_complete(unsigned* bar, unsigned x, unsigned& nloc, unsigned& nx) {
    const unsigned G = gridDim.x * gridDim.y * gridDim.z;
    unsigned sum, cnt, mine, sp = 0u;
    for (;;) {
        sum = 0u; cnt = 0u; mine = 0u;
#pragma unroll
        for (unsigned j = 0; j < 16; ++j) { const unsigned c = xb_ld(&bar[XB_XCNT(j)]); sum += c; cnt += (c > 0u) ? 1u : 0u; mine = (j == x) ? c : mine; }
        if (sum == G) break;
        __builtin_amdgcn_s_sleep(1);
        if ((++sp & 255u) == 0u) { if (xb_ld(&bar[XB_TMO])) break; if (sp > XB_SPIN_CAP) { atomicAdd(&bar[XB_TMO], 1u); break; } }
    }
    nloc = mine > 0u ? mine : 1u; nx = cnt > 0u ? cnt : 1u;
}

__device__ __forceinline__ void xcd_barrier(const XcdBarrier& b) {
    asm volatile("s_waitcnt vmcnt(0)" ::: "memory");
    __syncthreads();
    if (threadIdx.x == 0) {
        unsigned* bar = b.bar;
        __builtin_amdgcn_s_waitcnt(0);
        unsigned nloc = b.st[0], nx = b.st[1];
        if (nloc == 0u) { xcd_barrier_complete(bar, b.x, nloc, nx); b.st[0] = nloc; b.st[1] = nx; }
        const unsigned old = xb_add(&bar[XB_XSUB(b.x)], 1u);
        const unsigned gen = old / nloc;
        if (old + 1u == (gen + 1u) * nloc) {
            __builtin_amdgcn_fence(__ATOMIC_RELEASE, "agent");
            asm volatile("s_waitcnt vmcnt(0)" ::: "memory");
            const unsigned og = xb_add(&bar[XB_TOP], 1u);
            const unsigned tg = og / nx;
            if (og + 1u == (tg + 1u) * nx) xb_add(&bar[XB_TOPGEN], 1u);
            else XB_SPIN(xb_ld(&bar[XB_TOPGEN]) == tg, bar);
            __builtin_amdgcn_fence(__ATOMIC_ACQUIRE, "agent");
            xb_add(&bar[XB_XGEN(b.x)], 1u);
            asm volatile("s_waitcnt vmcnt(0)" ::: "memory");
        } else {
            XB_SPIN(xb_ld(&bar[XB_XGEN(b.x)]) == gen, bar);
            __builtin_amdgcn_fence(__ATOMIC_ACQUIRE, "agent");
            asm volatile("s_waitcnt vmcnt(0)" ::: "memory");
        }
    }
    __syncthreads();
}

#undef LAS

constexpr int NWAVES = 8;
constexpr int RING_OFF = 0, RING_BYTES = 131072;
constexpr int LDSCTL_OFF = RING_BYTES;
constexpr int LDS_TILE_OFF = LDSCTL_OFF + 4096;
constexpr int LDS_BYTES = 147456;
#define LAS __attribute__((address_space(3)))
#define GAS __attribute__((address_space(1)))
typedef unsigned v4u __attribute__((ext_vector_type(4)));

__device__ __forceinline__ int proj_perm(int n) {
    if (n < COL_K || n >= COL_GATE) return n;
    if (n < COL_Q) { const int r = n - COL_K, hs = r >> 6, d = r & 63; return COL_K + 128 * (d >> 5) + 32 * hs + (d & 31); }
    const int r = n - COL_Q, h = r >> 6, d = r & 63; return COL_Q + 256 * (h >> 2) + 128 * (d >> 5) + 32 * (h & 3) + (d & 31);
}
__device__ __forceinline__ int gu_perm(int c) { const int jc = c & 1023, up = c >> 10; return 256 * (jc >> 7) + 128 * up + (jc & 127); }
typedef float wc_f32x4 __attribute__((ext_vector_type(4)));
struct WcMat { const float* W; bf16* WT; int N, ldk, koff, mode, local; };
__device__ __forceinline__ WcMat wc_decode(const P& p, int it) {
    constexpr int I_GLU = 8 * 2, I_SSM = 8 * 4, I_D1 = 16 * 4;
    int r = it; WcMat m;
    if (r < 32 * I_D1) { const int e = r / I_D1; m = WcMat{p.in[28] + (size_t)e * 1024 * 1024, (bf16*)(p.ws + WS_WD) + (size_t)e * 1024 * 1024, 1024, 1024, 0, 0, r % I_D1}; return m; } r -= 32 * I_D1;
    if (r < I_GLU) { m = WcMat{p.in[17], (bf16*)(p.ws + WS_WGLU), 512, 512, 0, 0, r}; return m; } r -= I_GLU;
    if (r < I_SSM) { m = WcMat{p.in[19], (bf16*)(p.ws + WS_W12), 1024, 1024, 0, 0, r}; return m; } r -= I_SSM;
    if (r < I_SSM) { m = WcMat{p.in[22], (bf16*)(p.ws + WS_W12), 1024, 1024, 512, 0, r}; return m; } r -= I_SSM;
    m = WcMat{p.in[23], (bf16*)(p.ws + WS_WOUT), 1024, 1024, 0, 0, r}; return m;
}
#define WQ_LOAD(V, item) do { const bool gu_ = (item) < 2048; const int e_ = (item) >> 6, sn_ = gu_ ? (item) & 63 : (item) - 2048; const int N_ = gu_ ? 2048 : DIN; \
        const float* src_ = (gu_ ? p.in[26] + (size_t)e_ * 1024 * 2048 : p.in[8]) + (size_t)(t >> 3) * N_ + 32 * sn_ + 4 * (t & 7); \
        _Pragma("unroll") for (int i_ = 0; i_ < 16; ++i_) V[i_] = *(const wc_f32x4*)(src_ + (size_t)(64 * i_) * N_); } while (0)
__device__ __forceinline__ void wq_proc(const P& p, const wc_f32x4 (&v)[16], int item, LAS unsigned char* lds) {
    const bool gu = item < 2048; const int t = threadIdx.x, e = item >> 6, sn = gu ? item & 63 : item - 2048;
    LAS unsigned* cmax = (LAS unsigned*)(lds + 65536);
    if (t < 32) cmax[t] = 0u;
    __syncthreads();
    wc_f32x4 m4 = {0.f, 0.f, 0.f, 0.f};
#pragma unroll
    for (int i = 0; i < 16; ++i) { m4[0] = fmaxf(m4[0], fabsf(v[i][0])); m4[1] = fmaxf(m4[1], fabsf(v[i][1])); m4[2] = fmaxf(m4[2], fabsf(v[i][2])); m4[3] = fmaxf(m4[3], fabsf(v[i][3]));
        const unsigned lo = pk2(v[i][0], v[i][1]), hi = pk2(v[i][2], v[i][3]);
        typedef unsigned wc_u32x2 __attribute__((ext_vector_type(2))); *(LAS wc_u32x2*)(lds + (((t >> 3) + 64 * i) * 32 + 4 * (t & 7)) * 2) = (wc_u32x2){lo, hi}; }
#pragma unroll
    for (int j = 0; j < 4; ++j) __hip_atomic_fetch_max(cmax + 4 * (t & 7) + j, __float_as_uint(m4[j]), __ATOMIC_RELAXED, __HIP_MEMORY_SCOPE_WORKGROUP);
    __syncthreads();
    const int n = t & 31, cg = t >> 5; const float am = __uint_as_float(cmax[n]), inv = am > 0.f ? 127.f / am : 0.f;
    const int c0 = 32 * sn + n, drow = gu ? gu_perm(c0) : proj_perm(c0);
    signed char* dst = gu ? (signed char*)(p.ws + WS_WGQ) + ((size_t)e * 2048 + drow) * 1024 : (signed char*)(p.ws + WS_WIN) + (size_t)drow * 1024;
    if (cg == 0) { if (gu) ((float*)(p.ws + WS_WGS))[e * 2048 + drow] = am * (1.f / 127.f); else ((float*)(p.ws + WS_WINS))[drow] = am * (1.f / 127.f); }
#pragma unroll
    for (int j = 0; j < 4; ++j) { const int c = cg + 16 * j; unsigned o4[4];
#pragma unroll
        for (int w = 0; w < 4; ++w) { unsigned acc = 0u;
#pragma unroll
            for (int q = 0; q < 4; ++q) { const int k = 16 * c + 4 * w + q; const float x = __uint_as_float((unsigned)(*(const LAS unsigned short*)(lds + (k * 32 + n) * 2)) << 16);
                int qi = __float2int_rn(x * inv); qi = qi > 127 ? 127 : (qi < -127 ? -127 : qi);
                acc |= ((unsigned)(qi & 255)) << (8 * q); }
            o4[w] = acc; }
        *(uint4*)(dst + 16 * c) = make_uint4(o4[0], o4[1], o4[2], o4[3]); }
    __syncthreads();
}
#define WC_LOAD(V, M) do { const int nblk_ = M.N >> 8, kb_ = M.local / nblk_, nb_ = M.local - kb_ * nblk_; const float* src_ = M.W + (size_t)(64 * kb_ + wave) * M.N + 256 * nb_ + 4 * lane; \
        _Pragma("unroll") for (int i_ = 0; i_ < 8; ++i_) V[i_] = *(const wc_f32x4*)(src_ + (size_t)(8 * i_) * M.N); } while (0)
#define WC_PROC(V, M, buf) do { const int nblk_ = M.N >> 8, kb_ = M.local / nblk_, nb_ = M.local - kb_ * nblk_, k0_ = 64 * kb_, n0_ = 256 * nb_; LAS float* scr_ = (LAS float*)(lds + (buf) * 65536); \
        _Pragma("unroll") for (int i_ = 0; i_ < 8; ++i_) { const int row_ = wave + 8 * i_; *(LAS wc_f32x4*)(scr_ + row_ * 256 + ((4 * lane) ^ (((row_ >> 3) & 7) << 2))) = V[i_]; } \
        __syncthreads(); const int c_ = lane & 7; \
        _Pragma("unroll") for (int j_ = 0; j_ < 4; ++j_) { const int n_ = 64 * j_ + 8 * wave + (lane >> 3); const LAS float* s_ = scr_ + (8 * c_) * 256 + (n_ ^ (c_ << 2)); \
            v4u o_; o_.x = pk2(s_[0 * 256], s_[1 * 256]); o_.y = pk2(s_[2 * 256], s_[3 * 256]); o_.z = pk2(s_[4 * 256], s_[5 * 256]); o_.w = pk2(s_[6 * 256], s_[7 * 256]); \
            const int dr_ = M.mode == 1 ? proj_perm(n0_ + n_) : M.mode == 2 ? gu_perm(n0_ + n_) : n0_ + n_; \
            *(v4u*)(M.WT + (size_t)dr_ * M.ldk + M.koff + k0_ + 8 * c_) = o_; } } while (0)
__device__ __forceinline__ void ph_wconv(const P& p, int bx, LAS unsigned char* lds) {
    const int lane = threadIdx.x & 63, wave = threadIdx.x >> 6, t = threadIdx.x;
    const int r = bx >= 160 ? bx - 160 : bx + 96;
    if (r < 104) { wc_f32x4 sa[16]; WQ_LOAD(sa, 2048 + r); wq_proc(p, sa, 2048 + r, lds); }
    else if (r < 248) { wc_f32x4 wa[8]; const WcMat ma = wc_decode(p, 2048 + r - 104); WC_LOAD(wa, ma); WC_PROC(wa, ma, 0); }
}
__device__ __forceinline__ void ph_wexp(const P& p, int idx, LAS unsigned char* lds) {
    const int lane = threadIdx.x & 63, wave = threadIdx.x >> 6, t = threadIdx.x;
    { wc_f32x4 sa[16], sb[16];
      WQ_LOAD(sa, idx);
#pragma unroll 1
      for (int q = 0; q < 8; q += 2) {
          WQ_LOAD(sb, (q + 1) * 256 + idx);
          wq_proc(p, sa, q * 256 + idx, lds);
          if (q + 2 < 8) WQ_LOAD(sa, (q + 2) * 256 + idx);
          wq_proc(p, sb, (q + 1) * 256 + idx, lds);
      } }
    { wc_f32x4 wa[8], wb[8]; WcMat ma = wc_decode(p, idx), mb; WC_LOAD(wa, ma);
#pragma unroll 1
      for (int q = 0; q < 8; q += 2) {
          mb = wc_decode(p, (q + 1) * 256 + idx); WC_LOAD(wb, mb);
          WC_PROC(wa, ma, 0);
          if (q + 2 < 8) { ma = wc_decode(p, (q + 2) * 256 + idx); WC_LOAD(wa, ma); }
          WC_PROC(wb, mb, 1);
      } }
    __syncthreads();
}
#undef WC_LOAD
#undef WC_PROC
#undef WQ_LOAD

__device__ __forceinline__ void ph_s5tab(const P& p, int g, int dir, float* L) {
    float* pw = L; float* Bb = L + 2176; float* Cc = Bb + 2048; float* Kt = Cc + 2048;
    const int tid = threadIdx.x, dg = dir * 32 + g;
    const float step = expf(p.in[11][dg]);
    for (int i = tid; i < 64 * 17; i += 512) { const int n = i / 17, tau = i - n * 17; const float zr = p.in[9][dg * 64 + n] * step, zi = p.in[10][dg * 64 + n] * step;
        const float e = expf(zr * (float)tau), a = zi * (float)tau; float sn, cs; sincosf(a, &sn, &cs); pw[i * 2] = e * cs; pw[i * 2 + 1] = e * sn; }
    for (int i = tid; i < 1024; i += 512) { const int n = i >> 4, q = i & 15; const float lr = p.in[9][dg * 64 + n], li = p.in[10][dg * 64 + n]; const float zr = lr * step, zi = li * step, e = expf(zr);
        float sn, cs; sincosf(zi, &sn, &cs); const float nr = e * cs - 1.f, ni = e * sn, den = lr * lr + li * li; const float cr = (nr * lr + ni * li) / den, ci = (ni * lr - nr * li) / den;
        const float br = p.in[12][(dg * 64 + n) * 16 + q], bi = p.in[13][(dg * 64 + n) * 16 + q]; Bb[i * 2] = cr * br - ci * bi; Bb[i * 2 + 1] = cr * bi + ci * br; }
    for (int i = tid; i < 1024; i += 512) { Cc[i * 2] = p.in[14][dg * 1024 + i]; Cc[i * 2 + 1] = p.in[15][dg * 1024 + i]; }
    __syncthreads();
    typedef float f2 __attribute__((ext_vector_type(2)));
    { const int tau = tid >> 5, pp = (tid >> 1) & 15, q0 = (tid & 1) * 8;
      float a[8] = {0.f, 0.f, 0.f, 0.f, 0.f, 0.f, 0.f, 0.f};
#pragma unroll 4
      for (int n = 0; n < 64; ++n) { const f2 c = *(const f2*)(Cc + (pp * 64 + n) * 2), w = *(const f2*)(pw + (n * 17 + tau) * 2); const float zr = c.x * w.x - c.y * w.y, zi = c.x * w.y + c.y * w.x;
#pragma unroll
          for (int q = 0; q < 8; ++q) { const f2 bq = *(const f2*)(Bb + (n * 16 + q0 + q) * 2); a[q] += zr * bq.x - zi * bq.y; } }
#pragma unroll
      for (int q = 0; q < 8; ++q) Kt[(tau * 16 + pp) * 16 + q0 + q] = a[q]; }
    __syncthreads();
    if (tid < 256) ((float*)(p.ws + WS_KD))[dg * 256 + tid] = Kt[tid];
    bf16* TCV = (bf16*)(p.ws + WS_TCV) + (size_t)g * 256 * 512;
    for (int i = tid; i < 256 * 256; i += 512) { const int row = i >> 8, k = i & 255, ii = row >> 4, pp = row & 15, j = k >> 4, q = k & 15;
        if (dir == 0 ? (j < ii) : (j > ii)) TCV[row * 512 + k] = f2bf(Kt[((dir == 0 ? ii - j : j - ii) * 16 + pp) * 16 + q]); }
    for (int i = tid; i < 256 * 128; i += 512) { const int row = i >> 7, kk = i & 127, ii = row >> 4, pp = row & 15, n = kk >> 1, ri = kk & 1, tau = dir == 0 ? ii + 1 : 16 - ii;
        const f2 c = *(const f2*)(Cc + (pp * 64 + n) * 2), w = *(const f2*)(pw + (n * 17 + tau) * 2);
        TCV[row * 512 + 256 + dir * 128 + kk] = f2bf(ri == 0 ? (c.x * w.x - c.y * w.y) : -(c.x * w.y + c.y * w.x)); }
    bf16* WS5 = (bf16*)(p.ws + WS_WS5) + (size_t)g * 256 * 256 + (size_t)dir * 128 * 256;
    for (int i = tid; i < 128 * 256; i += 512) { const int row = i >> 8, k = i & 255, n = row >> 1, ri = row & 1, ii = k >> 4, q = k & 15, tau = dir == 0 ? 15 - ii : ii;
        const f2 w = *(const f2*)(pw + (n * 17 + tau) * 2), bq = *(const f2*)(Bb + (n * 16 + q) * 2);
        WS5[i] = f2bf(ri == 0 ? w.x * bq.x - w.y * bq.y : w.x * bq.y + w.y * bq.x); }
}
__device__ __forceinline__ void ph_s5diag(const P& p, int g) {
    const float* KD = (const float*)(p.ws + WS_KD); bf16* TCV = (bf16*)(p.ws + WS_TCV) + (size_t)g * 256 * 512;
    for (int i = threadIdx.x; i < 4096; i += 512) { const int ii = i >> 8, pp = (i >> 4) & 15, q = i & 15;
        const float v = KD[g * 256 + pp * 16 + q] + KD[(32 + g) * 256 + pp * 16 + q] + (pp == q ? p.in[16][g * 16 + pp] : 0.f);
        TCV[(ii * 16 + pp) * 512 + ii * 16 + q] = f2bf(v); }
}
__device__ __forceinline__ void ph_s5scan(const P& p, int bx, int G, float* L) {
    const int n = threadIdx.x & 63, s = threadIdx.x >> 6;
    for (int w = bx; w < 256; w += G) { const int b = w >> 6, g = (w >> 1) & 31, dir = w & 1, dg = dir * 32 + g;
        const float lr = p.in[9][dg * 64 + n], li = p.in[10][dg * 64 + n], step = expf(p.in[11][dg]); const float zr = 16.f * lr * step, zi = 16.f * li * step, ez = expf(zr);
        float sn_, cs_; sincosf(zi, &sn_, &cs_); const float ar = ez * cs_, ai = ez * sn_;
        const float ez64 = expf(64.f * zr); sincosf(64.f * zi, &sn_, &cs_); const float Ar = ez64 * cs_, Ai = ez64 * sn_;
        const bf16* sl = (const bf16*)(p.ws + WS_SL) + (size_t)g * NCHUNK_PAD * 256 + dir * 128 + 2 * n;
        bf16* hh = (bf16*)(p.ws + WS_UH) + (size_t)g * NCHUNK_PAD * 512 + 256 + dir * 128 + 2 * n;
        const int k0 = dir ? 511 - 64 * s : 64 * s; const long inc = dir ? -1 : 1;
        const bf16* pc = sl + (size_t)(2048 + b * 16 + (dir ? 15 : 0)) * 256; const bf16* ps = sl + (size_t)(b * 512 + k0) * 256; bf16* ph = hh + (size_t)(b * 512 + k0) * 512;
        unsigned vc[16], v[64];
#pragma unroll
        for (int u = 0; u < 16; ++u) { vc[u] = *(const unsigned*)pc; pc += inc * 256; asm volatile("" : "+v"(pc)); }
#pragma unroll
        for (int u = 0; u < 64; ++u) { v[u] = *(const unsigned*)ps; ps += inc * 256; asm volatile("" : "+v"(ps)); }
        float c0r = 0.f, c0i = 0.f;
#pragma unroll
        for (int u = 0; u < 16; ++u) { const float x = __uint_as_float(vc[u] << 16), y = __uint_as_float(vc[u] & 0xffff0000u); const float nr = ar * c0r - ai * c0i + x, ni = ar * c0i + ai * c0r + y; c0r = nr; c0i = ni; }
        float sr = 0.f, si = 0.f;
#pragma unroll
        for (int u = 0; u < 64; ++u) { const float x = __uint_as_float(v[u] << 16), y = __uint_as_float(v[u] & 0xffff0000u); const float nr = ar * sr - ai * si + x, ni = ar * si + ai * sr + y; sr = nr; si = ni; }
        L[(s * 64 + n) * 2] = sr; L[(s * 64 + n) * 2 + 1] = si;
        __syncthreads();
        sr = c0r; si = c0i;
        for (int t = 0; t < s; ++t) { const float x = L[(t * 64 + n) * 2], y = L[(t * 64 + n) * 2 + 1]; const float nr = Ar * sr - Ai * si + x, ni = Ar * si + Ai * sr + y; sr = nr; si = ni; }
#pragma unroll
        for (int u = 0; u < 64; ++u) { *(unsigned*)ph = pk2(sr, si); ph += inc * 512; asm volatile("" : "+v"(ph));
            const float x = __uint_as_float(v[u] << 16), y = __uint_as_float(v[u] & 0xffff0000u); const float nr = ar * sr - ai * si + x, ni = ar * si + ai * sr + y; sr = nr; si = ni; }
        __syncthreads();
    }
}

__global__ void __launch_bounds__(NWAVES * 64, 2) mk_fwd(P p, int ph_lo, int ph_hi) {
    extern __shared__ __attribute__((aligned(16))) unsigned char lds_raw[];
    LAS unsigned char* lds = (LAS unsigned char*)lds_raw;
    const int tid = threadIdx.x, G = gridDim.x, bx = blockIdx.x;
    const int vcu = (G % 8 == 0) ? (bx % 8) * (G / 8) + bx / 8 : bx;
    for (int u = tid; u < 64; u += NWAVES * 64) ((LAS unsigned*)(lds + LDSCTL_OFF))[u] = 0u;
    __syncthreads();
    unsigned* barw = (unsigned*)(p.ws + WS_CTL) + 4096;
    XcdBarrier bar; bar.bar = barw; bar.x = 0; bar.st = nullptr;
    if (ph_hi - ph_lo > 1) bar = xcd_barrier_post(barw, (volatile LAS unsigned*)(lds + LDSCTL_OFF) + 8);
#define IN(k) (ph_lo <= (k) && (k) < ph_hi)
#define PH(k) if (IN(k))
#define SEAM(k) do { if (IN(k) && IN((k) + 1)) xcd_barrier(bar); } while (0)

    PH(0) { if (bx < 64) ph_s5tab(p, bx >> 1, bx & 1, (float*)lds_raw); else if (bx < 160) ph_mod(p, bx - 64, 96, (float*)lds_raw); ph_rope(p, bx, G); __syncthreads(); ph_wconv(p, bx, lds); }
    SEAM(0);
    PH(1) { ph_h1(p, bx, G); if (bx < 32) ph_s5diag(p, bx); }
    SEAM(1);
    PH(2) {
        pg8::GemmG g{(const char*)(p.ws + WS_H1), (const char*)(p.ws + WS_WIN), 128, (size_t)128 * 1024, (size_t)256 * 1024, 512, 512, nullptr, 0u};
        pg8::SchedProj S; S.init(G, bx);
        pg8::EpiProj E{(bf16*)(p.ws + WS_UH), (bf16*)(p.ws + WS_KB), (bf16*)(p.ws + WS_VB), (bf16*)(p.ws + WS_QB), (unsigned char*)(p.ws + WS_GT), p.in[20], p.in[21], (const float*)(p.ws + WS_ROPE),
                       (const float*)(p.ws + WS_H1S), (const float*)(p.ws + WS_WINS)};
        pg8::gemm_phase<pg8::EpiProj, pg8::SchedProj, pg8::AoRow, false, true, true>(lds + RING_OFF, g, pg8::AoRow{512}, S, E);
    }
    SEAM(2);
    PH(3) {
        pg8::GemmG g{(const char*)(p.ws + WS_UH), (const char*)(p.ws + WS_WS5), 128, (size_t)128 * 512 * 2, (size_t)256 * 512 * 2, 256, 256, nullptr, 0u};
        pg8::SchedS5 S{9, G, bx};
        pg8::EpiSloc E{(bf16*)(p.ws + WS_SL)};
        pg8::gemm_phase(lds + RING_OFF, g, pg8::AoRow{512}, S, E);
    }
    SEAM(3);
    PH(4) { ph_s5scan(p, bx, G, (float*)lds_raw); }
    SEAM(4);
    PH(5) {
        pg8::GemmG g{(const char*)(p.ws + WS_UH), (const char*)(p.ws + WS_TCV), 128, (size_t)128 * 512 * 2, (size_t)256 * 512 * 2, 512, 512, nullptr, 0u};
        pg8::SchedS5 S{8, G, bx};
        pg8::EpiS5Y E{(bf16*)(p.ws + WS_SG)};
        pg8::gemm_phase(lds + RING_OFF, g, pg8::AoRow{512}, S, E);
    }
    PH(6) {
        float gq = 0.f, gk = 0.f;
        for (int d = 0; d < 64; ++d) { gq = fmaxf(gq, fabsf(p.in[20][d])); gk = fmaxf(gk, fabsf(p.in[21][d])); }
        const float mref = 64.f * C2 * gq * gk * 1.02f + 0.05f;
        const attn_body::AttnTensors AT{(const attn_body::bf16*)(p.ws + WS_QB), (const attn_body::bf16*)(p.ws + WS_KB), (const attn_body::bf16*)(p.ws + WS_VB), (attn_body::bf16*)(p.ws + WS_GO) + 512, mref};
        const attn_body::StaticOrder S(G, bx);
        const int kq = bx >> 3, jgap = kq & 3, widx = jgap * 64 + (kq >> 2) * 8 + (bx & 7);
        attn_body::AttnUnit u; int i = 0;
#pragma unroll 1
        for (; i < jgap; ++i) { S.next(i, u); attn_body::attn_unit<8>(u.bh >> 3, u.bh & 7, u.qb, AT.Q, AT.K, AT.V, AT.O, (char*)lds_raw + RING_OFF, AT.mref); }
        ph_wexp(p, widx, lds);
#pragma unroll 1
        for (; i < 4; ++i) { S.next(i, u); attn_body::attn_unit<8>(u.bh >> 3, u.bh & 7, u.qb, AT.Q, AT.K, AT.V, AT.O, (char*)lds_raw + RING_OFF, AT.mref); }
    }
    SEAM(6);
    PH(7) {
        pg8::GemmG g{(const char*)(p.ws + WS_SG), (const char*)(p.ws + WS_WGLU), (size_t)4 * T * 32, (size_t)128 * 32, (size_t)256 * 32, 512, 512, nullptr, 0u};
        pg8::StaticOrder S; S.init(T, 512, G, bx);
        pg8::EpiGlu E{(const bf16*)(p.ws + WS_SG), p.in[18], (bf16*)(p.ws + WS_GO)};
        pg8::gemm_phase(lds + RING_OFF, g, pg8::AoGrp{}, S, E);
    }
    SEAM(7);
    PH(8) {
        pg8::StaticOrder S; S.init(T, 1024, G, bx);
        { pg8::GemmG g{(const char*)(p.ws + WS_GO), (const char*)(p.ws + WS_W12), 128, (size_t)128 * 1024 * 2, (size_t)256 * 1024 * 2, 1024, 512, nullptr, 0u};
          pg8::EpiMerge<0> E{(const unsigned char*)(p.ws + WS_GT), (bf16*)(p.ws + WS_M1), (bf16*)(p.ws + WS_MG)};
          pg8::gemm_phase(lds + RING_OFF, g, pg8::AoRow{1024}, S, E); }
        { pg8::GemmG g{(const char*)(p.ws + WS_GO) + 1024, (const char*)(p.ws + WS_W12) + 1024, 128, (size_t)128 * 1024 * 2, (size_t)256 * 1024 * 2, 1024, 512, nullptr, 0u};
          pg8::EpiMerge<1> E{(const unsigned char*)(p.ws + WS_GT), (bf16*)(p.ws + WS_M1), (bf16*)(p.ws + WS_MG)};
          pg8::gemm_phase(lds + RING_OFF, g, pg8::AoRow{1024}, S, E); }
    }
    SEAM(8);
    PH(9) {
        pg8::GemmG g{(const char*)(p.ws + WS_MG), (const char*)(p.ws + WS_WOUT), 128, (size_t)128 * 1024 * 2, (size_t)256 * 1024 * 2, 1024, 1024, nullptr, 0u};
        pg8::StaticOrder S; S.init(T, 1024, G, bx);
        pg8::EpiOut E{p.in[0], (const float*)(p.ws + WS_MOD), (bf16*)(p.ws + WS_XM)};
        pg8::gemm_phase(lds + RING_OFF, g, pg8::AoRow{1024}, S, E);
    }
    SEAM(9);
    PH(10) { ph_route_a(p, bx, G, (float*)lds_raw); }
    SEAM(10);
    PH(11) { ph_route_b(p, bx, G, (int*)lds_raw); }
    SEAM(11);
    if (IN(12) || IN(13)) {
        const int* TILE_E = (const int*)(p.ws + WS_TILE); LAS int* lt = (LAS int*)(lds + LDS_TILE_OFF);
        for (int i = tid; i < 1024; i += NWAVES * 64) lt[i] = TILE_E[i];
        __syncthreads();
    }
    PH(12) {
        const LAS int* lt = (const LAS int*)(lds + LDS_TILE_OFF);
        pg8::GemmG g{(const char*)(p.ws + WS_H2), (const char*)(p.ws + WS_WGQ), 128, 0, 0, 512, 512, (const int*)(p.ws + WS_SLOTTOK), 1024u};
        pg8::SchedMoE S{lt, lt[1023], 8, G, bx, 0};
        pg8::EpiGU8 E{p.in[27], (const float*)(p.ws + WS_SLOTSA), (const float*)(p.ws + WS_WGS), (bf16*)(p.ws + WS_ACT)};
        pg8::gemm_phase<pg8::EpiGU8, pg8::SchedMoE, pg8::AoRow, true, true, true>(lds + RING_OFF, g, pg8::AoRow{512}, S, E);
    }
    SEAM(12);
    PH(13) {
        const LAS int* lt = (const LAS int*)(lds + LDS_TILE_OFF);
        pg8::GemmG g{(const char*)(p.ws + WS_ACT), (const char*)(p.ws + WS_WD), 128, (size_t)128 * 1024 * 2, (size_t)256 * 1024 * 2, 1024, 1024, nullptr, 0u};
        pg8::SchedMoE S{lt, lt[1023], 4, G, bx, 1};
        pg8::EpiDown E{p.in[29], (const float*)(p.ws + WS_SLOTGATE), (bf16*)(p.ws + WS_YB)};
        pg8::gemm_phase(lds + RING_OFF, g, pg8::AoRow{1024}, S, E);
    }
    SEAM(13);
    PH(14) { ph_final(p, bx, G); }
#undef IN
#undef PH
#undef SEAM
}

extern "C" void kernel_launch(void* const* d_in, const int* in_sizes, int n_in, void* d_out, int out_size, void* d_ws, size_t ws_size, hipStream_t stream) {
    if (n_in != 31 || out_size != T * DM || ws_size < WS_END) { fprintf(stderr, "kernel_launch: unexpected shapes (n_in %d out %d ws %zu)\n", n_in, out_size, ws_size); return; }
    static int grid = 0;
    if (!grid) {
        int dev = 0, cus = 0, per_cu = 0;
        (void)hipGetDevice(&dev); (void)hipDeviceGetAttribute(&cus, hipDeviceAttributeMultiprocessorCount, dev);
        (void)hipFuncSetAttribute((const void*)mk_fwd, hipFuncAttributeMaxDynamicSharedMemorySize, LDS_BYTES);
        (void)hipOccupancyMaxActiveBlocksPerMultiprocessor(&per_cu, (const void*)mk_fwd, NWAVES * 64, LDS_BYTES);
        (void)hipGetLastError();
        if (cus != 256 || per_cu < 1) fprintf(stderr, "kernel_launch: note: %d CUs, occupancy query %d; this kernel is built for one 512-thread workgroup on each of 256 CUs\n", cus, per_cu);
        grid = 256;
    }
    P p{}; for (int i = 0; i < 31; ++i) p.in[i] = (const float*)d_in[i]; p.out = (float*)d_out; p.ws = (unsigned char*)d_ws;
    (void)hipMemsetAsync((char*)d_ws + WS_CTL, 0, 1 * MiB, stream);
    hipLaunchKernelGGL(mk_fwd, dim3(grid), dim3(NWAVES * 64), LDS_BYTES, stream, p, 0, 15);
}
```

```cpp
#include <hip/hip_runtime.h>
#include <cstdio>
#include <cstdint>

constexpr int NB = 4, SEQ = 8192, DM = 1024, LC = 256;
constexpr int T = NB * SEQ;
constexpr int TC = NB * LC;
constexpr int TR = T + TC;
constexpr int DIN = 3328, COL_K = 512, COL_V = 640, COL_Q = 768, COL_GATE = 1280;
constexpr int NMOD = 6 * DM;
constexpr int SKV = LC + SEQ;
constexpr int NE = 32;
constexpr int NSLOT_MAX = 139264;
constexpr int NCHUNK_PAD = 2304;
constexpr float EPS = 1e-6f;
constexpr float C2 = 0.125f * 1.4426950408889634f;

constexpr size_t MiB = 1u << 20;
constexpr size_t WS_CTL = 0;
constexpr size_t WS_MOD = 1 * MiB;
constexpr size_t WS_ROPE = 1 * MiB + 256 * 1024;
constexpr size_t WS_WCNT = 2 * MiB;
constexpr size_t WS_BCNT = 2 * MiB + 256 * 1024;
constexpr size_t WS_KD = 2 * MiB + 384 * 1024;
constexpr size_t WS_TILE = 2 * MiB + 512 * 1024;
constexpr size_t WS_WIN = 4 * MiB, WS_WGLU = 11 * MiB, WS_W12 = 12 * MiB, WS_WOUT = 14 * MiB;
constexpr size_t WS_TCV = 16 * MiB, WS_WS5 = 24 * MiB;
constexpr size_t WS_WGU = 32 * MiB, WS_WD = 160 * MiB;
constexpr size_t WS_SL = 733 * MiB;
constexpr size_t WS_TOPI = 28 * MiB, WS_TOPG = 28 * MiB + 512 * 1024, WS_TOKSLOT = 29 * MiB;
constexpr size_t WS_SLOTTOK = 29 * MiB + 512 * 1024, WS_SLOTGATE = 30 * MiB + 512 * 1024;
constexpr size_t WS_XM = 224 * MiB;
constexpr size_t WS_H2 = 352 * MiB;
constexpr size_t WS_H2S = 384 * MiB;
constexpr size_t WS_SLOTSA = 385 * MiB;
constexpr size_t WS_WGQ = 288 * MiB;
constexpr size_t WS_WGS = 3 * MiB;
constexpr size_t WS_H1 = 417 * MiB;
constexpr size_t WS_H1S = 451 * MiB;
constexpr size_t WS_WINS = 3 * MiB + 256 * 1024;
constexpr size_t WS_UH = 483 * MiB;
constexpr size_t WS_KB = 555 * MiB, WS_VB = 564 * MiB;
constexpr size_t WS_QB = 573 * MiB;
constexpr size_t WS_GT = 605 * MiB;
constexpr size_t WS_SG = 769 * MiB;
constexpr size_t WS_GO = 801 * MiB;
constexpr size_t WS_M1 = 865 * MiB;
constexpr size_t WS_MG = 417 * MiB;
constexpr size_t WS_ACT = 417 * MiB;
constexpr size_t WS_YB = 689 * MiB;
constexpr size_t WS_END = 993 * MiB;

typedef unsigned short bf16;
struct P { const float* in[31]; float* out; unsigned char* ws; };

__device__ __forceinline__ float bf2f(bf16 v) { return __uint_as_float(((unsigned)v) << 16); }
__device__ __forceinline__ bf16 f2bf(float f) { unsigned u = __float_as_uint(f); return (bf16)((u + 0x7fffu + ((u >> 16) & 1u)) >> 16); }
__device__ __forceinline__ unsigned pk2(float lo, float hi) { return (unsigned)f2bf(lo) | ((unsigned)f2bf(hi) << 16); }
__device__ __forceinline__ float wave_sum(float v) {
#pragma unroll
    for (int o = 1; o < 64; o <<= 1) v += __shfl_xor(v, o);
    return v;
}
__device__ __forceinline__ float sigmoidf(float v) { return 1.f / (1.f + expf(-v)); }

__device__ __forceinline__ void ph_mod(const P& p, int bid, int nb, float* lds) {
    float* s = lds; float* red = lds + 5 * 1024;
    const float* c = p.in[1]; const float* cc = p.in[3];
    for (int i = threadIdx.x; i < 5 * 1024; i += 512) { const float v = i < 4096 ? c[i] : cc[i - 4096]; s[i] = v / (1.f + expf(-v)); }
    __syncthreads();
    const float* w = p.in[4]; const float* bm = p.in[5]; float* mod = (float*)(p.ws + WS_MOD);
    const int jl = threadIdx.x & 63, ks = threadIdx.x >> 6;
    for (int it = bid; it < 96; it += nb) {
        const int j = it * 64 + jl;
        float a0 = 0.f, a1 = 0.f, a2 = 0.f, a3 = 0.f, a4 = 0.f;
#pragma unroll 1
        for (int k0 = ks * 128; k0 < ks * 128 + 128; k0 += 64) { float wv[64];
#pragma unroll
            for (int q = 0; q < 64; ++q) wv[q] = w[(size_t)(k0 + q) * NMOD + j];
#pragma unroll
            for (int q = 0; q < 64; ++q) { const int k = k0 + q; a0 += s[k] * wv[q]; a1 += s[1024 + k] * wv[q]; a2 += s[2048 + k] * wv[q]; a3 += s[3072 + k] * wv[q]; a4 += s[4096 + k] * wv[q]; }
        }
        red[(ks * 5 + 0) * 64 + jl] = a0; red[(ks * 5 + 1) * 64 + jl] = a1; red[(ks * 5 + 2) * 64 + jl] = a2; red[(ks * 5 + 3) * 64 + jl] = a3; red[(ks * 5 + 4) * 64 + jl] = a4;
        __syncthreads();
        if (threadIdx.x < 320) { const int r = threadIdx.x >> 6; float t = 0.f;
            for (int q = 0; q < 8; ++q) t += red[(q * 5 + r) * 64 + jl];
            mod[r * NMOD + j] = t + bm[j]; }
        __syncthreads();
    }
}
__device__ __forceinline__ void ph_rope(const P& p, int bid, int nb) {
    float* R = (float*)(p.ws + WS_ROPE);
    for (int i = bid * 512 + threadIdx.x; i < 192 * 16; i += nb * 512) {
        const int j = i & 15; const int pos = i >> 4;
        const float invf = powf(10000.f, -(float)j / 16.f);
        if (pos < 128) { const float a = (float)pos * invf; R[pos * 16 + j] = cosf(a); R[2048 + pos * 16 + j] = sinf(a); }
        else { const int cp = pos - 128; const float a = (float)cp * invf; R[4096 + cp * 16 + j] = cosf(a); R[5120 + cp * 16 + j] = sinf(a); }
    }
}
__device__ __forceinline__ void ph_h1_row(const float4 (&v)[4], const float4 (&gf)[4], const float4 (&sh)[4], signed char* orow, float* oscale, int lane) {
    float ss = 0.f;
#pragma unroll
    for (int j = 0; j < 4; ++j) ss += v[j].x * v[j].x + v[j].y * v[j].y + v[j].z * v[j].z + v[j].w * v[j].w;
    ss = wave_sum(ss); const float rs = 1.f / sqrtf(ss * (1.f / DM) + EPS); float h[4][4]; float am = 0.f;
#pragma unroll
    for (int j = 0; j < 4; ++j) { h[j][0] = v[j].x * rs * gf[j].x + sh[j].x; h[j][1] = v[j].y * rs * gf[j].y + sh[j].y; h[j][2] = v[j].z * rs * gf[j].z + sh[j].z; h[j][3] = v[j].w * rs * gf[j].w + sh[j].w;
        am = fmaxf(fmaxf(am, fmaxf(fabsf(h[j][0]), fabsf(h[j][1]))), fmaxf(fabsf(h[j][2]), fabsf(h[j][3]))); }
#pragma unroll
    for (int o = 1; o < 64; o <<= 1) am = fmaxf(am, __shfl_xor(am, o));
    const float inv = am > 0.f ? 127.f / am : 0.f;
#pragma unroll
    for (int j = 0; j < 4; ++j) { const int q0 = __float2int_rn(h[j][0] * inv), q1 = __float2int_rn(h[j][1] * inv), q2 = __float2int_rn(h[j][2] * inv), q3 = __float2int_rn(h[j][3] * inv);
        *(unsigned*)(orow + 4 * lane + 256 * j) = (unsigned)(q0 & 255) | ((unsigned)(q1 & 255) << 8) | ((unsigned)(q2 & 255) << 16) | ((unsigned)(q3 & 255) << 24); }
    if (lane == 0) *oscale = am * (1.f / 127.f);
}
__device__ __forceinline__ void ph_h1(const P& p, int bid, int nb) {
    const int lane = threadIdx.x & 63, wave = threadIdx.x >> 6, gw = bid * 8 + wave, ngw = nb * 8;
    const float* g = p.in[6]; const float* mod = (const float*)(p.ws + WS_MOD); signed char* H1 = (signed char*)(p.ws + WS_H1); float* H1S = (float*)(p.ws + WS_H1S);
    const int rpw = T / ngw;
    float4 gf[4], sh[4], v[4], v1[4], v2[4];
#define H1_MOD(mrow) do { _Pragma("unroll") for (int j = 0; j < 4; ++j) { const int col = 4 * lane + 256 * j; const float4 gg = *(const float4*)(g + col), sc = *(const float4*)(mod + (mrow) * NMOD + 1024 + col); \
        sh[j] = *(const float4*)(mod + (mrow) * NMOD + col); gf[j] = make_float4(gg.x * (1.f + sc.x), gg.y * (1.f + sc.y), gg.z * (1.f + sc.z), gg.w * (1.f + sc.w)); } } while (0)
#define H1_LOAD(V, xr) do { _Pragma("unroll") for (int j = 0; j < 4; ++j) V[j] = ((const float4*)(xr))[lane + 64 * j]; } while (0)
    const int r0 = gw * rpw; const float* x0 = p.in[0] + (size_t)r0 * DM;
    H1_LOAD(v, x0); H1_LOAD(v1, x0 + DM);
    H1_MOD(r0 / SEQ);
    for (int k = 0; k < rpw; ++k) {
        if (k + 2 < rpw) H1_LOAD(v2, x0 + (size_t)(k + 2) * DM);
        ph_h1_row(v, gf, sh, H1 + (size_t)(r0 + k) * DM, H1S + r0 + k, lane);
#pragma unroll
        for (int j = 0; j < 4; ++j) { v[j] = v1[j]; v1[j] = v2[j]; }
    }
    for (int rc = gw; rc < TC; rc += ngw) { H1_LOAD(v, p.in[2] + (size_t)rc * DM); H1_MOD(4); ph_h1_row(v, gf, sh, H1 + (size_t)(T + rc) * DM, H1S + T + rc, lane); }
#undef H1_LOAD
#undef H1_MOD
}
__device__ __forceinline__ void ph_wgquant(const P& p, int bid, int nb) {
    const int lane = threadIdx.x & 63, wave = threadIdx.x >> 6, gw = bid * 8 + wave, ngw = nb * 8;
    const bf16* WG = (const bf16*)(p.ws + WS_WGU); signed char* WQ = (signed char*)(p.ws + WS_WGQ); float* WS = (float*)(p.ws + WS_WGS);
    constexpr int NROWS = 32 * 2048; const int rpw = NROWS / ngw, r0 = gw * rpw;
    uint4 va[2], vb[2], vc[2];
#define WQ_LOAD(V, r) do { const uint4* s_ = (const uint4*)(WG + (size_t)(r) * 1024) + 2 * lane; V[0] = s_[0]; V[1] = s_[1]; } while (0)
    WQ_LOAD(va, r0); WQ_LOAD(vb, r0 + 1);
    for (int k = 0; k < rpw; ++k) { if (k + 2 < rpw) WQ_LOAD(vc, r0 + k + 2);
        const unsigned w[8] = {va[0].x, va[0].y, va[0].z, va[0].w, va[1].x, va[1].y, va[1].z, va[1].w}; float f[16]; float am = 0.f;
#pragma unroll
        for (int j = 0; j < 8; ++j) { f[2 * j] = __uint_as_float(w[j] << 16); f[2 * j + 1] = __uint_as_float(w[j] & 0xffff0000u); am = fmaxf(am, fmaxf(fabsf(f[2 * j]), fabsf(f[2 * j + 1]))); }
#pragma unroll
        for (int o = 1; o < 64; o <<= 1) am = fmaxf(am, __shfl_xor(am, o));
        const float inv = am > 0.f ? 127.f / am : 0.f; unsigned o4[4];
#pragma unroll
        for (int j = 0; j < 4; ++j) { const int q0 = __float2int_rn(f[4 * j] * inv), q1 = __float2int_rn(f[4 * j + 1] * inv), q2 = __float2int_rn(f[4 * j + 2] * inv), q3 = __float2int_rn(f[4 * j + 3] * inv);
            o4[j] = (unsigned)(q0 & 255) | ((unsigned)(q1 & 255) << 8) | ((unsigned)(q2 & 255) << 16) | ((unsigned)(q3 & 255) << 24); }
        *(uint4*)(WQ + (size_t)(r0 + k) * 1024 + 16 * lane) = make_uint4(o4[0], o4[1], o4[2], o4[3]);
        if (lane == 0) WS[r0 + k] = am * (1.f / 127.f);
        va[0] = vb[0]; va[1] = vb[1]; vb[0] = vc[0]; vb[1] = vc[1]; }
#undef WQ_LOAD
}
typedef short rt_bf16x8 __attribute__((ext_vector_type(8)));
typedef float rt_f32x4 __attribute__((ext_vector_type(4)));
typedef unsigned rt_u32x4 __attribute__((ext_vector_type(4)));
typedef float rt_f32x2 __attribute__((ext_vector_type(2))); typedef __bf16 rt_bf16x2 __attribute__((ext_vector_type(2)));
__device__ __forceinline__ unsigned rt_pk(float lo, float hi) { const rt_f32x2 v = {lo, hi}; const rt_bf16x2 b = __builtin_convertvector(v, rt_bf16x2); return __builtin_bit_cast(unsigned, b); }
__device__ __forceinline__ void ph_route_a(const P& p, int bid, int nb, float* ldsf) {
    typedef __attribute__((address_space(3))) unsigned char lds_b;
    lds_b* lds = (lds_b*)ldsf;
    const int tid = threadIdx.x, lane = tid & 63, wave = tid >> 6, gw = bid * 8 + wave;
    const int rpw = 16; const int r0 = gw * rpw, b = (bid * 8 * rpw) / SEQ;
    const float* rw = p.in[24]; const float* g = p.in[7]; const float* mod = (const float*)(p.ws + WS_MOD); const bf16* XM = (const bf16*)(p.ws + WS_XM);
    signed char* H2 = (signed char*)(p.ws + WS_H2); float* H2S = (float*)(p.ws + WS_H2S); int* TOPI = (int*)(p.ws + WS_TOPI); float* TOPG = (float*)(p.ws + WS_TOPG); int* WCNT = (int*)(p.ws + WS_WCNT);
    float* ggs = ldsf + 32768 + 2048; float* shs = ggs + 1024; float* biasp = ldsf + 32768 + 512; float* red = ldsf + 32768 + 1024;
    if (bid == 0) { for (int i = tid; i < 256; i += 512) ((unsigned*)(H2 + (size_t)T * DM))[i] = 0u; if (tid == 0) H2S[T] = 0.f; }
    for (int c = tid; c < 1024; c += 512) { ggs[c] = g[c] * (1.f + mod[b * NMOD + 4096 + c]); shs[c] = mod[b * NMOD + 3072 + c]; }
    __syncthreads();
    { const int e = tid & 31, part = tid >> 5;
      float a = 0.f;
#pragma unroll 8
      for (int k = part * 64; k < part * 64 + 64; ++k) a += shs[k] * rw[k * 32 + e];
      red[part * 32 + e] = a; }
    for (int it = tid; it < 4096; it += 512) { const int e = it & 31, c = it >> 5;
        float w[8];
#pragma unroll
        for (int j = 0; j < 8; ++j) w[j] = rw[(8 * c + j) * 32 + e] * ggs[8 * c + j];
        unsigned hi[4], lo[4];
#pragma unroll
        for (int j = 0; j < 4; ++j) { hi[j] = rt_pk(w[2 * j], w[2 * j + 1]); lo[j] = rt_pk(w[2 * j] - __uint_as_float(hi[j] << 16), w[2 * j + 1] - __uint_as_float(hi[j] & 0xffff0000u)); }
        const int off = (e * 1024 + ((c ^ (e & 15)) << 3)) * 2;
        *(__attribute__((address_space(3))) rt_u32x4*)(lds + off) = (rt_u32x4){hi[0], hi[1], hi[2], hi[3]};
        *(__attribute__((address_space(3))) rt_u32x4*)(lds + 65536 + off) = (rt_u32x4){lo[0], lo[1], lo[2], lo[3]}; }
    __syncthreads();
    if (tid < 32) { float a = p.in[25][tid]; for (int q = 0; q < 16; ++q) a += red[q * 32 + tid]; biasp[tid] = a; }
    __syncthreads();
    const int r = lane & 15, kq = lane >> 4;
    const bf16* xp = XM + (size_t)(r0 + r) * DM + 8 * kq;
    rt_f32x4 acc0 = {0.f, 0.f, 0.f, 0.f}, acc1 = {0.f, 0.f, 0.f, 0.f}; float ss = 0.f;
#pragma unroll 4
    for (int ks = 0; ks < 32; ++ks) {
        const rt_u32x4 xw = *(const rt_u32x4*)(xp + 32 * ks);
#pragma unroll
        for (int j = 0; j < 4; ++j) { const float a0 = __uint_as_float(xw[j] << 16), a1 = __uint_as_float(xw[j] & 0xffff0000u); ss += a0 * a0 + a1 * a1; }
        const rt_bf16x8 Ah = __builtin_bit_cast(rt_bf16x8, xw);
        const int c = 4 * ks + kq;
        const int o0 = (r * 1024 + ((c ^ r) << 3)) * 2, o1 = ((16 + r) * 1024 + ((c ^ r) << 3)) * 2;
        const rt_bf16x8 Bh0 = *(const __attribute__((address_space(3))) rt_bf16x8*)(lds + o0), Bl0 = *(const __attribute__((address_space(3))) rt_bf16x8*)(lds + 65536 + o0);
        const rt_bf16x8 Bh1 = *(const __attribute__((address_space(3))) rt_bf16x8*)(lds + o1), Bl1 = *(const __attribute__((address_space(3))) rt_bf16x8*)(lds + 65536 + o1);
        acc0 = __builtin_amdgcn_mfma_f32_16x16x32_bf16(Ah, Bh0, acc0, 0, 0, 0); acc1 = __builtin_amdgcn_mfma_f32_16x16x32_bf16(Ah, Bh1, acc1, 0, 0, 0);
        acc0 = __builtin_amdgcn_mfma_f32_16x16x32_bf16(Ah, Bl0, acc0, 0, 0, 0); acc1 = __builtin_amdgcn_mfma_f32_16x16x32_bf16(Ah, Bl1, acc1, 0, 0, 0);
    }
    ss += __shfl_xor(ss, 16); ss += __shfl_xor(ss, 32);
    const float rs = 1.f / sqrtf(ss * (1.f / DM) + EPS);
    const int e0 = r, e1 = 16 + r; const float bp0 = biasp[e0], bp1 = biasp[e1];
    float lg0[4], lg1[4];
#pragma unroll
    for (int q = 0; q < 4; ++q) { const float rst = __shfl(rs, 4 * kq + q); lg0[q] = acc0[q] * rst + bp0; lg1[q] = acc1[q] * rst + bp1; }
    float tv[4][4]; int ti[4][4]; int cnt0 = 0, cnt1 = 0;
#pragma unroll
    for (int k = 0; k < 4; ++k) {
#pragma unroll
        for (int q = 0; q < 4; ++q) { float m = lg0[q]; int mi = e0; if (lg1[q] > m) { m = lg1[q]; mi = e1; }
#pragma unroll
            for (int off = 1; off < 16; off <<= 1) { const float om = __shfl_xor(m, off); const int oi = __shfl_xor(mi, off); if (om > m || (om == m && oi < mi)) { m = om; mi = oi; } }
            tv[k][q] = m; ti[k][q] = mi; if (mi == e0) { lg0[q] = -INFINITY; ++cnt0; } if (mi == e1) { lg1[q] = -INFINITY; ++cnt1; } } }
    if (r == 0) {
#pragma unroll
        for (int q = 0; q < 4; ++q) { const int t = r0 + 4 * kq + q; const float x1 = expf(tv[1][q] - tv[0][q]), x2 = expf(tv[2][q] - tv[0][q]), x3 = expf(tv[3][q] - tv[0][q]); const float inv = 1.f / (1.f + x1 + x2 + x3);
            *(int4*)(TOPI + t * 4) = make_int4(ti[0][q], ti[1][q], ti[2][q], ti[3][q]); *(float4*)(TOPG + t * 4) = make_float4(inv, x1 * inv, x2 * inv, x3 * inv); } }
    cnt0 += __shfl_xor(cnt0, 16); cnt0 += __shfl_xor(cnt0, 32); cnt1 += __shfl_xor(cnt1, 16); cnt1 += __shfl_xor(cnt1, 32);
    if (kq == 0) { WCNT[gw * 32 + e0] = cnt0; WCNT[gw * 32 + e1] = cnt1; }
    { float4 gf[4], sf[4]; uint2 v[4], v1[4], v2[4];
#pragma unroll
      for (int j = 0; j < 4; ++j) { gf[j] = *(const float4*)(ggs + 4 * lane + 256 * j); sf[j] = *(const float4*)(shs + 4 * lane + 256 * j); }
      const bf16* x0 = XM + (size_t)r0 * DM;
#define RT_LOAD(V, xr) do { _Pragma("unroll") for (int j = 0; j < 4; ++j) V[j] = ((const uint2*)(xr))[lane + 64 * j]; } while (0)
      RT_LOAD(v, x0); RT_LOAD(v1, x0 + DM);
      for (int k = 0; k < 16; ++k) { if (k + 2 < 16) RT_LOAD(v2, x0 + (size_t)(k + 2) * DM);
          const float rk = __shfl(rs, k); float h[4][4]; float am = 0.f;
#pragma unroll
          for (int j = 0; j < 4; ++j) { const float a0 = __uint_as_float(v[j].x << 16), a1 = __uint_as_float(v[j].x & 0xffff0000u), a2 = __uint_as_float(v[j].y << 16), a3 = __uint_as_float(v[j].y & 0xffff0000u);
              h[j][0] = a0 * rk * gf[j].x + sf[j].x; h[j][1] = a1 * rk * gf[j].y + sf[j].y; h[j][2] = a2 * rk * gf[j].z + sf[j].z; h[j][3] = a3 * rk * gf[j].w + sf[j].w;
              am = fmaxf(fmaxf(am, fmaxf(fabsf(h[j][0]), fabsf(h[j][1]))), fmaxf(fabsf(h[j][2]), fabsf(h[j][3]))); }
#pragma unroll
          for (int o = 1; o < 64; o <<= 1) am = fmaxf(am, __shfl_xor(am, o));
          const float inv = am > 0.f ? 127.f / am : 0.f;
#pragma unroll
          for (int j = 0; j < 4; ++j) { const int q0 = __float2int_rn(h[j][0] * inv), q1 = __float2int_rn(h[j][1] * inv), q2 = __float2int_rn(h[j][2] * inv), q3 = __float2int_rn(h[j][3] * inv);
              *(unsigned*)(H2 + (size_t)(r0 + k) * DM + 4 * lane + 256 * j) = (unsigned)(q0 & 255) | ((unsigned)(q1 & 255) << 8) | ((unsigned)(q2 & 255) << 16) | ((unsigned)(q3 & 255) << 24); }
          if (lane == 0) H2S[r0 + k] = am * (1.f / 127.f);
#pragma unroll
          for (int j = 0; j < 4; ++j) { v[j] = v1[j]; v1[j] = v2[j]; } }
#undef RT_LOAD
    }
    __syncthreads();
    int* li = (int*)ldsf; if (kq == 0) { li[wave * 32 + e0] = cnt0; li[wave * 32 + e1] = cnt1; }
    __syncthreads();
    if (tid < 32) { int a = 0; for (int w = 0; w < 8; ++w) a += li[w * 32 + tid]; ((int*)(p.ws + WS_BCNT))[bid * 32 + tid] = a; }
}
__device__ __forceinline__ void ph_route_b(const P& p, int bid, int nb, int* ldsI) {
    int* partT = ldsI; int* partB = ldsI + 512; int* total = ldsI + 1024; int* before = ldsI + 1056; int* pstart = ldsI + 1088;
    const int* WCNT = (const int*)(p.ws + WS_WCNT); const int* TOPI = (const int*)(p.ws + WS_TOPI); const float* TOPG = (const float*)(p.ws + WS_TOPG);
    int* SLOT_TOK = (int*)(p.ws + WS_SLOTTOK); float* SLOT_GATE = (float*)(p.ws + WS_SLOTGATE); int* TOK_SLOT = (int*)(p.ws + WS_TOKSLOT); int* TILE_E = (int*)(p.ws + WS_TILE);
    const float* H2S = (const float*)(p.ws + WS_H2S); float* SLOT_SA = (float*)(p.ws + WS_SLOTSA);
    const int t = threadIdx.x, e = t & 31, part = t >> 5, gw0 = bid * 8, nwav = nb * 8, per = nb / 16;
    const int* BCNT = (const int*)(p.ws + WS_BCNT);
    int sT = 0, sB = 0;
    { int c[16];
#pragma unroll
      for (int q = 0; q < 16; ++q) c[q] = (q < per) ? BCNT[(part * per + q) * 32 + e] : 0;
#pragma unroll
      for (int q = 0; q < 16; ++q) { sT += c[q]; if (part * per + q < bid) sB += c[q]; } }
    partT[part * 32 + e] = sT; partB[part * 32 + e] = sB;
    __syncthreads();
    if (t < 32) { int a = 0, bsum = 0; for (int q = 0; q < 16; ++q) { a += partT[q * 32 + t]; bsum += partB[q * 32 + t]; } total[t] = a; before[t] = bsum; }
    __syncthreads();
    if (t == 0) { int acc = 0; for (int q = 0; q < 32; ++q) { pstart[q] = acc; acc += ((total[q] + 255) / 256) * 256; } pstart[32] = acc; }
    __syncthreads();
    const int lane = t & 63, wave = t >> 6, my_e = (lane >> 1) & 31, rpw = T / nwav;
    int base = pstart[my_e] + before[my_e];
    for (int w = 0; w < wave; ++w) base += WCNT[(gw0 + w) * 32 + my_e];
    int run = 0;
    const int rb0 = (gw0 + wave) * rpw;
    for (int r8 = 0; r8 < rpw; r8 += 8) { int4 tiv[8]; float4 tgv[8]; float sav[8];
#pragma unroll
        for (int q = 0; q < 8; ++q) { tiv[q] = *(const int4*)(TOPI + (rb0 + r8 + q) * 4); tgv[q] = *(const float4*)(TOPG + (rb0 + r8 + q) * 4); sav[q] = H2S[rb0 + r8 + q]; }
#pragma unroll
        for (int q = 0; q < 8; ++q) { const int r = rb0 + r8 + q;
            const int tia[4] = {tiv[q].x, tiv[q].y, tiv[q].z, tiv[q].w}; const float tga[4] = {tgv[q].x, tgv[q].y, tgv[q].z, tgv[q].w}; int sl[4];
#pragma unroll
            for (int k = 0; k < 4; ++k) { const int ek = tia[k]; sl[k] = __shfl(base + run, 2 * ek); if (my_e == ek) run++; }
            if (lane == 0) { SLOT_TOK[sl[0]] = r; SLOT_TOK[sl[1]] = r; SLOT_TOK[sl[2]] = r; SLOT_TOK[sl[3]] = r;
                SLOT_GATE[sl[0]] = tga[0]; SLOT_GATE[sl[1]] = tga[1]; SLOT_GATE[sl[2]] = tga[2]; SLOT_GATE[sl[3]] = tga[3]; *(int4*)(TOK_SLOT + r * 4) = make_int4(sl[0], sl[1], sl[2], sl[3]);
                SLOT_SA[sl[0]] = sav[q]; SLOT_SA[sl[1]] = sav[q]; SLOT_SA[sl[2]] = sav[q]; SLOT_SA[sl[3]] = sav[q]; } }
    }
    if (bid == 0) {
        for (int q = wave; q < 32; q += 8) { const int ps = pstart[q], pe = pstart[q + 1];
            for (int s = ps + total[q] + lane; s < pe; s += 64) { SLOT_TOK[s] = T; SLOT_GATE[s] = 0.f; SLOT_SA[s] = 0.f; }
            for (int tl = ps / 256 + lane; tl < pe / 256; tl += 64) TILE_E[tl] = q; }
        if (t == 0) TILE_E[1023] = pstart[32] / 256;
    }
}
__device__ __forceinline__ void ph_final(const P& p, int bid, int nb) {
    const int lane = threadIdx.x & 63, wave = threadIdx.x >> 6, gw = bid * 8 + wave, ngw = nb * 8;
    const float* gfin = p.in[30]; const float* mod = (const float*)(p.ws + WS_MOD); const bf16* XM = (const bf16*)(p.ws + WS_XM);
    const bf16* YB = (const bf16*)(p.ws + WS_YB); const int* TOK_SLOT = (const int*)(p.ws + WS_TOKSLOT);
    float4 gf[4];
#pragma unroll
    for (int j = 0; j < 4; ++j) gf[j] = *(const float4*)(gfin + 4 * lane + 256 * j);
    uint2 yc[4][4], yn[4][4]; uint2 xc[4], xn[4]; int4 sl1, sl2;
#define FIN_LOAD(Y, X, SL, R) do { const int sla_[4] = {SL.x, SL.y, SL.z, SL.w}; _Pragma("unroll") for (int j = 0; j < 4; ++j) { const int col = 4 * lane + 256 * j; \
        X[j] = *(const uint2*)(XM + (size_t)(R) * DM + col); _Pragma("unroll") for (int k = 0; k < 4; ++k) Y[k][j] = *(const uint2*)(YB + (size_t)sla_[k] * DM + col); } } while (0)
    int r = gw;
    sl1 = *(const int4*)(TOK_SLOT + r * 4);
    FIN_LOAD(yc, xc, sl1, r);
    if (r + ngw < T) sl1 = *(const int4*)(TOK_SLOT + (r + ngw) * 4);
    for (; r < T; r += ngw) {
        const int rn = r + ngw, rnn = rn + ngw;
        if (rnn < T) sl2 = *(const int4*)(TOK_SLOT + rnn * 4);
        if (rn < T) FIN_LOAD(yn, xn, sl1, rn);
        const int b = r / SEQ; float4 v[4]; float ss = 0.f;
#pragma unroll
        for (int j = 0; j < 4; ++j) { const int col = 4 * lane + 256 * j; float f0 = 0.f, f1 = 0.f, f2 = 0.f, f3 = 0.f;
#pragma unroll
            for (int k = 0; k < 4; ++k) { const uint2 y = yc[k][j];
                f0 += __uint_as_float(y.x << 16); f1 += __uint_as_float(y.x & 0xffff0000u); f2 += __uint_as_float(y.y << 16); f3 += __uint_as_float(y.y & 0xffff0000u); }
            const float4 g2 = *(const float4*)(mod + b * NMOD + 5120 + col);
            v[j].x = __uint_as_float(xc[j].x << 16) + g2.x * f0; v[j].y = __uint_as_float(xc[j].x & 0xffff0000u) + g2.y * f1; v[j].z = __uint_as_float(xc[j].y << 16) + g2.z * f2; v[j].w = __uint_as_float(xc[j].y & 0xffff0000u) + g2.w * f3;
            ss += v[j].x * v[j].x + v[j].y * v[j].y + v[j].z * v[j].z + v[j].w * v[j].w; }
        ss = wave_sum(ss); const float rs = 1.f / sqrtf(ss * (1.f / DM) + EPS);
#pragma unroll
        for (int j = 0; j < 4; ++j) { const int col = 4 * lane + 256 * j;
            *(float4*)(p.out + (size_t)r * DM + col) = make_float4(v[j].x * rs * gf[j].x, v[j].y * rs * gf[j].y, v[j].z * rs * gf[j].z, v[j].w * rs * gf[j].w); }
#pragma unroll
        for (int j = 0; j < 4; ++j) { xc[j] = xn[j];
#pragma unroll
            for (int k = 0; k < 4; ++k) yc[k][j] = yn[k][j]; }
        sl1 = sl2;
    }
#undef FIN_LOAD
}

namespace pg8 {
#define PG8_LAS __attribute__((address_space(3)))
typedef unsigned short bf16_t;
typedef short bf16x8 __attribute__((ext_vector_type(8)));
typedef float f32x4 __attribute__((ext_vector_type(4)));
typedef unsigned u32x4 __attribute__((ext_vector_type(4)));
typedef int i32x4 __attribute__((ext_vector_type(4)));
typedef unsigned u32x2 __attribute__((ext_vector_type(2)));
template <bool I8> struct AccT { typedef f32x4 type; }; template <> struct AccT<true> { typedef i32x4 type; };
constexpr int BM = 256, BK = 64, HALF = 128, HTB = HALF * BK * 2  , STAGE_BYTES = 8 * HTB, NXCD = 8, WGM = 8;

__host__ __device__ __forceinline__ int lds_byte(int r, int c) { const int st = (r >> 4) * 2 + (c >> 5), rr = r & 15, cc = c & 31, ob = rr * 64 + cc * 2; return st * 1024 + (ob ^ (((ob >> 9) & 1) << 5)); }
__host__ __device__ __forceinline__ void stage_rc(int b, int& R, int& C) { const int st = b / 1024, sb = b % 1024, swz = sb ^ (((sb >> 9) & 1) << 5); R = (st >> 1) * 16 + swz / 64; C = (st & 1) * 32 + (swz % 64) / 2; }
__host__ __device__ __forceinline__ int perm32(int rho) { const int n = rho >> 4, i = rho & 15; return 8 * (i >> 2) + 4 * n + (i & 3); }

struct Unit { int pm, pn; };
struct GemmG { const char* A; const char* Bt; size_t a_kstep, a_hstep, a_tstep; int ldb; int K; const int* gidx; unsigned g_row; };
struct AoRow { int lda; __device__ __forceinline__ unsigned operator()(int R, int C) const { return (unsigned)(R * lda + C) * 2u; } };
struct AoGrp { __device__ __forceinline__ unsigned operator()(int R, int C) const { return (unsigned)(((C >> 4) * T + R) * 16 + (C & 15)) * 2u; } };

struct StaticOrder {
    int nM, nN, nwg, G, c;
    __host__ __device__ void init(int M, int N, int G_, int c_) { nM = M / BM; nN = N / BM; nwg = nM * nN; G = G_; c = c_; }
    __host__ __device__ bool next(int i, Unit& u) const {
        const long L = (long)i * G + c; if (L >= nwg) return false;
        int wgid = (int)L; { const int q = nwg / NXCD, r = nwg % NXCD, xcd = wgid % NXCD, off = wgid / NXCD; wgid = (xcd < r ? xcd * (q + 1) : r * (q + 1) + (xcd - r) * q) + off; }
        const int nig = WGM * nN, gid = wgid / nig, fm = gid * WGM, gsz = (nM - fm) < WGM ? (nM - fm) : WGM;
        u.pm = fm + ((wgid % nig) % gsz); u.pn = (wgid % nig) / gsz; return true;
    }
};
typedef float f32x2_t __attribute__((ext_vector_type(2))); typedef __bf16 bf16x2_t __attribute__((ext_vector_type(2)));
__device__ __forceinline__ unsigned cvt_pk_bf16(float lo, float hi) { const f32x2_t v = {lo, hi}; const bf16x2_t b = __builtin_convertvector(v, bf16x2_t); return __builtin_bit_cast(unsigned, b); }
__device__ __forceinline__ u32x4 pack8(const f32x4 a, const f32x4 b) { u32x4 w; w.x = cvt_pk_bf16(a[0], a[1]); w.y = cvt_pk_bf16(a[2], a[3]); w.z = cvt_pk_bf16(b[0], b[1]); w.w = cvt_pk_bf16(b[2], b[3]); return w; }
__device__ __forceinline__ f32x4 unpack_lo(const u32x4 w) { return (f32x4){__uint_as_float(w.x << 16), __uint_as_float(w.x & 0xffff0000u), __uint_as_float(w.y << 16), __uint_as_float(w.y & 0xffff0000u)}; }
__device__ __forceinline__ f32x4 unpack_hi(const u32x4 w) { return (f32x4){__uint_as_float(w.z << 16), __uint_as_float(w.z & 0xffff0000u), __uint_as_float(w.w << 16), __uint_as_float(w.w & 0xffff0000u)}; }
__device__ __forceinline__ float fsig(float v) { return __builtin_amdgcn_rcpf(1.f + __builtin_amdgcn_exp2f(-1.4426950408889634f * v)); }
__device__ __forceinline__ f32x4 fsig4(const f32x4 v) { return (f32x4){fsig(v[0]), fsig(v[1]), fsig(v[2]), fsig(v[3])}; }

template <class Epi, class Sched, class AO, bool GATHER = false, bool ALIGN_EPI = true, bool I8 = false>
__device__ __forceinline__ void gemm_phase(PG8_LAS unsigned char* lds, const GemmG g, const AO& ao, const Sched& S, const Epi& E) {
    const int tid = threadIdx.x, wid = __builtin_amdgcn_readfirstlane(tid >> 6), lane = tid & 63, wr = wid >> 2, wc = wid & 3, fr = lane & 15, fq = lane >> 4;
    const int K = g.K, nt = K / BK;
    unsigned voffB[2]; unsigned oc[2][2], on[2][2]; int RA[2]; unsigned CA2[2];
#pragma unroll
    for (int i = 0; i < 2; ++i) { int R, C; stage_rc(tid * 16 + i * 8192, R, C); const int Rb = (R & ~31) + perm32(R & 31);
        voffB[i] = (unsigned)(Rb * g.ldb + C) * 2u; RA[i] = R; CA2[i] = (unsigned)C * 2u;
        if constexpr (!GATHER) { oc[0][i] = ao(R, C); oc[1][i] = oc[0][i] + (unsigned)g.a_hstep; on[0][i] = oc[0][i]; on[1][i] = oc[1][i]; } }
    const size_t kstepA = g.a_kstep, kstepB = (size_t)(BK * 2);
    const size_t hstepB = (size_t)HALF * g.ldb * 2, tstepB = 2 * hstepB;
    const unsigned ldsw = (unsigned)wid * 1024u;
    const int aoff = lds_byte(wr * 64 + fr, fq * 8), boff = lds_byte(wc * 32 + fr, fq * 8);
#define PG8_SA(b, h) (((b) * 2 + (h)) * HTB)
#define PG8_SB(b, h) ((4 + (b) * 2 + (h)) * HTB)
#define PG8_STAGE_B(bufoff, gbase) do { _Pragma("unroll") for (int _i = 0; _i < 2; ++_i) \
        __builtin_amdgcn_global_load_lds((const unsigned*)((const char*)(gbase) + voffB[_i]), (PG8_LAS unsigned*)(lds + (bufoff) + ldsw + _i * 8192), 16, 0, 0); } while (0)
#define PG8_STAGE_A(bufoff, gbase, OFFS, h) do { _Pragma("unroll") for (int _i = 0; _i < 2; ++_i) \
        __builtin_amdgcn_global_load_lds((const unsigned*)((const char*)(gbase) + OFFS[h][_i]), (PG8_LAS unsigned*)(lds + (bufoff) + ldsw + _i * 8192), 16, 0, 0); } while (0)
#define PG8_LDA(dst, b, h) do { _Pragma("unroll") for (int m = 0; m < 4; ++m) _Pragma("unroll") for (int k = 0; k < 2; ++k) dst[m][k] = *(const PG8_LAS bf16x8*)(lds + PG8_SA(b, h) + aoff + m * 2048 + k * 1024); } while (0)
#define PG8_LDB(dst, b, h) do { _Pragma("unroll") for (int n = 0; n < 2; ++n) _Pragma("unroll") for (int k = 0; k < 2; ++k) dst[n][k] = *(const PG8_LAS bf16x8*)(lds + PG8_SB(b, h) + boff + n * 2048 + k * 1024); } while (0)
#define PG8_MMA(ai, bj, At, Bt) do { __builtin_amdgcn_s_setprio(1); _Pragma("unroll") for (int m = 0; m < 4; ++m) _Pragma("unroll") for (int n = 0; n < 2; ++n) _Pragma("unroll") for (int k = 0; k < 2; ++k) { \
        if constexpr (I8) acc[ai][bj][m][n] = __builtin_bit_cast(acc_t, __builtin_amdgcn_mfma_i32_16x16x64_i8(__builtin_bit_cast(i32x4, Bt[n][k]), __builtin_bit_cast(i32x4, At[m][k]), __builtin_bit_cast(i32x4, acc[ai][bj][m][n]), 0, 0, 0)); \
        else acc[ai][bj][m][n] = __builtin_bit_cast(acc_t, __builtin_amdgcn_mfma_f32_16x16x32_bf16(Bt[n][k], At[m][k], __builtin_bit_cast(f32x4, acc[ai][bj][m][n]), 0, 0, 0)); } __builtin_amdgcn_s_setprio(0); } while (0)
#define PG8_WAIT_V(n) asm volatile("s_waitcnt vmcnt(" #n ")" ::: "memory")
#define PG8_WAIT_L(n) asm volatile("s_waitcnt lgkmcnt(" #n ")" ::: "memory")
#define PG8_BAR __builtin_amdgcn_s_barrier()
#define PG8_SCHED __builtin_amdgcn_sched_barrier(0)
#define PG8_GIDX(dst, u) do { _Pragma("unroll") for (int _h = 0; _h < 2; ++_h) _Pragma("unroll") for (int _i = 0; _i < 2; ++_i) \
        dst[_h][_i] = (unsigned)g.gidx[(u).pm * BM + _h * HALF + RA[_i]] * g.g_row + CA2[_i]; } while (0)
    Unit cur, nxt; int ui = 0;
    if (!S.next(0, cur)) return;
    typedef typename AccT<I8>::type acc_t;
    acc_t acc[2][2][4][2];
#pragma unroll
    for (int a = 0; a < 2; ++a)
#pragma unroll
        for (int b = 0; b < 2; ++b)
#pragma unroll
            for (int m = 0; m < 4; ++m)
#pragma unroll
                for (int n = 0; n < 2; ++n) acc[a][b][m][n] = (acc_t){0, 0, 0, 0};
    bf16x8 At[4][2], B0[2][2], B1[2][2];
    if constexpr (GATHER) { PG8_GIDX(oc, cur); }
    const char* cA = GATHER ? g.A : g.A + (size_t)cur.pm * g.a_tstep; const char* cB = g.Bt + (size_t)cur.pn * tstepB;
    PG8_STAGE_B(PG8_SB(0, 0), cB); PG8_STAGE_B(PG8_SB(0, 1), cB + hstepB); PG8_STAGE_A(PG8_SA(0, 0), cA, oc, 0); PG8_STAGE_A(PG8_SA(0, 1), cA, oc, 1);
    if (wr == 1) PG8_BAR;
    PG8_WAIT_V(2); PG8_BAR;
    PG8_STAGE_B(PG8_SB(1, 0), cB + kstepB); PG8_STAGE_A(PG8_SA(1, 0), cA + kstepA, oc, 0); PG8_STAGE_B(PG8_SB(1, 1), cB + hstepB + kstepB);
    PG8_WAIT_V(6); PG8_BAR;
    for (;;) {
        const bool has_next = S.next(ui + 1, nxt);
        if constexpr (GATHER) { if (has_next) { PG8_GIDX(on, nxt); } else {
#pragma unroll
            for (int _h = 0; _h < 2; ++_h)
#pragma unroll
                for (int _i = 0; _i < 2; ++_i) on[_h][_i] = oc[_h][_i]; } }
        const char* nA = GATHER ? g.A : (has_next ? g.A + (size_t)nxt.pm * g.a_tstep : cA); const char* nB = has_next ? g.Bt + (size_t)nxt.pn * tstepB : cB;
#pragma unroll 1
        for (int t = 0; t < nt; t += 2) {
            const bool last = (t == nt - 2);
            const char* a1 = cA + (size_t)(t + 1) * kstepA;
            const char* a2 = last ? nA : cA + (size_t)(t + 2) * kstepA; const char* b2 = last ? nB : cB + (size_t)(t + 2) * kstepB;
            const char* a3 = a2 + kstepA; const char* b3 = b2 + kstepB;
            unsigned o2[2][2];
#pragma unroll
            for (int _h = 0; _h < 2; ++_h)
#pragma unroll
                for (int _i = 0; _i < 2; ++_i) o2[_h][_i] = (GATHER && last) ? on[_h][_i] : oc[_h][_i];
            PG8_LDB(B0, 0, 0); PG8_LDB(B1, 0, 1); PG8_SCHED; PG8_LDA(At, 0, 0); PG8_STAGE_A(PG8_SA(1, 1), a1, oc, 1);
            PG8_WAIT_V(8); PG8_WAIT_L(0); PG8_BAR; PG8_MMA(0, 0, At, B0); PG8_MMA(0, 1, At, B1); PG8_BAR; PG8_SCHED;
            PG8_LDA(At, 0, 1); PG8_STAGE_B(PG8_SB(0, 0), b2); PG8_STAGE_B(PG8_SB(0, 1), b2 + hstepB); PG8_STAGE_A(PG8_SA(0, 0), a2, o2, 0);
            PG8_WAIT_V(8); PG8_WAIT_L(0); PG8_BAR; PG8_MMA(1, 0, At, B0); PG8_MMA(1, 1, At, B1); PG8_BAR; PG8_SCHED;
            PG8_LDB(B0, 1, 0); PG8_LDB(B1, 1, 1); PG8_SCHED; PG8_LDA(At, 1, 0); PG8_STAGE_A(PG8_SA(0, 1), a2, o2, 1);
            PG8_WAIT_V(8); PG8_WAIT_L(0); PG8_BAR; PG8_MMA(0, 0, At, B0); PG8_MMA(0, 1, At, B1); PG8_BAR; PG8_SCHED;
            PG8_LDA(At, 1, 1); PG8_STAGE_B(PG8_SB(1, 0), b3); PG8_STAGE_B(PG8_SB(1, 1), b3 + hstepB); PG8_STAGE_A(PG8_SA(1, 0), a3, o2, 0);
            PG8_WAIT_V(8); PG8_WAIT_L(0); PG8_BAR; PG8_MMA(1, 0, At, B0); PG8_MMA(1, 1, At, B1); PG8_BAR; PG8_SCHED;
        }
        if constexpr (ALIGN_EPI) { if (wr == 0) PG8_BAR; }
        E(acc, cur, wr, wc, fr, fq);
        if (!has_next) break;
#pragma unroll
        for (int a = 0; a < 2; ++a)
#pragma unroll
            for (int b = 0; b < 2; ++b)
#pragma unroll
                for (int m = 0; m < 4; ++m)
#pragma unroll
                    for (int n = 0; n < 2; ++n) acc[a][b][m][n] = (acc_t){0, 0, 0, 0};
        cur = nxt; cA = nA; cB = nB; ++ui;
#pragma unroll
        for (int _h = 0; _h < 2; ++_h)
#pragma unroll
            for (int _i = 0; _i < 2; ++_i) oc[_h][_i] = on[_h][_i];
        if constexpr (ALIGN_EPI) { if (wr == 1) PG8_BAR; }
    }
    PG8_WAIT_V(0);
    if constexpr (!ALIGN_EPI) { if (wr == 0) PG8_BAR; }
    PG8_BAR;
#undef PG8_SA
#undef PG8_SB
#undef PG8_STAGE_A
#undef PG8_STAGE_B
#undef PG8_LDA
#undef PG8_LDB
#undef PG8_MMA
#undef PG8_WAIT_V
#undef PG8_WAIT_L
#undef PG8_BAR
#undef PG8_SCHED
#undef PG8_GIDX
}

#define EPI_ROWS(ai, m) (u.pm * BM + (ai) * HALF + wr * 64 + (m) * 16 + fr)
struct EpiProj {
    bf16_t* UH; bf16_t* KB; bf16_t* VB; bf16_t* QB; unsigned char* GT; const float* qg; const float* kg; const float* rope; const float* sa; const float* sb;
    __device__ __forceinline__ void operator()(const i32x4 (&acci)[2][2][4][2], const Unit& u, int wr, int wc, int fr, int fq) const {
        asm volatile("" : "+v"(fr), "+v"(fq));
        const int pn = u.pn;
        const float* sbp = sb + pn * BM + wc * 32 + 8 * fq;
#define ACCF(ai, bj, m, n) (__builtin_convertvector(acci[ai][bj][m][n], f32x4) * (*(const f32x4*)(sbp + (bj) * HALF + 4 * (n)) * sa_r))
        if (pn < 2) {
#pragma unroll
            for (int ai = 0; ai < 2; ++ai)
#pragma unroll
                for (int m = 0; m < 4; ++m) { const int row = EPI_ROWS(ai, m); const float sa_r = sa[row];
#pragma unroll
                    for (int bj = 0; bj < 2; ++bj) { const int c0 = pn * 256 + bj * 128 + wc * 32 + 8 * fq;
                        *(u32x4*)(UH + ((size_t)(c0 >> 4) * NCHUNK_PAD + (row >> 4)) * 512 + (row & 15) * 16 + (c0 & 15)) = pack8(ACCF(ai, bj, m, 0), ACCF(ai, bj, m, 1)); } }
        } else if (pn < 5) {
            const bool isq = pn >= 3, isv = (pn == 2) && (wc >= 2), lat = u.pm < (T / BM);
            const float* gn = isq ? qg : kg;
            const float osc = isq ? C2 : 1.f;
#pragma unroll
            for (int ai = 0; ai < 2; ++ai)
#pragma unroll
                for (int m = 0; m < 4; ++m) { const int row = EPI_ROWS(ai, m); const float sa_r = sa[row];
                    int b, spos; if (lat) { b = row >> 13; spos = LC + (row & (SEQ - 1)); } else { const int rr = row - T; b = rr >> 8; spos = rr & (LC - 1); }
                    if (isv) {
                        bf16_t* o = VB + ((size_t)(b * 2 + (wc - 2)) * SKV + spos) * 64 + 8 * fq;
#pragma unroll
                        for (int bj = 0; bj < 2; ++bj) *(u32x4*)(o + 32 * bj) = pack8(ACCF(ai, bj, m, 0), ACCF(ai, bj, m, 1));
                    } else {
                        float ss = 0.f;
#pragma unroll
                        for (int bj = 0; bj < 2; ++bj)
#pragma unroll
                            for (int n = 0; n < 2; ++n) { const f32x4 x = ACCF(ai, bj, m, n); ss += (x[0] * x[0] + x[1] * x[1]) + (x[2] * x[2] + x[3] * x[3]); }
                        ss += __shfl_xor(ss, 16); ss += __shfl_xor(ss, 32);
                        const float rs = osc / sqrtf(ss * (1.f / 64.f) + EPS);
                        bf16_t* o = isq ? QB + (size_t)row * 512 + (4 * (pn - 3) + wc) * 64 + 8 * fq : KB + ((size_t)(b * 2 + wc) * SKV + spos) * 64 + 8 * fq;
                        const int t = row & (SEQ - 1), rid = t >> 6, cid = t & 63;
#pragma unroll
                        for (int bj = 0; bj < 2; ++bj) {
                            const f32x4 gv0 = *(const f32x4*)(gn + 32 * bj + 8 * fq), gv1 = *(const f32x4*)(gn + 32 * bj + 8 * fq + 4);
                            f32x4 y0 = ACCF(ai, bj, m, 0) * gv0 * rs, y1 = ACCF(ai, bj, m, 1) * gv1 * rs;
                            if (lat) { const float* rp = rope + (bj == 0 ? rid * 16 : 4096 + cid * 16) + 4 * fq; const f32x4 cs = *(const f32x4*)rp, sn = *(const f32x4*)(rp + (bj == 0 ? 2048 : 1024));
                                const f32x4 z0 = (f32x4){y0[0] * cs[0] - y0[1] * sn[0], y0[0] * sn[0] + y0[1] * cs[0], y0[2] * cs[1] - y0[3] * sn[1], y0[2] * sn[1] + y0[3] * cs[1]};
                                const f32x4 z1 = (f32x4){y1[0] * cs[2] - y1[1] * sn[2], y1[0] * sn[2] + y1[1] * cs[2], y1[2] * cs[3] - y1[3] * sn[3], y1[2] * sn[3] + y1[3] * cs[3]};
                                y0 = z0; y1 = z1; }
                            *(u32x4*)(o + 32 * bj) = pack8(y0, y1); }
                    } }
        } else {
#pragma unroll
            for (int ai = 0; ai < 2; ++ai)
#pragma unroll
                for (int m = 0; m < 4; ++m) { const int row = EPI_ROWS(ai, m); const float sa_r = sa[row];
#pragma unroll
                    for (int bj = 0; bj < 2; ++bj)
                        { const f32x4 s0 = fsig4(ACCF(ai, bj, m, 0)) * 255.f, s1 = fsig4(ACCF(ai, bj, m, 1)) * 255.f;
                          u32x2 w; w.x = (unsigned)__float2int_rn(s0[0]) | ((unsigned)__float2int_rn(s0[1]) << 8) | ((unsigned)__float2int_rn(s0[2]) << 16) | ((unsigned)__float2int_rn(s0[3]) << 24);
                          w.y = (unsigned)__float2int_rn(s1[0]) | ((unsigned)__float2int_rn(s1[1]) << 8) | ((unsigned)__float2int_rn(s1[2]) << 16) | ((unsigned)__float2int_rn(s1[3]) << 24);
                          *(u32x2*)(GT + (size_t)row * 2048 + (pn - 5) * 256 + bj * 128 + wc * 32 + 8 * fq) = w; } }
        }
    }
#undef ACCF
};
struct EpiGlu {
    const bf16_t* SG; const float* bias; bf16_t* GO;
    __device__ __forceinline__ void operator()(const f32x4 (&acc)[2][2][4][2], const Unit& u, int wr, int wc, int fr, int fq) const {
#pragma unroll
        for (int bj = 0; bj < 2; ++bj) { const int c0 = u.pn * BM + bj * HALF + wc * 32 + 8 * fq;
            const f32x4 b0 = *(const f32x4*)(bias + c0), b1 = *(const f32x4*)(bias + c0 + 4);
#pragma unroll
            for (int ai = 0; ai < 2; ++ai)
#pragma unroll
                for (int m = 0; m < 4; ++m) { const int row = EPI_ROWS(ai, m);
                    const u32x4 sw = *(const u32x4*)(SG + ((size_t)(c0 >> 4) * T + row) * 16 + (c0 & 15));
                    const f32x4 s0 = unpack_lo(sw), s1 = unpack_hi(sw);
                    *(u32x4*)(GO + (size_t)row * 1024 + c0) = pack8(s0 * fsig4(acc[ai][bj][m][0] + b0), s1 * fsig4(acc[ai][bj][m][1] + b1)); } }
    }
};
template <int MODE> struct EpiMerge {
    const unsigned char* GT; bf16_t* M1; bf16_t* MG;
    __device__ __forceinline__ void operator()(const f32x4 (&acc)[2][2][4][2], const Unit& u, int wr, int wc, int fr, int fq) const {
#pragma unroll
        for (int ai = 0; ai < 2; ++ai)
#pragma unroll
            for (int m = 0; m < 4; ++m) { const int row = EPI_ROWS(ai, m);
#pragma unroll
                for (int bj = 0; bj < 2; ++bj) { const int c0 = u.pn * BM + bj * HALF + wc * 32 + 8 * fq;
                    const u32x2 gw = *(const u32x2*)(GT + (size_t)row * 2048 + MODE * 1024 + c0);
                    const f32x4 g0 = (f32x4){(float)(gw.x & 255u), (float)((gw.x >> 8) & 255u), (float)((gw.x >> 16) & 255u), (float)(gw.x >> 24)} * (1.f / 255.f);
                    const f32x4 g1 = (f32x4){(float)(gw.y & 255u), (float)((gw.y >> 8) & 255u), (float)((gw.y >> 16) & 255u), (float)(gw.y >> 24)} * (1.f / 255.f);
                    const f32x4 v0 = g0 * acc[ai][bj][m][0], v1 = g1 * acc[ai][bj][m][1];
                    bf16_t* mp = M1 + (size_t)row * 1024 + c0;
                    if (MODE == 0) { *(u32x4*)mp = pack8(v0, v1); }
                    else { const u32x4 aw = *(const u32x4*)mp; *(u32x4*)(MG + (size_t)row * 1024 + c0) = pack8(unpack_lo(aw) + v0, unpack_hi(aw) + v1); } } }
    }
};
struct EpiOut {
    const float* x; const float* mod; bf16_t* XM;
    __device__ __forceinline__ void operator()(const f32x4 (&acc)[2][2][4][2], const Unit& u, int wr, int wc, int fr, int fq) const {
        const int b = (u.pm * BM) / SEQ;
#pragma unroll
        for (int bj = 0; bj < 2; ++bj) { const int c0 = u.pn * BM + bj * HALF + wc * 32 + 8 * fq;
            const f32x4 g0 = *(const f32x4*)(mod + b * NMOD + 2048 + c0), g1 = *(const f32x4*)(mod + b * NMOD + 2048 + c0 + 4);
#pragma unroll
            for (int ai = 0; ai < 2; ++ai)
#pragma unroll
                for (int m = 0; m < 4; ++m) { const size_t off = (size_t)EPI_ROWS(ai, m) * 1024 + c0;
                    const f32x4 x0 = *(const f32x4*)(x + off), x1 = *(const f32x4*)(x + off + 4);
                    *(u32x4*)(XM + off) = pack8(x0 + g0 * acc[ai][bj][m][0], x1 + g1 * acc[ai][bj][m][1]); } }
    }
};
struct EpiGU {
    const float* bgu; bf16_t* ACT;
    __device__ __forceinline__ void operator()(const f32x4 (&acc)[2][2][4][2], const Unit& u, int wr, int wc, int fr, int fq) const {
        const int e = u.pn >> 3, jc = (u.pn & 7) * 128 + wc * 32 + 8 * fq; const float* bp = bgu + e * 2048 + jc;
        const f32x4 bg0 = *(const f32x4*)bp, bg1 = *(const f32x4*)(bp + 4), bu0 = *(const f32x4*)(bp + 1024), bu1 = *(const f32x4*)(bp + 1028);
#pragma unroll
        for (int ai = 0; ai < 2; ++ai)
#pragma unroll
            for (int m = 0; m < 4; ++m) { const int row = EPI_ROWS(ai, m); f32x4 o[2];
#pragma unroll
                for (int n = 0; n < 2; ++n) { const f32x4 gt = acc[ai][0][m][n] + (n ? bg1 : bg0), up = acc[ai][1][m][n] + (n ? bu1 : bu0);
#pragma unroll
                    for (int j = 0; j < 4; ++j) { const float gq = fminf(gt[j], 7.f), uq = fminf(fmaxf(up[j], -7.f), 7.f); o[n][j] = (uq + 1.f) * (gq * fsig(1.702f * gq)); } }
                *(u32x4*)(ACT + (size_t)row * 1024 + jc) = pack8(o[0], o[1]); }
    }
};
struct EpiGU8 {
    const float* bgu; const float* sa; const float* sb; bf16_t* ACT;
    __device__ __forceinline__ void operator()(const i32x4 (&acc)[2][2][4][2], const Unit& u, int wr, int wc, int fr, int fq) const {
        const int e = u.pn >> 3, jl = wc * 32 + 8 * fq, jc = (u.pn & 7) * 128 + jl; const float* bp = bgu + e * 2048 + jc; const float* sp = sb + e * 2048 + (u.pn & 7) * 256 + jl;
        const f32x4 bg0 = *(const f32x4*)bp, bg1 = *(const f32x4*)(bp + 4), bu0 = *(const f32x4*)(bp + 1024), bu1 = *(const f32x4*)(bp + 1028);
        const f32x4 sg0 = *(const f32x4*)sp, sg1 = *(const f32x4*)(sp + 4), su0 = *(const f32x4*)(sp + 128), su1 = *(const f32x4*)(sp + 132);
        float sr[2][4];
#pragma unroll
        for (int ai = 0; ai < 2; ++ai)
#pragma unroll
            for (int m = 0; m < 4; ++m) sr[ai][m] = sa[EPI_ROWS(ai, m)];
#pragma unroll
        for (int ai = 0; ai < 2; ++ai)
#pragma unroll
            for (int m = 0; m < 4; ++m) { const int row = EPI_ROWS(ai, m); f32x4 o[2];
#pragma unroll
                for (int n = 0; n < 2; ++n) { const f32x4 sg = (n ? sg1 : sg0) * sr[ai][m], su = (n ? su1 : su0) * sr[ai][m];
#pragma unroll
                    for (int j = 0; j < 4; ++j) { const float gt = (float)acc[ai][0][m][n][j] * sg[j] + (n ? bg1 : bg0)[j], up = (float)acc[ai][1][m][n][j] * su[j] + (n ? bu1 : bu0)[j];
                        const float gq = fminf(gt, 7.f), uq = fminf(fmaxf(up, -7.f), 7.f); o[n][j] = (uq + 1.f) * (gq * fsig(1.702f * gq)); } }
                *(u32x4*)(ACT + (size_t)row * 1024 + jc) = pack8(o[0], o[1]); }
    }
};
struct EpiDown {
    const float* bd; const float* sgate; bf16_t* YB;
    __device__ __forceinline__ void operator()(const f32x4 (&acc)[2][2][4][2], const Unit& u, int wr, int wc, int fr, int fq) const {
        const int e = u.pn >> 2;
#pragma unroll
        for (int ai = 0; ai < 2; ++ai)
#pragma unroll
            for (int m = 0; m < 4; ++m) { const int row = EPI_ROWS(ai, m); const float gt = sgate[row];
#pragma unroll
                for (int bj = 0; bj < 2; ++bj) { const int c0 = (u.pn & 3) * BM + bj * HALF + wc * 32 + 8 * fq; const float* bp = bd + e * 1024 + c0;
                    const f32x4 b0 = *(const f32x4*)bp, b1 = *(const f32x4*)(bp + 4);
                    *(u32x4*)(YB + (size_t)row * 1024 + c0) = pack8((acc[ai][bj][m][0] + b0) * gt, (acc[ai][bj][m][1] + b1) * gt); } }
    }
};
struct EpiSloc {
    bf16_t* SL;
    __device__ __forceinline__ void operator()(const f32x4 (&acc)[2][2][4][2], const Unit& u, int wr, int wc, int fr, int fq) const {
#pragma unroll
        for (int ai = 0; ai < 2; ++ai)
#pragma unroll
            for (int m = 0; m < 4; ++m) { const int row = EPI_ROWS(ai, m);
#pragma unroll
                for (int bj = 0; bj < 2; ++bj) *(u32x4*)(SL + (size_t)row * 256 + bj * HALF + wc * 32 + 8 * fq) = pack8(acc[ai][bj][m][0], acc[ai][bj][m][1]); }
    }
};
struct EpiS5Y {
    bf16_t* SG;
    __device__ __forceinline__ f32x4 gelu4(const f32x4 x) const { f32x4 r;
#pragma unroll
        for (int j = 0; j < 4; ++j) { const float v = x[j], u2 = 1.5957691216057308f * (v + 0.044715f * v * v * v); r[j] = v * fsig(u2); } return r; }
    __device__ __forceinline__ void operator()(const f32x4 (&acc)[2][2][4][2], const Unit& u, int wr, int wc, int fr, int fq) const {
        const int grp = u.pn, mt = u.pm - 9 * grp;
#pragma unroll
        for (int ai = 0; ai < 2; ++ai)
#pragma unroll
            for (int m = 0; m < 4; ++m) { const int chunk = mt * BM + ai * HALF + wr * 64 + m * 16 + fr;
#pragma unroll
                for (int bj = 0; bj < 2; ++bj) { const int col = bj * HALF + wc * 32 + 8 * fq; const int tok = chunk * 16 + (col >> 4);
                    *(u32x4*)(SG + ((size_t)grp * T + tok) * 16 + (col & 15)) = pack8(gelu4(acc[ai][bj][m][0]), gelu4(acc[ai][bj][m][1])); } }
    }
};
#undef EPI_ROWS
struct SchedProj {
    StaticOrder so; int G, c;
    __device__ void init(int G_, int c_) { so.init(T, DIN, G_, c_); G = G_; c = c_; }
    __device__ bool next(int i, Unit& u) const { const int L = i * G + c; if (L < so.nwg) return so.next(i, u); const int r = L - so.nwg; if (r >= 12) return false; u.pm = T / BM + r / 3; u.pn = r % 3; return true; }
};
struct SchedS5 {
    int mper, G, c;
    __device__ bool next(int i, Unit& u) const { const int L = i * G + c; if (L >= 32 * mper) return false; const int grp = L / mper; u.pm = 9 * grp + (L % mper); u.pn = grp; return true; }
};
struct SchedMoE {
    const PG8_LAS int* tile_e; int ntiles, nN, G, c, rev;
    __device__ bool next(int i, Unit& u) const {
        int tile, pn;
        if (nN == 4 && G == 256) {
            const int x = c & 7; pn = x & 3; tile = 64 * i + 32 * (x >> 2) + (c >> 3); if (tile >= ntiles) return false; }
        else { const int L = i * G + c; if (L >= ntiles * nN) return false; tile = L / nN; pn = L % nN; }
        u.pm = rev ? ntiles - 1 - tile : tile; u.pn = tile_e[u.pm] * nN + pn; return true; }
};
}

#include <hip/hip_bf16.h>
#include <cmath>

namespace attn_body {
using bf16=__hip_bfloat16;
using bf16x8=__attribute__((ext_vector_type(8)))short;
using s16x4=__attribute__((ext_vector_type(4)))short;
using f32x16=__attribute__((ext_vector_type(16)))float;
using u32x4=__attribute__((ext_vector_type(4)))unsigned;
constexpr int D=64,QP=512,KP=64,OP=1024,ASEQ=8192,ASKV=8448;
constexpr int NW=8,QBLK=32,QB=QBLK*NW,KVBLK=64,NQB=ASEQ/QB;
constexpr int ATTN_UNIT_ROWS=QB;
__device__ __forceinline__ int crow(int r,int hi){return (r&3)+8*(r>>2)+4*hi;}
#define SBAR() __builtin_amdgcn_sched_barrier(0)
__device__ __forceinline__ void cmask(f32x16&p0,f32x16&p1,int jb,int qrel,int hi){
  const float NEG=-INFINITY; int kb=64*jb+4*hi;
  #pragma unroll
  for(int r=0;r<16;++r){int kv=kb+(r&3)+8*(r>>2); if(kv>qrel)p0[r]=NEG; if(kv+32>qrel)p1[r]=NEG;}
}

constexpr int NSLOT=3, SLOTB=8192;
constexpr int LDS_K=0, LDS_V=NSLOT*SLOTB, LDS_WS=2*NSLOT*SLOTB, LDS_OST=LDS_WS+NW*64*4, LDS_BYTES=LDS_OST+NW*4096;
constexpr float C2=0.125f*1.4426950408889634f;
__device__ __forceinline__ void glds16(const void*gsrc,unsigned lds_dst){unsigned keep;
  asm volatile("s_mov_b32 %0, m0\n\ts_mov_b32 m0, %2\n\ts_nop 0\n\tglobal_load_lds_dwordx4 %1, off\n\ts_mov_b32 m0, %0":"=&s"(keep):"v"(gsrc),"s"(lds_dst):"memory");}
__device__ __forceinline__ float max3f(float a,float b,float c){float r;asm("v_max3_f32 %0, %1, %2, %3":"=v"(r):"v"(a),"v"(b),"v"(c));return r;}
__device__ __forceinline__ float max2f(float a,float b){float r;asm("v_max_f32_e32 %0, %1, %2":"=v"(r):"v"(a),"v"(b));return r;}
__device__ __forceinline__ float fadd_s(float a,float b){float r;asm("v_add_f32_e32 %0, %1, %2":"=v"(r):"v"(a),"v"(b));return r;}
__device__ __forceinline__ float fsub_s(float a,float b){float r;asm("v_sub_f32_e32 %0, %1, %2":"=v"(r):"v"(a),"v"(b));return r;}
typedef float f32x2_t __attribute__((ext_vector_type(2))); typedef __bf16 bf16x2_t __attribute__((ext_vector_type(2)));
__device__ __forceinline__ unsigned cvtpk_s(float lo,float hi){f32x2_t v={lo,hi};bf16x2_t b=__builtin_convertvector(v,bf16x2_t);return __builtin_bit_cast(unsigned,b);}
#define WAIT_BAR(N) asm volatile("s_waitcnt vmcnt(" #N ") lgkmcnt(0)\n\ts_barrier":::"memory")

__device__ __forceinline__ void qkt(f32x16&p0,f32x16&p1,const char*Kslot,const bf16x8*qr,const f32x16&negm,int r32,int hi){
  const char*kb=Kslot+hi*1024+r32*16;
  #pragma unroll
  for(int d0=0;d0<4;++d0){
    const bf16x8 b0=*reinterpret_cast<const bf16x8*>(kb+d0*2048);
    const bf16x8 b1=*reinterpret_cast<const bf16x8*>(kb+d0*2048+512);
    if(d0==0){p0=__builtin_amdgcn_mfma_f32_32x32x16_bf16(b0,qr[0],negm,0,0,0);p1=__builtin_amdgcn_mfma_f32_32x32x16_bf16(b1,qr[0],negm,0,0,0);}
    else{p0=__builtin_amdgcn_mfma_f32_32x32x16_bf16(b0,qr[d0],p0,0,0,0);p1=__builtin_amdgcn_mfma_f32_32x32x16_bf16(b1,qr[d0],p1,0,0,0);}}
}
typedef __attribute__((address_space(3))) const char* lds_cptr;
typedef short v4i16_t __attribute__((ext_vector_type(4)));
__device__ __forceinline__ void kload8(bf16x8*kf,lds_cptr kp){
  kf[0]=*(const __attribute__((address_space(3))) bf16x8*)(kp);      kf[1]=*(const __attribute__((address_space(3))) bf16x8*)(kp+512);
  kf[2]=*(const __attribute__((address_space(3))) bf16x8*)(kp+2048); kf[3]=*(const __attribute__((address_space(3))) bf16x8*)(kp+2560);
  kf[4]=*(const __attribute__((address_space(3))) bf16x8*)(kp+4096); kf[5]=*(const __attribute__((address_space(3))) bf16x8*)(kp+4608);
  kf[6]=*(const __attribute__((address_space(3))) bf16x8*)(kp+6144); kf[7]=*(const __attribute__((address_space(3))) bf16x8*)(kp+6656);
}
__device__ __forceinline__ void kload2(bf16x8*kf,lds_cptr kp,int j){ kf[2*j]=*(const __attribute__((address_space(3))) bf16x8*)(kp+j*2048); kf[2*j+1]=*(const __attribute__((address_space(3))) bf16x8*)(kp+j*2048+512); }
__device__ __forceinline__ s16x4 vtr(lds_cptr p){ return __builtin_bit_cast(s16x4,__builtin_amdgcn_ds_read_tr16_b64_v4i16((__attribute__((address_space(3))) v4i16_t*)p)); }
__device__ __forceinline__ float rowmax(const f32x16&p0,const f32x16&p1){
  float a=max3f(p0[0],p0[1],p1[0]),b=max3f(p0[2],p0[3],p1[1]);a=max3f(a,p1[2],p1[3]);
  #pragma unroll
  for(int r=4;r<16;r+=4){a=max3f(a,p0[r],p0[r+1]);b=max3f(b,p0[r+2],p0[r+3]);a=max3f(a,p1[r],p1[r+1]);b=max3f(b,p1[r+2],p1[r+3]);}
  const float m=max2f(a,b);
  auto rr=__builtin_amdgcn_permlane32_swap(__float_as_uint(m),__float_as_uint(m),false,false);
  return max2f(__uint_as_float(rr[0]),__uint_as_float(rr[1]));
}
__device__ __forceinline__ void pv(f32x16*o,int vb,bf16x8 pa0,bf16x8 pa1,bf16x8 pa2,bf16x8 pa3){
  #pragma unroll
  for(int d0=0;d0<2;++d0){s16x4 lo[4],hi[4];
    #pragma unroll
    for(int ks=0;ks<4;++ks){
      asm volatile("ds_read_b64_tr_b16 %0,%1 offset:%c2":"=&v"(lo[ks]):"v"(vb),"i"(d0*4096+ks*1024):"memory");
      asm volatile("ds_read_b64_tr_b16 %0,%1 offset:%c2":"=&v"(hi[ks]):"v"(vb),"i"(d0*4096+ks*1024+512):"memory");}
    asm volatile("s_waitcnt lgkmcnt(0)":::"memory");SBAR();
    #define PK(k) (bf16x8){lo[k][0],lo[k][1],lo[k][2],lo[k][3],hi[k][0],hi[k][1],hi[k][2],hi[k][3]}
    o[d0]=__builtin_amdgcn_mfma_f32_32x32x16_bf16(pa0,PK(0),o[d0],0,0,0);
    o[d0]=__builtin_amdgcn_mfma_f32_32x32x16_bf16(pa1,PK(1),o[d0],0,0,0);
    o[d0]=__builtin_amdgcn_mfma_f32_32x32x16_bf16(pa2,PK(2),o[d0],0,0,0);
    o[d0]=__builtin_amdgcn_mfma_f32_32x32x16_bf16(pa3,PK(3),o[d0],0,0,0);
    #undef PK
  }
}

#ifndef ATTN_STORE16
#define ATTN_STORE16(p,v) (*(u32x4*)(p)=(v))
#endif
template<int THRL> __device__ __forceinline__ void attn_unit(int b,int h,int qb,const bf16*Q,const bf16*__restrict__ K,const bf16*__restrict__ V,bf16*O,char*shm,float mref){
  const int tid=threadIdx.x,lane=tid&63,r32=lane&31,hi=lane>>5; const int wid=__builtin_amdgcn_readfirstlane(tid>>6);
  const long rowbase=(long)b*ASEQ; const int q0=qb*QB;
  const bf16*Qw=Q+(rowbase+q0+wid*QBLK)*QP+h*D;
  const bf16*Kh=K+(long)(b*2+(h>>2))*ASKV*KP,*Vh=V+(long)(b*2+(h>>2))*ASKV*KP;
  const unsigned lds0=(unsigned)(uintptr_t)shm;
  float*wsf=(float*)(shm+LDS_WS)+wid*64;
  const bf16*ksrc=Kh+(long)lane*KP+wid*8;
  const bf16*vsrc=Vh+(long)(16*(wid&3)+(lane>>2))*KP+(wid>>2)*32+(lane&3)*8;
  const unsigned kdst=lds0+LDS_K+wid*1024, vdst=lds0+LDS_V+wid*1024;
  #define DMA_K(t,slot) glds16(ksrc+(long)(t)*KVBLK*KP,(unsigned)__builtin_amdgcn_readfirstlane(kdst+(slot)))
  #define DMA_V(t,slot) glds16(vsrc+(long)(t)*KVBLK*KP,(unsigned)__builtin_amdgcn_readfirstlane(vdst+(slot)))
  const int vb0=(int)(lds0+LDS_V)+((lane>>4)&1)*32+(lane&3)*8+(4*hi+((lane&15)>>2))*64;
  const char*Kbase=shm+LDS_K; bf16x8 kf[8];
  const lds_cptr shm3=(lds_cptr)shm; const lds_cptr kp0=shm3+LDS_K+hi*1024+r32*16; const lds_cptr vp0=shm3+LDS_V+((lane>>4)&1)*32+(lane&3)*8+(4*hi+((lane&15)>>2))*64;
  const int NT=ASKV/KVBLK;
  DMA_K(0,0);DMA_V(0,0);DMA_K(1,SLOTB);
  bf16x8 qr[4];
  #pragma unroll
  for(int d0=0;d0<4;++d0)qr[d0]=*reinterpret_cast<const bf16x8*>(&Qw[(long)r32*QP+d0*16+hi*8]);
  float l_reg=0.f;f32x16 o[2];o[0]=f32x16{};o[1]=f32x16{};f32x16 negm;
  _Pragma("unroll") for(int r=0;r<16;++r)negm[r]=-mref; asm volatile("":"+v"(negm));
  const int qrel=wid*QBLK+r32;
  #define CMASK(P0,P1,t) do{}while(0)
  #define START(P0,P1) do{ _Pragma("unroll") for(int r=0;r<16;++r)P0[r]=__builtin_amdgcn_exp2f(P0[r]); }while(0)
  #define RESC() do{}while(0)
  f32x16 pA0,pA1,pB0,pB1;
  int sl_prev=0,sl_cur=0,sl_next=SLOTB;
  #define ROT() do{sl_prev=sl_cur;sl_cur=sl_next;sl_next=(sl_next==(NSLOT-1)*SLOTB)?0:sl_next+SLOTB;}while(0)
  DMA_K(2,2*SLOTB);
  WAIT_BAR(3);
  qkt(pA0,pA1,Kbase,qr,negm,r32,hi);asm volatile("s_nop 15\n\ts_nop 7":"+v"(pA0),"+v"(pA1));CMASK(pA0,pA1,0);
  START(pA0,pA1);
  _Pragma("unroll") for(int r=0;r<16;++r)pA1[r]=__builtin_amdgcn_exp2f(pA1[r]);
  WAIT_BAR(0);
  DMA_K(3,0);DMA_V(1,SLOTB);
  ROT();
  kload8(kf,kp0+sl_cur);
  WAIT_BAR(2);
  s16x4 vlo[8],vhi[8]; u32x4 pw0,pw1,pw2,pw3;
  #define PKW(P,B) cvtpk_s(P[B],P[B+1])
  #define PAF(k) __builtin_bit_cast(bf16x8,pw##k)
  #define VFR(i) (bf16x8){vlo[i][0],vlo[i][1],vlo[i][2],vlo[i][3],vhi[i][0],vhi[i][1],vhi[i][2],vhi[i][3]}
  #define PIN(x) asm volatile("":"+v"(x))
  #define MX3(a,b,c) __builtin_fmaxf(__builtin_fmaxf((a),(b)),(c))
  #define GAPA(MF,A0,A1,A2,A3,W0,W1,PW) do{ MF; sacc+=A0; sacc+=A1; sacc+=A2; sacc+=A3; PIN(sacc); W0; W1; PIN(PW); SBAR(); }while(0)
  #define EX(v) __builtin_amdgcn_exp2f(v)
  #define GAPB(MF,X,B) do{ MF; X[B]=EX(X[B]); X[B+1]=EX(X[B+1]); X[B+2]=EX(X[B+2]); X[B+3]=EX(X[B+3]); PIN(X); SBAR(); }while(0)
  #define VRD(i) do{ vlo[i]=vtr(vp_+(((i)>>2)*4096+((i)&3)*1024)); vhi[i]=vtr(vp_+(((i)>>2)*4096+((i)&3)*1024+512)); }while(0)
  #define KRD(G,j) do{ if(G){ kload2(kf,kp0+sl_next,j); SBAR(); } }while(0)
  #define STEP(C0,C1,P0,P1,t,GK,GV,GL) do{ SBAR(); \
    const lds_cptr vp_=vp0+sl_prev; \
    VRD(0); SBAR(); float sacc=(P0[0]+P0[1]); \
    GAPA(C0=__builtin_amdgcn_mfma_f32_32x32x16_bf16(kf[0],qr[0],negm,0,0,0), P0[2],P0[3],P0[4],P0[5],     pw0[0]=PKW(P0,0), pw0[1]=PKW(P0,2), pw0); \
    VRD(4); SBAR(); GAPA(C1=__builtin_amdgcn_mfma_f32_32x32x16_bf16(kf[1],qr[0],negm,0,0,0), P0[6],P0[7],P0[8],P0[9],     pw0[2]=PKW(P0,4), pw0[3]=PKW(P0,6), pw0); \
    VRD(1); SBAR(); GAPA(C0=__builtin_amdgcn_mfma_f32_32x32x16_bf16(kf[2],qr[1],C0,0,0,0),   P0[10],P0[11],P0[12],P0[13], pw1[0]=PKW(P0,8), pw1[1]=PKW(P0,10), pw1); \
    VRD(5); SBAR(); GAPA(C1=__builtin_amdgcn_mfma_f32_32x32x16_bf16(kf[3],qr[1],C1,0,0,0),   P0[14],P0[15],P1[0],P1[1],   pw1[2]=PKW(P0,12),pw1[3]=PKW(P0,14), pw1); \
    VRD(2); SBAR(); GAPA(C0=__builtin_amdgcn_mfma_f32_32x32x16_bf16(kf[4],qr[2],C0,0,0,0),   P1[2],P1[3],P1[4],P1[5],     pw2[0]=PKW(P1,0), pw2[1]=PKW(P1,2), pw2); \
    VRD(6); SBAR(); GAPA(C1=__builtin_amdgcn_mfma_f32_32x32x16_bf16(kf[5],qr[2],C1,0,0,0),   P1[6],P1[7],P1[8],P1[9],     pw2[2]=PKW(P1,4), pw2[3]=PKW(P1,6), pw2); \
    VRD(3); SBAR(); GAPA(C0=__builtin_amdgcn_mfma_f32_32x32x16_bf16(kf[6],qr[3],C0,0,0,0),   P1[10],P1[11],P1[12],P1[13], pw3[0]=PKW(P1,8), pw3[1]=PKW(P1,10), pw3); \
    VRD(7); SBAR(); GAPA(C1=__builtin_amdgcn_mfma_f32_32x32x16_bf16(kf[7],qr[3],C1,0,0,0),   P1[14],P1[15],0.f,0.f,       pw3[2]=PKW(P1,12),pw3[3]=PKW(P1,14), pw3); \
    l_reg+=sacc; \
    if(GK){DMA_K((t)+3,sl_cur);} if(GV){DMA_V((t)+1,sl_next);} \
    CMASK(C0,C1,t); \
    SBAR(); \
    GAPB(o[0]=__builtin_amdgcn_mfma_f32_32x32x16_bf16(PAF(0),VFR(0),o[0],0,0,0), C0,0); \
    GAPB(o[1]=__builtin_amdgcn_mfma_f32_32x32x16_bf16(PAF(0),VFR(4),o[1],0,0,0), C0,4); \
    KRD(GL,0); GAPB(o[0]=__builtin_amdgcn_mfma_f32_32x32x16_bf16(PAF(1),VFR(1),o[0],0,0,0), C0,8); \
    KRD(GL,1); GAPB(o[1]=__builtin_amdgcn_mfma_f32_32x32x16_bf16(PAF(1),VFR(5),o[1],0,0,0), C0,12); \
    KRD(GL,2); GAPB(o[0]=__builtin_amdgcn_mfma_f32_32x32x16_bf16(PAF(2),VFR(2),o[0],0,0,0), C1,0); \
    KRD(GL,3); GAPB(o[1]=__builtin_amdgcn_mfma_f32_32x32x16_bf16(PAF(2),VFR(6),o[1],0,0,0), C1,4); \
    GAPB(o[0]=__builtin_amdgcn_mfma_f32_32x32x16_bf16(PAF(3),VFR(3),o[0],0,0,0), C1,8); \
    GAPB(o[1]=__builtin_amdgcn_mfma_f32_32x32x16_bf16(PAF(3),VFR(7),o[1],0,0,0), C1,12); \
    }while(0)
  int t=1;
  #undef CMASK
  #define CMASK(P0,P1,t) do{}while(0)
  for(;t+5<NT;t+=2){
    STEP(pB0,pB1,pA0,pA1,t,true,true,true);     WAIT_BAR(2); RESC(); ROT();
    STEP(pA0,pA1,pB0,pB1,t+1,true,true,true);   WAIT_BAR(2); RESC(); ROT();
  }
  #undef CMASK
  #define CMASK(P0,P1,t) do{}while(0)
  #define ENDW(tt) do{ if((tt)+3<NT){WAIT_BAR(2);} else if((tt)+2<NT){WAIT_BAR(1);} else {WAIT_BAR(0);} }while(0)
  for(;t+1<NT;t+=2){
    STEP(pB0,pB1,pA0,pA1,t,(t+3<NT),(t+1<NT),(t+1<NT));       ENDW(t);   RESC(); ROT();
    STEP(pA0,pA1,pB0,pB1,t+1,(t+4<NT),(t+2<NT),(t+2<NT));     ENDW(t+1); RESC(); ROT();
  }
  STEP(pB0,pB1,pA0,pA1,NT-1,false,false,false); RESC();
  { float sacc=pB0[0]+pB0[1]; _Pragma("unroll") for(int r=2;r<16;++r)sacc+=pB0[r]; _Pragma("unroll") for(int r=0;r<16;++r)sacc+=pB1[r]; l_reg+=sacc;
    pw0=(u32x4){PKW(pB0,0),PKW(pB0,2),PKW(pB0,4),PKW(pB0,6)};pw1=(u32x4){PKW(pB0,8),PKW(pB0,10),PKW(pB0,12),PKW(pB0,14)};pw2=(u32x4){PKW(pB1,0),PKW(pB1,2),PKW(pB1,4),PKW(pB1,6)};pw3=(u32x4){PKW(pB1,8),PKW(pB1,10),PKW(pB1,12),PKW(pB1,14)};
    SBAR(); pv(o,vb0+sl_cur,PAF(0),PAF(1),PAF(2),PAF(3)); }
  #undef PKW
  #undef PAF
  #undef VFR
  #undef PIN
  #undef MX3
  #undef GAPA
  #undef GAPB
  #undef EX
  #undef VRD
  #undef KRD
  #undef STEP
  #undef ENDW
  {auto rr=__builtin_amdgcn_permlane32_swap(__float_as_uint(l_reg),__float_as_uint(l_reg),false,false);l_reg=__uint_as_float(rr[0])+__uint_as_float(rr[1]);}
  if(hi==0)wsf[32+r32]=l_reg;asm volatile("s_waitcnt lgkmcnt(0)":::"memory");
  float rli[16];
  #pragma unroll
  for(int r=0;r<16;++r)rli[r]=__builtin_amdgcn_rcpf(wsf[32+crow(r,hi)]);
  bf16*Ow=O+(rowbase+q0+wid*QBLK)*OP+h*D;
  { bf16*stg=(bf16*)(shm+LDS_OST)+wid*2048;
    #pragma unroll
    for(int r=0;r<16;++r){const int orow=crow(r,hi);
      #pragma unroll
      for(int d0=0;d0<2;++d0)stg[orow*64+d0*32+r32]=__float2bfloat16(o[d0][r]*rli[r]);}
    asm volatile("s_waitcnt lgkmcnt(0)":::"memory");
    #pragma unroll
    for(int i=0;i<4;++i){const int row=i*8+(lane>>3),ch=lane&7; const u32x4 v=*(const u32x4*)(stg+row*64+ch*8); ATTN_STORE16(Ow+(long)row*OP+ch*8,v);} }
  asm volatile("s_waitcnt lgkmcnt(0)\n\ts_barrier":::"memory");
  #undef DMA_K
  #undef DMA_V
  #undef CMASK
  #undef START
  #undef RESC
  #undef ROT
}
constexpr int ATTN_LDS_BYTES=LDS_BYTES;
struct AttnTensors { const bf16* Q; const bf16* K; const bf16* V; bf16* O; float mref; };
struct AttnUnit { int bh; int qb; };
struct StaticOrder {
  int vcu;
  __device__ __forceinline__ explicit StaticOrder(int grid,int block):vcu((block%8)*(grid/8)+block/8){}
  __device__ __forceinline__ bool next(int i,AttnUnit&u)const{ if(i>=4)return false; const int s=vcu&7; u.bh=vcu>>3; u.qb=(i==0)?s:(i==1)?15-s:(i==2)?16+s:31-s; return true; }
  __device__ __forceinline__ void a_ready(const AttnUnit&)const{}
  __device__ __forceinline__ void done(const AttnUnit&)const{}
};
template<class Sched,int THRL=8> __device__ __forceinline__ void attn_phase(char*lds,const AttnTensors&T,const Sched&S){
  AttnUnit u;
  for(int i=0;S.next(i,u);++i){ S.a_ready(u); attn_unit<THRL>(u.bh>>3,u.bh&7,u.qb,T.Q,T.K,T.V,T.O,lds,T.mref); S.done(u); }
}
#undef SBAR
#undef WAIT_BAR
}

#define LAS __attribute__((address_space(3)))

#define XB_TMO      128
#define XB_XCNT(j)  (256  + 64 * (j))
#define XB_XSUB(j)  (1280 + 64 * (j))
#define XB_XGEN(j)  (2304 + 64 * (j))
#define XB_TOP      3328
#define XB_TOPGEN   3392
#define XCD_BAR_WORDS 3456
#define XB_SPIN_CAP (1u << 18)

__device__ __forceinline__ unsigned xb_ld(unsigned* p)              { return __hip_atomic_load(p, __ATOMIC_RELAXED, __HIP_MEMORY_SCOPE_AGENT); }
__device__ __forceinline__ unsigned xb_add(unsigned* p, unsigned v) { return __hip_atomic_fetch_add(p, v, __ATOMIC_RELAXED, __HIP_MEMORY_SCOPE_AGENT); }
__device__ __forceinline__ unsigned xb_xcc_id() { return (unsigned)__builtin_amdgcn_s_getreg((3 << 11) | 20) & 0xFu; }
#define XB_SPIN(cond, bar) do { unsigned _sp = 0; while (cond) { __builtin_amdgcn_s_sleep(1); \
    if ((++_sp & 255u) == 0u) { if (xb_ld(&(bar)[XB_TMO])) break; if (_sp > XB_SPIN_CAP) { atomicAdd(&(bar)[XB_TMO], 1u); break; } } } } while (0)

struct XcdBarrier {
    unsigned* bar; unsigned x;
    volatile LAS unsigned* st;
};

__device__ __forceinline__ XcdBarrier xcd_barrier_post(unsigned* bar, volatile LAS unsigned* st) {
    XcdBarrier b; b.bar = bar; b.x = xb_xcc_id(); b.st = st;
    if (threadIdx.x == 0) (void)xb_add(&bar[XB_XCNT(b.x)], 1u);
    return b;
}
__device__ __forceinline__ void xcd_barrier_complete(unsigned* bar, unsigned x, unsigned& nloc, unsigned& nx) {
    const unsigned G = gridDim.x * gridDim.y * gridDim.z;
    unsigned sum, cnt, mine, sp = 0u;
    for (;;) {
        sum = 0u; cnt = 0u; mine = 0u;
#pragma unroll
        for (unsigned j = 0; j < 16; ++j) { const unsigned c = xb_ld(&bar[XB_XCNT(j)]); sum += c; cnt += (c > 0u) ? 1u : 0u; mine = (j == x) ? c : mine; }
        if (sum == G) break;
        __builtin_amdgcn_s_sleep(1);
        if ((++sp & 255u) == 0u) { if (xb_ld(&bar[XB_TMO])) break; if (sp > XB_SPIN_CAP) { atomicAdd(&bar[XB_TMO], 1u); break; } }
    }
    nloc = mine > 0u ? mine : 1u; nx = cnt > 0u ? cnt : 1u;
}

__device__ __forceinline__ void xcd_barrier(const XcdBarrier& b) {
    asm volatile("s_waitcnt vmcnt(0)" ::: "memory");
    __syncthreads();
    if (threadIdx.x == 0) {
        unsigned* bar = b.bar;
        __builtin_amdgcn_s_waitcnt(0);
        unsigned nloc = b.st[0], nx = b.st[1];
        if (nloc == 0u) { xcd_barrier_complete(bar, b.x, nloc, nx); b.st[0] = nloc; b.st[1] = nx; }
        const unsigned old = xb_add(&bar[XB_XSUB(b.x)], 1u);
        const unsigned gen = old / nloc;
        if (old + 1u == (gen + 1u) * nloc) {
            __builtin_amdgcn_fence(__ATOMIC_RELEASE, "agent");
            asm volatile("s_waitcnt vmcnt(0)" ::: "memory");
            const unsigned og = xb_add(&bar[XB_TOP], 1u);
            const unsigned tg = og / nx;
            if (og + 1u == (tg + 1u) * nx) xb_add(&bar[XB_TOPGEN], 1u);
            else XB_SPIN(xb_ld(&bar[XB_TOPGEN]) == tg, bar);
            __builtin_amdgcn_fence(__ATOMIC_ACQUIRE, "agent");
            xb_add(&bar[XB_XGEN(b.x)], 1u);
            asm volatile("s_waitcnt vmcnt(0)" ::: "memory");
        } else {
            XB_SPIN(xb_ld(&bar[XB_XGEN(b.x)]) == gen, bar);
            __builtin_amdgcn_fence(__ATOMIC_ACQUIRE, "agent");
            asm volatile("s_waitcnt vmcnt(0)" ::: "memory");
        }
    }
    __syncthreads();
}

#undef LAS

constexpr int NWAVES = 8;
constexpr int RING_OFF = 0, RING_BYTES = 131072;
constexpr int LDSCTL_OFF = RING_BYTES;
constexpr int LDS_TILE_OFF = LDSCTL_OFF + 4096;
constexpr int LDS_BYTES = 147456;
#define LAS __attribute__((address_space(3)))
#define GAS __attribute__((address_space(1)))
typedef unsigned v4u __attribute__((ext_vector_type(4)));

__device__ __forceinline__ int proj_perm(int n) {
    if (n < COL_K || n >= COL_GATE) return n;
    if (n < COL_Q) { const int r = n - COL_K, hs = r >> 6, d = r & 63; return COL_K + 128 * (d >> 5) + 32 * hs + (d & 31); }
    const int r = n - COL_Q, h = r >> 6, d = r & 63; return COL_Q + 256 * (h >> 2) + 128 * (d >> 5) + 32 * (h & 3) + (d & 31);
}
__device__ __forceinline__ int gu_perm(int c) { const int jc = c & 1023, up = c >> 10; return 256 * (jc >> 7) + 128 * up + (jc & 127); }
typedef float wc_f32x4 __attribute__((ext_vector_type(4)));
struct WcMat { const float* W; bf16* WT; int N, ldk, koff, mode, local; };
__device__ __forceinline__ WcMat wc_decode(const P& p, int it) {
    constexpr int I_GLU = 8 * 2, I_SSM = 8 * 4, I_D1 = 16 * 4;
    int r = it; WcMat m;
    if (r < 32 * I_D1) { const int e = r / I_D1; m = WcMat{p.in[28] + (size_t)e * 1024 * 1024, (bf16*)(p.ws + WS_WD) + (size_t)e * 1024 * 1024, 1024, 1024, 0, 0, r % I_D1}; return m; } r -= 32 * I_D1;
    if (r < I_GLU) { m = WcMat{p.in[17], (bf16*)(p.ws + WS_WGLU), 512, 512, 0, 0, r}; return m; } r -= I_GLU;
    if (r < I_SSM) { m = WcMat{p.in[19], (bf16*)(p.ws + WS_W12), 1024, 1024, 0, 0, r}; return m; } r -= I_SSM;
    if (r < I_SSM) { m = WcMat{p.in[22], (bf16*)(p.ws + WS_W12), 1024, 1024, 512, 0, r}; return m; } r -= I_SSM;
    m = WcMat{p.in[23], (bf16*)(p.ws + WS_WOUT), 1024, 1024, 0, 0, r}; return m;
}
#define WQ_LOAD(V, item) do { const bool gu_ = (item) < 2048, wd_ = (item) >= 2152; const int e_ = wd_ ? ((item) - 2152) >> 5 : (item) >> 6, sn_ = gu_ ? (item) & 63 : wd_ ? ((item) - 2152) & 31 : (item) - 2048; const int N_ = gu_ ? 2048 : wd_ ? 1024 : DIN; \
        const float* src_ = (gu_ ? p.in[26] + (size_t)e_ * 1024 * 2048 : wd_ ? p.in[28] + (size_t)e_ * 1024 * 1024 : p.in[8]) + (size_t)(t >> 3) * N_ + 32 * sn_ + 4 * (t & 7); \
        _Pragma("unroll") for (int i_ = 0; i_ < 16; ++i_) V[i_] = *(const wc_f32x4*)(src_ + (size_t)(64 * i_) * N_); } while (0)
__device__ __forceinline__ void wq_proc(const P& p, const wc_f32x4 (&v)[16], int item, LAS unsigned char* lds) {
    const bool gu = item < 2048; const int t = threadIdx.x, e = item >> 6, sn = gu ? item & 63 : item - 2048;
    if (item >= 2152) {
#pragma unroll
        for (int i = 0; i < 16; ++i) { const unsigned lo = pk2(v[i][0], v[i][1]), hi = pk2(v[i][2], v[i][3]);
            typedef unsigned wc_u32x2 __attribute__((ext_vector_type(2))); *(LAS wc_u32x2*)(lds + (((t >> 3) + 64 * i) * 32 + 4 * (t & 7)) * 2) = (wc_u32x2){lo, hi}; }
        __syncthreads();
        const int n = t & 31, cg = t >> 5, ed = (item - 2152) >> 5, sd = (item - 2152) & 31;
        bf16* dst = (bf16*)(p.ws + WS_WD) + ((size_t)ed * 1024 + 32 * sd + n) * 1024;
#pragma unroll
        for (int j = 0; j < 4; ++j) { const int c = cg + 16 * j; unsigned o8[8];
#pragma unroll
            for (int w = 0; w < 8; ++w) { const int k = 16 * c + 2 * w; o8[w] = (unsigned)(*(const LAS unsigned short*)(lds + (k * 32 + n) * 2)) | ((unsigned)(*(const LAS unsigned short*)(lds + ((k + 1) * 32 + n) * 2)) << 16); }
            *(uint4*)(dst + 16 * c) = make_uint4(o8[0], o8[1], o8[2], o8[3]); *(uint4*)(dst + 16 * c + 8) = make_uint4(o8[4], o8[5], o8[6], o8[7]); }
        __syncthreads();
        return; }
    LAS unsigned* cmax = (LAS unsigned*)(lds + 65536);
    if (t < 32) cmax[t] = 0u;
    __syncthreads();
    wc_f32x4 m4 = {0.f, 0.f, 0.f, 0.f};
#pragma unroll
    for (int i = 0; i < 16; ++i) { m4[0] = fmaxf(m4[0], fabsf(v[i][0])); m4[1] = fmaxf(m4[1], fabsf(v[i][1])); m4[2] = fmaxf(m4[2], fabsf(v[i][2])); m4[3] = fmaxf(m4[3], fabsf(v[i][3]));
        const unsigned lo = pk2(v[i][0], v[i][1]), hi = pk2(v[i][2], v[i][3]);
        typedef unsigned wc_u32x2 __attribute__((ext_vector_type(2))); *(LAS wc_u32x2*)(lds + (((t >> 3) + 64 * i) * 32 + 4 * (t & 7)) * 2) = (wc_u32x2){lo, hi}; }
#pragma unroll
    for (int j = 0; j < 4; ++j) __hip_atomic_fetch_max(cmax + 4 * (t & 7) + j, __float_as_uint(m4[j]), __ATOMIC_RELAXED, __HIP_MEMORY_SCOPE_WORKGROUP);
    __syncthreads();
    const int n = t & 31, cg = t >> 5; const float am = __uint_as_float(cmax[n]), inv = am > 0.f ? 127.f / am : 0.f;
    const int c0 = 32 * sn + n, drow = gu ? gu_perm(c0) : proj_perm(c0);
    signed char* dst = gu ? (signed char*)(p.ws + WS_WGQ) + ((size_t)e * 2048 + drow) * 1024 : (signed char*)(p.ws + WS_WIN) + (size_t)drow * 1024;
    if (cg == 0) { if (gu) ((float*)(p.ws + WS_WGS))[e * 2048 + drow] = am * (1.f / 127.f); else ((float*)(p.ws + WS_WINS))[drow] = am * (1.f / 127.f); }
#pragma unroll
    for (int j = 0; j < 4; ++j) { const int c = cg + 16 * j; unsigned o4[4];
#pragma unroll
        for (int w = 0; w < 4; ++w) { unsigned acc = 0u;
#pragma unroll
            for (int q = 0; q < 4; ++q) { const int k = 16 * c + 4 * w + q; const float x = __uint_as_float((unsigned)(*(const LAS unsigned short*)(lds + (k * 32 + n) * 2)) << 16);
                int qi = __float2int_rn(x * inv); qi = qi > 127 ? 127 : (qi < -127 ? -127 : qi);
                acc |= ((unsigned)(qi & 255)) << (8 * q); }
            o4[w] = acc; }
        *(uint4*)(dst + 16 * c) = make_uint4(o4[0], o4[1], o4[2], o4[3]); }
    __syncthreads();
}
#define WC_LOAD(V, M) do { const int nblk_ = M.N >> 8, kb_ = M.local / nblk_, nb_ = M.local - kb_ * nblk_; const float* src_ = M.W + (size_t)(64 * kb_ + wave) * M.N + 256 * nb_ + 4 * lane; \
        _Pragma("unroll") for (int i_ = 0; i_ < 8; ++i_) V[i_] = *(const wc_f32x4*)(src_ + (size_t)(8 * i_) * M.N); } while (0)
#define WC_PROC(V, M, buf) do { const int nblk_ = M.N >> 8, kb_ = M.local / nblk_, nb_ = M.local - kb_ * nblk_, k0_ = 64 * kb_, n0_ = 256 * nb_; LAS float* scr_ = (LAS float*)(lds + (buf) * 65536); \
        _Pragma("unroll") for (int i_ = 0; i_ < 8; ++i_) { const int row_ = wave + 8 * i_; *(LAS wc_f32x4*)(scr_ + row_ * 256 + ((4 * lane) ^ (((row_ >> 3) & 7) << 2))) = V[i_]; } \
        __syncthreads(); const int c_ = lane & 7; \
        _Pragma("unroll") for (int j_ = 0; j_ < 4; ++j_) { const int n_ = 64 * j_ + 8 * wave + (lane >> 3); const LAS float* s_ = scr_ + (8 * c_) * 256 + (n_ ^ (c_ << 2)); \
            v4u o_; o_.x = pk2(s_[0 * 256], s_[1 * 256]); o_.y = pk2(s_[2 * 256], s_[3 * 256]); o_.z = pk2(s_[4 * 256], s_[5 * 256]); o_.w = pk2(s_[6 * 256], s_[7 * 256]); \
            const int dr_ = M.mode == 1 ? proj_perm(n0_ + n_) : M.mode == 2 ? gu_perm(n0_ + n_) : n0_ + n_; \
            *(v4u*)(M.WT + (size_t)dr_ * M.ldk + M.koff + k0_ + 8 * c_) = o_; } } while (0)
__device__ __forceinline__ void ph_wconv(const P& p, int bx, LAS unsigned char* lds) {
    const int lane = threadIdx.x & 63, wave = threadIdx.x >> 6, t = threadIdx.x;
    if (bx >= 224) { const int s0 = bx - 224; wc_f32x4 sa[16], sb[16];
        WQ_LOAD(sa, 2048 + s0); WQ_LOAD(sb, 2048 + s0 + 32); wq_proc(p, sa, 2048 + s0, lds); WQ_LOAD(sa, 2048 + s0 + 64); wq_proc(p, sb, 2048 + s0 + 32, lds); wq_proc(p, sa, 2048 + s0 + 64, lds); }
    else if (bx >= 64 && bx < 160) {
#pragma unroll 1
        for (int it = 96 + (bx - 64); it < 248; it += 96) {
            if (it < 104) { wc_f32x4 sa[16]; WQ_LOAD(sa, 2048 + it); wq_proc(p, sa, 2048 + it, lds); }
            else { wc_f32x4 wa[8]; const WcMat ma = wc_decode(p, 2048 + it - 104); WC_LOAD(wa, ma); WC_PROC(wa, ma, 0); __syncthreads(); } } }
}
__device__ __forceinline__ void wq_range(const P& p, int id0, int stride, int n, LAS unsigned char* lds) {
    const int t = threadIdx.x; wc_f32x4 sa[16], sb[16];
#define WQ_ID(q) ((id0 + (q) * stride) < 2048 ? (id0 + (q) * stride) : (id0 + (q) * stride) + 104)
    if (n > 0) WQ_LOAD(sa, WQ_ID(0));
#pragma unroll 1
    for (int q = 0; q < n; q += 2) {
        if (q + 1 < n) WQ_LOAD(sb, WQ_ID(q + 1));
        wq_proc(p, sa, WQ_ID(q), lds);
        if (q + 1 >= n) break;
        if (q + 2 < n) WQ_LOAD(sa, WQ_ID(q + 2));
        wq_proc(p, sb, WQ_ID(q + 1), lds);
    }
#undef WQ_ID
}
__device__ __forceinline__ void ph_wexp(const P& p, int idx, LAS unsigned char* lds) {
    wq_range(p, idx, 256, 12, lds);
    __syncthreads();
}
#undef WC_LOAD
#undef WC_PROC
#undef WQ_LOAD

__device__ __forceinline__ void ph_s5tab(const P& p, int g, int dir, int part, int nparts, float* L) {
    float* pw = L; float* Bb = L + 2176; float* Cc = Bb + 2048; float* Kt = Cc + 2048;
    const int tid = threadIdx.x, dg = dir * 32 + g;
    const float step = expf(p.in[11][dg]);
    for (int i = tid; i < 64 * 17; i += 512) { const int n = i / 17, tau = i - n * 17; const float zr = p.in[9][dg * 64 + n] * step, zi = p.in[10][dg * 64 + n] * step;
        const float e = expf(zr * (float)tau), a = zi * (float)tau; float sn, cs; sincosf(a, &sn, &cs); pw[i * 2] = e * cs; pw[i * 2 + 1] = e * sn; }
    for (int i = tid; i < 1024; i += 512) { const int n = i >> 4, q = i & 15; const float lr = p.in[9][dg * 64 + n], li = p.in[10][dg * 64 + n]; const float zr = lr * step, zi = li * step, e = expf(zr);
        float sn, cs; sincosf(zi, &sn, &cs); const float nr = e * cs - 1.f, ni = e * sn, den = lr * lr + li * li; const float cr = (nr * lr + ni * li) / den, ci = (ni * lr - nr * li) / den;
        const float br = p.in[12][(dg * 64 + n) * 16 + q], bi = p.in[13][(dg * 64 + n) * 16 + q]; Bb[i * 2] = cr * br - ci * bi; Bb[i * 2 + 1] = cr * bi + ci * br; }
    for (int i = tid; i < 1024; i += 512) { Cc[i * 2] = p.in[14][dg * 1024 + i]; Cc[i * 2 + 1] = p.in[15][dg * 1024 + i]; }
    __syncthreads();
    typedef float f2 __attribute__((ext_vector_type(2)));
    { const int tau = tid >> 5, pp = (tid >> 1) & 15, q0 = (tid & 1) * 8;
      float a[8] = {0.f, 0.f, 0.f, 0.f, 0.f, 0.f, 0.f, 0.f};
#pragma unroll 4
      for (int n = 0; n < 64; ++n) { const f2 c = *(const f2*)(Cc + (pp * 64 + n) * 2), w = *(const f2*)(pw + (n * 17 + tau) * 2); const float zr = c.x * w.x - c.y * w.y, zi = c.x * w.y + c.y * w.x;
#pragma unroll
          for (int q = 0; q < 8; ++q) { const f2 bq = *(const f2*)(Bb + (n * 16 + q0 + q) * 2); a[q] += zr * bq.x - zi * bq.y; } }
#pragma unroll
      for (int q = 0; q < 8; ++q) Kt[(tau * 16 + pp) * 16 + q0 + q] = a[q]; }
    __syncthreads();
    if (part == 0 && tid < 256) ((float*)(p.ws + WS_KD))[dg * 256 + tid] = Kt[tid];
    bf16* TCV = (bf16*)(p.ws + WS_TCV) + (size_t)g * 256 * 512;
    for (int i = part * 512 + tid; i < 256 * 256; i += 512 * nparts) { const int row = i >> 8, k = i & 255, ii = row >> 4, pp = row & 15, j = k >> 4, q = k & 15;
        if (dir == 0 ? (j < ii) : (j > ii)) TCV[row * 512 + k] = f2bf(Kt[((dir == 0 ? ii - j : j - ii) * 16 + pp) * 16 + q]); }
    for (int i = part * 512 + tid; i < 256 * 128; i += 512 * nparts) { const int row = i >> 7, kk = i & 127, ii = row >> 4, pp = row & 15, n = kk >> 1, ri = kk & 1, tau = dir == 0 ? ii + 1 : 16 - ii;
        const f2 c = *(const f2*)(Cc + (pp * 64 + n) * 2), w = *(const f2*)(pw + (n * 17 + tau) * 2);
        TCV[row * 512 + 256 + dir * 128 + kk] = f2bf(ri == 0 ? (c.x * w.x - c.y * w.y) : -(c.x * w.y + c.y * w.x)); }
    bf16* WS5 = (bf16*)(p.ws + WS_WS5) + (size_t)g * 256 * 256 + (size_t)dir * 128 * 256;
    for (int i = part * 512 + tid; i < 128 * 256; i += 512 * nparts) { const int row = i >> 8, k = i & 255, n = row >> 1, ri = row & 1, ii = k >> 4, q = k & 15, tau = dir == 0 ? 15 - ii : ii;
        const f2 w = *(const f2*)(pw + (n * 17 + tau) * 2), bq = *(const f2*)(Bb + (n * 16 + q) * 2);
        WS5[i] = f2bf(ri == 0 ? w.x * bq.x - w.y * bq.y : w.x * bq.y + w.y * bq.x); }
}
__device__ __forceinline__ void ph_s5diag(const P& p, int g) {
    const float* KD = (const float*)(p.ws + WS_KD); bf16* TCV = (bf16*)(p.ws + WS_TCV) + (size_t)g * 256 * 512;
    for (int i = threadIdx.x; i < 4096; i += 512) { const int ii = i >> 8, pp = (i >> 4) & 15, q = i & 15;
        const float v = KD[g * 256 + pp * 16 + q] + KD[(32 + g) * 256 + pp * 16 + q] + (pp == q ? p.in[16][g * 16 + pp] : 0.f);
        TCV[(ii * 16 + pp) * 512 + ii * 16 + q] = f2bf(v); }
}
__device__ __forceinline__ void ph_s5scan(const P& p, int bx, int G, float* L) {
    const int n = threadIdx.x & 63, s = threadIdx.x >> 6;
    for (int w = bx; w < 256; w += G) { const int b = w >> 6, g = (w >> 1) & 31, dir = w & 1, dg = dir * 32 + g;
        const float lr = p.in[9][dg * 64 + n], li = p.in[10][dg * 64 + n], step = expf(p.in[11][dg]); const float zr = 16.f * lr * step, zi = 16.f * li * step, ez = expf(zr);
        float sn_, cs_; sincosf(zi, &sn_, &cs_); const float ar = ez * cs_, ai = ez * sn_;
        const float ez64 = expf(64.f * zr); sincosf(64.f * zi, &sn_, &cs_); const float Ar = ez64 * cs_, Ai = ez64 * sn_;
        const bf16* sl = (const bf16*)(p.ws + WS_SL) + (size_t)g * NCHUNK_PAD * 256 + dir * 128 + 2 * n;
        bf16* hh = (bf16*)(p.ws + WS_UH) + (size_t)g * NCHUNK_PAD * 512 + 256 + dir * 128 + 2 * n;
        const int k0 = dir ? 511 - 64 * s : 64 * s; const long inc = dir ? -1 : 1;
        const bf16* pc = sl + (size_t)(2048 + b * 16 + (dir ? 15 : 0)) * 256; const bf16* ps = sl + (size_t)(b * 512 + k0) * 256; bf16* ph = hh + (size_t)(b * 512 + k0) * 512;
        unsigned vc[16], v[64];
#pragma unroll
        for (int u = 0; u < 16; ++u) { vc[u] = *(const unsigned*)pc; pc += inc * 256; asm volatile("" : "+v"(pc)); }
#pragma unroll
        for (int u = 0; u < 64; ++u) { v[u] = *(const unsigned*)ps; ps += inc * 256; asm volatile("" : "+v"(ps)); }
        float c0r = 0.f, c0i = 0.f;
#pragma unroll
        for (int u = 0; u < 16; ++u) { const float x = __uint_as_float(vc[u] << 16), y = __uint_as_float(vc[u] & 0xffff0000u); const float nr = ar * c0r - ai * c0i + x, ni = ar * c0i + ai * c0r + y; c0r = nr; c0i = ni; }
        float sr = 0.f, si = 0.f;
#pragma unroll
        for (int u = 0; u < 64; ++u) { const float x = __uint_as_float(v[u] << 16), y = __uint_as_float(v[u] & 0xffff0000u); const float nr = ar * sr - ai * si + x, ni = ar * si + ai * sr + y; sr = nr; si = ni; }
        L[(s * 64 + n) * 2] = sr; L[(s * 64 + n) * 2 + 1] = si;
        __syncthreads();
        sr = c0r; si = c0i;
        for (int t = 0; t < s; ++t) { const float x = L[(t * 64 + n) * 2], y = L[(t * 64 + n) * 2 + 1]; const float nr = Ar * sr - Ai * si + x, ni = Ar * si + Ai * sr + y; sr = nr; si = ni; }
#pragma unroll
        for (int u = 0; u < 64; ++u) { *(unsigned*)ph = pk2(sr, si); ph += inc * 512; asm volatile("" : "+v"(ph));
            const float x = __uint_as_float(v[u] << 16), y = __uint_as_float(v[u] & 0xffff0000u); const float nr = ar * sr - ai * si + x, ni = ar * si + ai * sr + y; sr = nr; si = ni; }
        __syncthreads();
    }
}

__global__ void __launch_bounds__(NWAVES * 64, 2) mk_fwd(P p, int ph_lo, int ph_hi) {
    extern __shared__ __attribute__((aligned(16))) unsigned char lds_raw[];
    LAS unsigned char* lds = (LAS unsigned char*)lds_raw;
    const int tid = threadIdx.x, G = gridDim.x, bx = blockIdx.x;
    const int vcu = (G % 8 == 0) ? (bx % 8) * (G / 8) + bx / 8 : bx;
    for (int u = tid; u < 64; u += NWAVES * 64) ((LAS unsigned*)(lds + LDSCTL_OFF))[u] = 0u;
    __syncthreads();
    unsigned* barw = (unsigned*)(p.ws + WS_CTL) + 4096;
    XcdBarrier bar; bar.bar = barw; bar.x = 0; bar.st = nullptr;
    if (ph_hi - ph_lo > 1) bar = xcd_barrier_post(barw, (volatile LAS unsigned*)(lds + LDSCTL_OFF) + 8);
#define IN(k) (ph_lo <= (k) && (k) < ph_hi)
#define PH(k) if (IN(k))
#define SEAM(k) do { if (IN(k) && IN((k) + 1)) xcd_barrier(bar); } while (0)

    PH(0) {
        if (bx < 64) ph_s5tab(p, bx >> 1, bx & 1, 0, 2, (float*)lds_raw); else if (bx < 160) ph_mod(p, bx - 64, 96, (float*)lds_raw); else if (bx < 224) ph_s5tab(p, (bx - 160) >> 1, bx & 1, 1, 2, (float*)lds_raw);
        ph_rope(p, bx, G); __syncthreads(); ph_wconv(p, bx, lds);
    }
    SEAM(0);
    PH(1) { ph_h1(p, bx, G); if (bx < 32) ph_s5diag(p, bx); }
    SEAM(1);
    PH(2) {
        pg8::GemmG g{(const char*)(p.ws + WS_H1), (const char*)(p.ws + WS_WIN), 128, (size_t)128 * 1024, (size_t)256 * 1024, 512, 512, nullptr, 0u};
        pg8::SchedProj S; S.init(G, bx);
        pg8::EpiProj E{(bf16*)(p.ws + WS_UH), (bf16*)(p.ws + WS_KB), (bf16*)(p.ws + WS_VB), (bf16*)(p.ws + WS_QB), (unsigned char*)(p.ws + WS_GT), p.in[20], p.in[21], (const float*)(p.ws + WS_ROPE),
                       (const float*)(p.ws + WS_H1S), (const float*)(p.ws + WS_WINS)};
        pg8::gemm_phase<pg8::EpiProj, pg8::SchedProj, pg8::AoRow, false, true, true>(lds + RING_OFF, g, pg8::AoRow{512}, S, E);
    }
    SEAM(2);
    PH(3) {
        pg8::GemmG g{(const char*)(p.ws + WS_UH), (const char*)(p.ws + WS_WS5), 128, (size_t)128 * 512 * 2, (size_t)256 * 512 * 2, 256, 256, nullptr, 0u};
        pg8::SchedS5 S{9, G, bx};
        pg8::EpiSloc E{(bf16*)(p.ws + WS_SL)};
        pg8::gemm_phase(lds + RING_OFF, g, pg8::AoRow{512}, S, E);
    }
    SEAM(3);
    PH(4) { ph_s5scan(p, bx, G, (float*)lds_raw); }
    SEAM(4);
    PH(5) {
        pg8::GemmG g{(const char*)(p.ws + WS_UH), (const char*)(p.ws + WS_TCV), 128, (size_t)128 * 512 * 2, (size_t)256 * 512 * 2, 512, 512, nullptr, 0u};
        pg8::SchedS5 S{8, G, bx};
        pg8::EpiS5Y E{(bf16*)(p.ws + WS_SG)};
        pg8::gemm_phase(lds + RING_OFF, g, pg8::AoRow{512}, S, E);
    }
    PH(6) {
        float gq = 0.f, gk = 0.f;
        for (int d = 0; d < 64; ++d) { gq = fmaxf(gq, fabsf(p.in[20][d])); gk = fmaxf(gk, fabsf(p.in[21][d])); }
        const float mref = 64.f * C2 * gq * gk * 1.02f + 0.05f;
        const attn_body::AttnTensors AT{(const attn_body::bf16*)(p.ws + WS_QB), (const attn_body::bf16*)(p.ws + WS_KB), (const attn_body::bf16*)(p.ws + WS_VB), (attn_body::bf16*)(p.ws + WS_GO) + 512, mref};
        const attn_body::StaticOrder S(G, bx);
        const int kq = bx >> 3, jgap = kq & 3, widx = jgap * 64 + (kq >> 2) * 8 + (bx & 7);
        attn_body::AttnUnit u; int i = 0;
#pragma unroll 1
        for (; i < jgap; ++i) { S.next(i, u); attn_body::attn_unit<8>(u.bh >> 3, u.bh & 7, u.qb, AT.Q, AT.K, AT.V, AT.O, (char*)lds_raw + RING_OFF, AT.mref); }
        ph_wexp(p, widx, lds);
#pragma unroll 1
        for (; i < 4; ++i) { S.next(i, u); attn_body::attn_unit<8>(u.bh >> 3, u.bh & 7, u.qb, AT.Q, AT.K, AT.V, AT.O, (char*)lds_raw + RING_OFF, AT.mref); }
    }
    SEAM(6);
    PH(7) {
        pg8::GemmG g{(const char*)(p.ws + WS_SG), (const char*)(p.ws + WS_WGLU), (size_t)4 * T * 32, (size_t)128 * 32, (size_t)256 * 32, 512, 512, nullptr, 0u};
        pg8::StaticOrder S; S.init(T, 512, G, bx);
        pg8::EpiGlu E{(const bf16*)(p.ws + WS_SG), p.in[18], (bf16*)(p.ws + WS_GO)};
        pg8::gemm_phase(lds + RING_OFF, g, pg8::AoGrp{}, S, E);
    }
    SEAM(7);
    PH(8) {
        pg8::StaticOrder S; S.init(T, 1024, G, bx);
        { pg8::GemmG g{(const char*)(p.ws + WS_GO), (const char*)(p.ws + WS_W12), 128, (size_t)128 * 1024 * 2, (size_t)256 * 1024 * 2, 1024, 512, nullptr, 0u};
          pg8::EpiMerge<0> E{(const unsigned char*)(p.ws + WS_GT), (bf16*)(p.ws + WS_M1), (bf16*)(p.ws + WS_MG)};
          pg8::gemm_phase(lds + RING_OFF, g, pg8::AoRow{1024}, S, E); }
        { pg8::GemmG g{(const char*)(p.ws + WS_GO) + 1024, (const char*)(p.ws + WS_W12) + 1024, 128, (size_t)128 * 1024 * 2, (size_t)256 * 1024 * 2, 1024, 512, nullptr, 0u};
          pg8::EpiMerge<1> E{(const unsigned char*)(p.ws + WS_GT), (bf16*)(p.ws + WS_M1), (bf16*)(p.ws + WS_MG)};
          pg8::gemm_phase(lds + RING_OFF, g, pg8::AoRow{1024}, S, E); }
    }
    SEAM(8);
    PH(9) {
        pg8::GemmG g{(const char*)(p.ws + WS_MG), (const char*)(p.ws + WS_WOUT), 128, (size_t)128 * 1024 * 2, (size_t)256 * 1024 * 2, 1024, 1024, nullptr, 0u};
        pg8::StaticOrder S; S.init(T, 1024, G, bx);
        pg8::EpiOut E{p.in[0], (const float*)(p.ws + WS_MOD), (bf16*)(p.ws + WS_XM)};
        pg8::gemm_phase(lds + RING_OFF, g, pg8::AoRow{1024}, S, E);
    }
    SEAM(9);
    PH(10) { ph_route_a(p, bx, G, (float*)lds_raw); }
    SEAM(10);
    PH(11) { ph_route_b(p, bx, G, (int*)lds_raw); }
    SEAM(11);
    if (IN(12) || IN(13)) {
        const int* TILE_E = (const int*)(p.ws + WS_TILE); LAS int* lt = (LAS int*)(lds + LDS_TILE_OFF);
        for (int i = tid; i < 1024; i += NWAVES * 64) lt[i] = TILE_E[i];
        __syncthreads();
    }
    PH(12) {
        const LAS int* lt = (const LAS int*)(lds + LDS_TILE_OFF);
        pg8::GemmG g{(const char*)(p.ws + WS_H2), (const char*)(p.ws + WS_WGQ), 128, 0, 0, 512, 512, (const int*)(p.ws + WS_SLOTTOK), 1024u};
        pg8::SchedMoE S{lt, lt[1023], 8, G, bx, 0};
        pg8::EpiGU8 E{p.in[27], (const float*)(p.ws + WS_SLOTSA), (const float*)(p.ws + WS_WGS), (bf16*)(p.ws + WS_ACT)};
        pg8::gemm_phase<pg8::EpiGU8, pg8::SchedMoE, pg8::AoRow, true, true, true>(lds + RING_OFF, g, pg8::AoRow{512}, S, E);
    }
    SEAM(12);
    PH(13) {
        const LAS int* lt = (const LAS int*)(lds + LDS_TILE_OFF);
        pg8::GemmG g{(const char*)(p.ws + WS_ACT), (const char*)(p.ws + WS_WD), 128, (size_t)128 * 1024 * 2, (size_t)256 * 1024 * 2, 1024, 1024, nullptr, 0u};
        pg8::SchedMoE S{lt, lt[1023], 4, G, bx, 1};
        pg8::EpiDown E{p.in[29], (const float*)(p.ws + WS_SLOTGATE), (bf16*)(p.ws + WS_YB)};
        pg8::gemm_phase(lds + RING_OFF, g, pg8::AoRow{1024}, S, E);
    }
    SEAM(13);
    PH(14) { ph_final(p, bx, G); }
#undef IN
#undef PH
#undef SEAM
}

extern "C" void kernel_launch(void* const* d_in, const int* in_sizes, int n_in, void* d_out, int out_size, void* d_ws, size_t ws_size, hipStream_t stream) {
    if (n_in != 31 || out_size != T * DM || ws_size < WS_END) { fprintf(stderr, "kernel_launch: unexpected shapes (n_in %d out %d ws %zu)\n", n_in, out_size, ws_size); return; }
    static int grid = 0;
    if (!grid) {
        int dev = 0, cus = 0, per_cu = 0;
        (void)hipGetDevice(&dev); (void)hipDeviceGetAttribute(&cus, hipDeviceAttributeMultiprocessorCount, dev);
        (void)hipFuncSetAttribute((const void*)mk_fwd, hipFuncAttributeMaxDynamicSharedMemorySize, LDS_BYTES);
        (void)hipOccupancyMaxActiveBlocksPerMultiprocessor(&per_cu, (const void*)mk_fwd, NWAVES * 64, LDS_BYTES);
        (void)hipGetLastError();
        if (cus != 256 || per_cu < 1) fprintf(stderr, "kernel_launch: note: %d CUs, occupancy query %d; this kernel is built for one 512-thread workgroup on each of 256 CUs\n", cus, per_cu);
        grid = 256;
    }
    P p{}; for (int i = 0; i < 31; ++i) p.in[i] = (const float*)d_in[i]; p.out = (float*)d_out; p.ws = (unsigned char*)d_ws;
    (void)hipMemsetAsync((char*)d_ws + WS_CTL, 0, 1 * MiB, stream);
    hipLaunchKernelGGL(mk_fwd, dim3(grid), dim3(NWAVES * 64), LDS_BYTES, stream, p, 0, 15);
}
```

```cpp
#include <hip/hip_runtime.h>
#include <cstdio>
#include <cstdint>

constexpr int NB = 4, SEQ = 8192, DM = 1024, LC = 256;
constexpr int T = NB * SEQ;
constexpr int TC = NB * LC;
constexpr int TR = T + TC;
constexpr int DIN = 3328, COL_K = 512, COL_V = 640, COL_Q = 768, COL_GATE = 1280;
constexpr int NMOD = 6 * DM;
constexpr int SKV = LC + SEQ;
constexpr int NE = 32;
constexpr int NSLOT_MAX = 139264;
constexpr int NCHUNK_PAD = 2304;
constexpr float EPS = 1e-6f;
constexpr float C2 = 0.125f * 1.4426950408889634f;

constexpr size_t MiB = 1u << 20;
constexpr size_t WS_CTL = 0;
constexpr size_t WS_MOD = 1 * MiB;
constexpr size_t WS_ROPE = 1 * MiB + 256 * 1024;
constexpr size_t WS_WCNT = 2 * MiB;
constexpr size_t WS_BCNT = 2 * MiB + 256 * 1024;
constexpr size_t WS_KD = 2 * MiB + 384 * 1024;
constexpr size_t WS_TILE = 2 * MiB + 512 * 1024;
constexpr size_t WS_WIN = 4 * MiB, WS_WGLU = 11 * MiB, WS_W12 = 12 * MiB, WS_WOUT = 14 * MiB;
constexpr size_t WS_TCV = 16 * MiB, WS_WS5 = 24 * MiB;
constexpr size_t WS_WGU = 32 * MiB, WS_WD = 160 * MiB;
constexpr size_t WS_SL = 733 * MiB;
constexpr size_t WS_TOPI = 28 * MiB, WS_TOPG = 28 * MiB + 512 * 1024, WS_TOKSLOT = 29 * MiB;
constexpr size_t WS_SLOTTOK = 29 * MiB + 512 * 1024, WS_SLOTGATE = 30 * MiB + 512 * 1024;
constexpr size_t WS_XM = 224 * MiB;
constexpr size_t WS_H2 = 352 * MiB;
constexpr size_t WS_H2S = 384 * MiB;
constexpr size_t WS_SLOTSA = 385 * MiB;
constexpr size_t WS_WGQ = 288 * MiB;
constexpr size_t WS_WGS = 3 * MiB;
constexpr size_t WS_H1 = 417 * MiB;
constexpr size_t WS_H1S = 451 * MiB;
constexpr size_t WS_WINS = 3 * MiB + 256 * 1024;
constexpr size_t WS_UH = 483 * MiB;
constexpr size_t WS_KB = 555 * MiB, WS_VB = 564 * MiB;
constexpr size_t WS_QB = 573 * MiB;
constexpr size_t WS_GT = 605 * MiB;
constexpr size_t WS_SG = 769 * MiB;
constexpr size_t WS_GO = 801 * MiB;
constexpr size_t WS_M1 = 865 * MiB;
constexpr size_t WS_MG = 417 * MiB;
constexpr size_t WS_ACT = 417 * MiB;
constexpr size_t WS_YB = 689 * MiB;
constexpr size_t WS_END = 993 * MiB;

typedef unsigned short bf16;
struct P { const float* in[31]; float* out; unsigned char* ws; };

__device__ __forceinline__ float bf2f(bf16 v) { return __uint_as_float(((unsigned)v) << 16); }
__device__ __forceinline__ bf16 f2bf(float f) { unsigned u = __float_as_uint(f); return (bf16)((u + 0x7fffu + ((u >> 16) & 1u)) >> 16); }
__device__ __forceinline__ unsigned pk2(float lo, float hi) { return (unsigned)f2bf(lo) | ((unsigned)f2bf(hi) << 16); }
__device__ __forceinline__ float wave_sum(float v) {
#pragma unroll
    for (int o = 1; o < 64; o <<= 1) v += __shfl_xor(v, o);
    return v;
}
__device__ __forceinline__ float sigmoidf(float v) { return 1.f / (1.f + expf(-v)); }

__device__ __forceinline__ void ph_mod(const P& p, int bid, int nb, float* lds) {
    float* s = lds; float* red = lds + 5 * 1024;
    const float* c = p.in[1]; const float* cc = p.in[3];
    for (int i = threadIdx.x; i < 5 * 1024; i += 512) { const float v = i < 4096 ? c[i] : cc[i - 4096]; s[i] = v / (1.f + expf(-v)); }
    __syncthreads();
    const float* w = p.in[4]; const float* bm = p.in[5]; float* mod = (float*)(p.ws + WS_MOD);
    const int jl = threadIdx.x & 63, ks = threadIdx.x >> 6;
    for (int it = bid; it < 96; it += nb) {
        const int j = it * 64 + jl;
        float a0 = 0.f, a1 = 0.f, a2 = 0.f, a3 = 0.f, a4 = 0.f;
#pragma unroll 1
        for (int k0 = ks * 128; k0 < ks * 128 + 128; k0 += 64) { float wv[64];
#pragma unroll
            for (int q = 0; q < 64; ++q) wv[q] = __builtin_nontemporal_load(w + (size_t)(k0 + q) * NMOD + j);
#pragma unroll
            for (int q4 = 0; q4 < 16; ++q4) { const int k = k0 + 4 * q4;
                const float4 s0 = *(const float4*)(s + k), s1 = *(const float4*)(s + 1024 + k), s2 = *(const float4*)(s + 2048 + k), s3 = *(const float4*)(s + 3072 + k), s4 = *(const float4*)(s + 4096 + k);
                const float w0 = wv[4 * q4], w1 = wv[4 * q4 + 1], w2 = wv[4 * q4 + 2], w3 = wv[4 * q4 + 3];
                a0 += s0.x * w0; a1 += s1.x * w0; a2 += s2.x * w0; a3 += s3.x * w0; a4 += s4.x * w0;
                a0 += s0.y * w1; a1 += s1.y * w1; a2 += s2.y * w1; a3 += s3.y * w1; a4 += s4.y * w1;
                a0 += s0.z * w2; a1 += s1.z * w2; a2 += s2.z * w2; a3 += s3.z * w2; a4 += s4.z * w2;
                a0 += s0.w * w3; a1 += s1.w * w3; a2 += s2.w * w3; a3 += s3.w * w3; a4 += s4.w * w3; }
        }
        red[(ks * 5 + 0) * 64 + jl] = a0; red[(ks * 5 + 1) * 64 + jl] = a1; red[(ks * 5 + 2) * 64 + jl] = a2; red[(ks * 5 + 3) * 64 + jl] = a3; red[(ks * 5 + 4) * 64 + jl] = a4;
        __syncthreads();
        if (threadIdx.x < 320) { const int r = threadIdx.x >> 6; float t = 0.f;
            for (int q = 0; q < 8; ++q) t += red[(q * 5 + r) * 64 + jl];
            mod[r * NMOD + j] = t + bm[j]; }
        __syncthreads();
    }
}
__device__ __forceinline__ void ph_rope(const P& p, int bid, int nb) {
    float* R = (float*)(p.ws + WS_ROPE);
    for (int i = bid * 512 + threadIdx.x; i < 192 * 16; i += nb * 512) {
        const int j = i & 15; const int pos = i >> 4;
        const float invf = powf(10000.f, -(float)j / 16.f);
        if (pos < 128) { const float a = (float)pos * invf; R[pos * 16 + j] = cosf(a); R[2048 + pos * 16 + j] = sinf(a); }
        else { const int cp = pos - 128; const float a = (float)cp * invf; R[4096 + cp * 16 + j] = cosf(a); R[5120 + cp * 16 + j] = sinf(a); }
    }
}
__device__ __forceinline__ void ph_h1_row(const float4 (&v)[4], const float4 (&gf)[4], const float4 (&sh)[4], signed char* orow, float* oscale, int lane) {
    float ss = 0.f;
#pragma unroll
    for (int j = 0; j < 4; ++j) ss += v[j].x * v[j].x + v[j].y * v[j].y + v[j].z * v[j].z + v[j].w * v[j].w;
    ss = wave_sum(ss); const float rs = 1.f / sqrtf(ss * (1.f / DM) + EPS); float h[4][4]; float am = 0.f;
#pragma unroll
    for (int j = 0; j < 4; ++j) { h[j][0] = v[j].x * rs * gf[j].x + sh[j].x; h[j][1] = v[j].y * rs * gf[j].y + sh[j].y; h[j][2] = v[j].z * rs * gf[j].z + sh[j].z; h[j][3] = v[j].w * rs * gf[j].w + sh[j].w;
        am = fmaxf(fmaxf(am, fmaxf(fabsf(h[j][0]), fabsf(h[j][1]))), fmaxf(fabsf(h[j][2]), fabsf(h[j][3]))); }
#pragma unroll
    for (int o = 1; o < 64; o <<= 1) am = fmaxf(am, __shfl_xor(am, o));
    const float inv = am > 0.f ? 127.f / am : 0.f;
#pragma unroll
    for (int j = 0; j < 4; ++j) { const int q0 = __float2int_rn(h[j][0] * inv), q1 = __float2int_rn(h[j][1] * inv), q2 = __float2int_rn(h[j][2] * inv), q3 = __float2int_rn(h[j][3] * inv);
        __builtin_nontemporal_store((unsigned)(q0 & 255) | ((unsigned)(q1 & 255) << 8) | ((unsigned)(q2 & 255) << 16) | ((unsigned)(q3 & 255) << 24), (unsigned*)(orow + 4 * lane + 256 * j)); }
    if (lane == 0) *oscale = am * (1.f / 127.f);
}
__device__ __forceinline__ void ph_h1(const P& p, int bid, int nb) {
    const int lane = threadIdx.x & 63, wave = threadIdx.x >> 6, gw = bid * 8 + wave, ngw = nb * 8;
    const float* g = p.in[6]; const float* mod = (const float*)(p.ws + WS_MOD); signed char* H1 = (signed char*)(p.ws + WS_H1); float* H1S = (float*)(p.ws + WS_H1S);
    const int rpw = T / ngw;
    float4 gf[4], sh[4], v[4], v1[4], v2[4];
#define H1_MOD(mrow) do { _Pragma("unroll") for (int j = 0; j < 4; ++j) { const int col = 4 * lane + 256 * j; const float4 gg = *(const float4*)(g + col), sc = *(const float4*)(mod + (mrow) * NMOD + 1024 + col); \
        sh[j] = *(const float4*)(mod + (mrow) * NMOD + col); gf[j] = make_float4(gg.x * (1.f + sc.x), gg.y * (1.f + sc.y), gg.z * (1.f + sc.z), gg.w * (1.f + sc.w)); } } while (0)
#define H1_LOAD(V, xr) do { _Pragma("unroll") for (int j = 0; j < 4; ++j) { typedef float h1_f32x4 __attribute__((ext_vector_type(4))); const h1_f32x4 w_ = __builtin_nontemporal_load(((const h1_f32x4*)(xr)) + lane + 64 * j); V[j] = make_float4(w_[0], w_[1], w_[2], w_[3]); } } while (0)
    const float* x0 = p.in[0] + (size_t)gw * DM; const size_t xs = (size_t)ngw * DM;
    H1_LOAD(v, x0); H1_LOAD(v1, x0 + xs);
    int bcur = -1;
    for (int k = 0; k < rpw; ++k) { const int row = gw + k * ngw, b = row / SEQ;
        H1_LOAD(v2, x0 + (size_t)((k + 2 < rpw) ? k + 2 : rpw - 1) * xs);
        if (b != bcur) { H1_MOD(b); bcur = b; }
        ph_h1_row(v, gf, sh, H1 + (size_t)row * DM, H1S + row, lane);
#pragma unroll
        for (int j = 0; j < 4; ++j) { v[j] = v1[j]; v1[j] = v2[j]; }
    }
    for (int rc = gw; rc < TC; rc += ngw) { H1_LOAD(v, p.in[2] + (size_t)rc * DM); H1_MOD(4); ph_h1_row(v, gf, sh, H1 + (size_t)(T + rc) * DM, H1S + T + rc, lane); }
#undef H1_LOAD
#undef H1_MOD
}
__device__ __forceinline__ void ph_wgquant(const P& p, int bid, int nb) {
    const int lane = threadIdx.x & 63, wave = threadIdx.x >> 6, gw = bid * 8 + wave, ngw = nb * 8;
    const bf16* WG = (const bf16*)(p.ws + WS_WGU); signed char* WQ = (signed char*)(p.ws + WS_WGQ); float* WS = (float*)(p.ws + WS_WGS);
    constexpr int NROWS = 32 * 2048; const int rpw = NROWS / ngw, r0 = gw * rpw;
    uint4 va[2], vb[2], vc[2];
#define WQ_LOAD(V, r) do { const uint4* s_ = (const uint4*)(WG + (size_t)(r) * 1024) + 2 * lane; V[0] = s_[0]; V[1] = s_[1]; } while (0)
    WQ_LOAD(va, r0); WQ_LOAD(vb, r0 + 1);
    for (int k = 0; k < rpw; ++k) { if (k + 2 < rpw) WQ_LOAD(vc, r0 + k + 2);
        const unsigned w[8] = {va[0].x, va[0].y, va[0].z, va[0].w, va[1].x, va[1].y, va[1].z, va[1].w}; float f[16]; float am = 0.f;
#pragma unroll
        for (int j = 0; j < 8; ++j) { f[2 * j] = __uint_as_float(w[j] << 16); f[2 * j + 1] = __uint_as_float(w[j] & 0xffff0000u); am = fmaxf(am, fmaxf(fabsf(f[2 * j]), fabsf(f[2 * j + 1]))); }
#pragma unroll
        for (int o = 1; o < 64; o <<= 1) am = fmaxf(am, __shfl_xor(am, o));
        const float inv = am > 0.f ? 127.f / am : 0.f; unsigned o4[4];
#pragma unroll
        for (int j = 0; j < 4; ++j) { const int q0 = __float2int_rn(f[4 * j] * inv), q1 = __float2int_rn(f[4 * j + 1] * inv), q2 = __float2int_rn(f[4 * j + 2] * inv), q3 = __float2int_rn(f[4 * j + 3] * inv);
            o4[j] = (unsigned)(q0 & 255) | ((unsigned)(q1 & 255) << 8) | ((unsigned)(q2 & 255) << 16) | ((unsigned)(q3 & 255) << 24); }
        *(uint4*)(WQ + (size_t)(r0 + k) * 1024 + 16 * lane) = make_uint4(o4[0], o4[1], o4[2], o4[3]);
        if (lane == 0) WS[r0 + k] = am * (1.f / 127.f);
        va[0] = vb[0]; va[1] = vb[1]; vb[0] = vc[0]; vb[1] = vc[1]; }
#undef WQ_LOAD
}
typedef short rt_bf16x8 __attribute__((ext_vector_type(8)));
typedef float rt_f32x4 __attribute__((ext_vector_type(4)));
typedef unsigned rt_u32x4 __attribute__((ext_vector_type(4)));
typedef float rt_f32x2 __attribute__((ext_vector_type(2))); typedef __bf16 rt_bf16x2 __attribute__((ext_vector_type(2)));
__device__ __forceinline__ unsigned rt_pk(float lo, float hi) { const rt_f32x2 v = {lo, hi}; const rt_bf16x2 b = __builtin_convertvector(v, rt_bf16x2); return __builtin_bit_cast(unsigned, b); }
__device__ __forceinline__ void ph_route_a(const P& p, int bid, int nb, float* ldsf) {
    typedef __attribute__((address_space(3))) unsigned char lds_b;
    lds_b* lds = (lds_b*)ldsf;
    const int tid = threadIdx.x, lane = tid & 63, wave = tid >> 6, gw = bid * 8 + wave;
    const int rpw = 16; const int r0 = gw * rpw, b = (bid * 8 * rpw) / SEQ;
    const float* rw = p.in[24]; const float* g = p.in[7]; const float* mod = (const float*)(p.ws + WS_MOD); const bf16* XM = (const bf16*)(p.ws + WS_XM);
    signed char* H2 = (signed char*)(p.ws + WS_H2); float* H2S = (float*)(p.ws + WS_H2S); int* TOPI = (int*)(p.ws + WS_TOPI); float* TOPG = (float*)(p.ws + WS_TOPG); int* WCNT = (int*)(p.ws + WS_WCNT);
    float* ggs = ldsf + 32768 + 2048; float* shs = ggs + 1024; float* biasp = ldsf + 32768 + 512; float* red = ldsf + 32768 + 1024;
    if (bid == 0) { for (int i = tid; i < 256; i += 512) ((unsigned*)(H2 + (size_t)T * DM))[i] = 0u; if (tid == 0) H2S[T] = 0.f; }
    for (int c = tid; c < 1024; c += 512) { ggs[c] = g[c] * (1.f + mod[b * NMOD + 4096 + c]); shs[c] = mod[b * NMOD + 3072 + c]; }
    __syncthreads();
    { const int e = tid & 31, part = tid >> 5;
      float a = 0.f;
#pragma unroll
      for (int k = part * 64; k < part * 64 + 64; ++k) a += shs[k] * rw[k * 32 + e];
      red[part * 32 + e] = a; }
#pragma unroll 4
    for (int it = tid; it < 4096; it += 512) { const int e = it & 31, c = it >> 5;
        float w[8];
#pragma unroll
        for (int j = 0; j < 8; ++j) w[j] = rw[(8 * c + j) * 32 + e] * ggs[8 * c + j];
        unsigned hi[4], lo[4];
#pragma unroll
        for (int j = 0; j < 4; ++j) { hi[j] = rt_pk(w[2 * j], w[2 * j + 1]); lo[j] = rt_pk(w[2 * j] - __uint_as_float(hi[j] << 16), w[2 * j + 1] - __uint_as_float(hi[j] & 0xffff0000u)); }
        const int off = (e * 1024 + ((c ^ (e & 15)) << 3)) * 2;
        *(__attribute__((address_space(3))) rt_u32x4*)(lds + off) = (rt_u32x4){hi[0], hi[1], hi[2], hi[3]};
        *(__attribute__((address_space(3))) rt_u32x4*)(lds + 65536 + off) = (rt_u32x4){lo[0], lo[1], lo[2], lo[3]}; }
    __syncthreads();
    if (tid < 32) { float a = p.in[25][tid]; for (int q = 0; q < 16; ++q) a += red[q * 32 + tid]; biasp[tid] = a; }
    __syncthreads();
    const int r = lane & 15, kq = lane >> 4;
    const bf16* xp = XM + (size_t)(r0 + r) * DM + 8 * kq;
    rt_f32x4 acc0 = {0.f, 0.f, 0.f, 0.f}, acc1 = {0.f, 0.f, 0.f, 0.f}; float ss = 0.f;
    rt_u32x4 xwa[32];
#pragma unroll
    for (int ks = 0; ks < 32; ++ks) xwa[ks] = *(const rt_u32x4*)(xp + 32 * ks);
#pragma unroll
    for (int ks = 0; ks < 32; ++ks) {
        const rt_u32x4 xw = xwa[ks];
#pragma unroll
        for (int j = 0; j < 4; ++j) { const float a0 = __uint_as_float(xw[j] << 16), a1 = __uint_as_float(xw[j] & 0xffff0000u); ss += a0 * a0 + a1 * a1; }
        const rt_bf16x8 Ah = __builtin_bit_cast(rt_bf16x8, xw);
        const int c = 4 * ks + kq;
        const int o0 = (r * 1024 + ((c ^ r) << 3)) * 2, o1 = ((16 + r) * 1024 + ((c ^ r) << 3)) * 2;
        const rt_bf16x8 Bh0 = *(const __attribute__((address_space(3))) rt_bf16x8*)(lds + o0), Bl0 = *(const __attribute__((address_space(3))) rt_bf16x8*)(lds + 65536 + o0);
        const rt_bf16x8 Bh1 = *(const __attribute__((address_space(3))) rt_bf16x8*)(lds + o1), Bl1 = *(const __attribute__((address_space(3))) rt_bf16x8*)(lds + 65536 + o1);
        acc0 = __builtin_amdgcn_mfma_f32_16x16x32_bf16(Ah, Bh0, acc0, 0, 0, 0); acc1 = __builtin_amdgcn_mfma_f32_16x16x32_bf16(Ah, Bh1, acc1, 0, 0, 0);
        acc0 = __builtin_amdgcn_mfma_f32_16x16x32_bf16(Ah, Bl0, acc0, 0, 0, 0); acc1 = __builtin_amdgcn_mfma_f32_16x16x32_bf16(Ah, Bl1, acc1, 0, 0, 0);
    }
    ss += __shfl_xor(ss, 16); ss += __shfl_xor(ss, 32);
    const float rs = 1.f / sqrtf(ss * (1.f / DM) + EPS);
    const int e0 = r, e1 = 16 + r; const float bp0 = biasp[e0], bp1 = biasp[e1];
    float lg0[4], lg1[4];
#pragma unroll
    for (int q = 0; q < 4; ++q) { const float rst = __shfl(rs, 4 * kq + q); lg0[q] = acc0[q] * rst + bp0; lg1[q] = acc1[q] * rst + bp1; }
    float tv[4][4]; int ti[4][4]; int cnt0 = 0, cnt1 = 0;
#pragma unroll
    for (int k = 0; k < 4; ++k) {
#pragma unroll
        for (int q = 0; q < 4; ++q) { float m = lg0[q]; int mi = e0; if (lg1[q] > m) { m = lg1[q]; mi = e1; }
#pragma unroll
            for (int off = 1; off < 16; off <<= 1) { const float om = __shfl_xor(m, off); const int oi = __shfl_xor(mi, off); if (om > m || (om == m && oi < mi)) { m = om; mi = oi; } }
            tv[k][q] = m; ti[k][q] = mi; if (mi == e0) { lg0[q] = -INFINITY; ++cnt0; } if (mi == e1) { lg1[q] = -INFINITY; ++cnt1; } } }
    if (r == 0) {
#pragma unroll
        for (int q = 0; q < 4; ++q) { const int t = r0 + 4 * kq + q; const float x1 = expf(tv[1][q] - tv[0][q]), x2 = expf(tv[2][q] - tv[0][q]), x3 = expf(tv[3][q] - tv[0][q]); const float inv = 1.f / (1.f + x1 + x2 + x3);
            *(int4*)(TOPI + t * 4) = make_int4(ti[0][q], ti[1][q], ti[2][q], ti[3][q]); *(float4*)(TOPG + t * 4) = make_float4(inv, x1 * inv, x2 * inv, x3 * inv); } }
    cnt0 += __shfl_xor(cnt0, 16); cnt0 += __shfl_xor(cnt0, 32); cnt1 += __shfl_xor(cnt1, 16); cnt1 += __shfl_xor(cnt1, 32);
    if (kq == 0) { WCNT[gw * 32 + e0] = cnt0; WCNT[gw * 32 + e1] = cnt1; }
    { float4 gf[4], sf[4]; uint2 va[16][4];
      const bf16* x0 = XM + (size_t)r0 * DM;
#pragma unroll
      for (int k = 0; k < 16; ++k)
#pragma unroll
          for (int j = 0; j < 4; ++j) va[k][j] = ((const uint2*)(x0 + (size_t)k * DM))[lane + 64 * j];
#pragma unroll
      for (int j = 0; j < 4; ++j) { gf[j] = *(const float4*)(ggs + 4 * lane + 256 * j); sf[j] = *(const float4*)(shs + 4 * lane + 256 * j); }
#pragma unroll
      for (int k = 0; k < 16; ++k) {
          const float rk = __shfl(rs, k); float h[4][4]; float am = 0.f;
#pragma unroll
          for (int j = 0; j < 4; ++j) { const uint2 v = va[k][j]; const float a0 = __uint_as_float(v.x << 16), a1 = __uint_as_float(v.x & 0xffff0000u), a2 = __uint_as_float(v.y << 16), a3 = __uint_as_float(v.y & 0xffff0000u);
              h[j][0] = a0 * rk * gf[j].x + sf[j].x; h[j][1] = a1 * rk * gf[j].y + sf[j].y; h[j][2] = a2 * rk * gf[j].z + sf[j].z; h[j][3] = a3 * rk * gf[j].w + sf[j].w;
              am = fmaxf(fmaxf(am, fmaxf(fabsf(h[j][0]), fabsf(h[j][1]))), fmaxf(fabsf(h[j][2]), fabsf(h[j][3]))); }
#pragma unroll
          for (int o = 1; o < 64; o <<= 1) am = fmaxf(am, __shfl_xor(am, o));
          const float inv = am > 0.f ? 127.f / am : 0.f;
#pragma unroll
          for (int j = 0; j < 4; ++j) { const int q0 = __float2int_rn(h[j][0] * inv), q1 = __float2int_rn(h[j][1] * inv), q2 = __float2int_rn(h[j][2] * inv), q3 = __float2int_rn(h[j][3] * inv);
              *(unsigned*)(H2 + (size_t)(r0 + k) * DM + 4 * lane + 256 * j) = (unsigned)(q0 & 255) | ((unsigned)(q1 & 255) << 8) | ((unsigned)(q2 & 255) << 16) | ((unsigned)(q3 & 255) << 24); }
          if (lane == 0) H2S[r0 + k] = am * (1.f / 127.f); }
    }
    __syncthreads();
    int* li = (int*)ldsf; if (kq == 0) { li[wave * 32 + e0] = cnt0; li[wave * 32 + e1] = cnt1; }
    __syncthreads();
    if (tid < 32) { int a = 0; for (int w = 0; w < 8; ++w) a += li[w * 32 + tid]; ((int*)(p.ws + WS_BCNT))[bid * 32 + tid] = a; }
}
__device__ __forceinline__ void ph_route_b(const P& p, int bid, int nb, int* ldsI) {
    int* partT = ldsI; int* partB = ldsI + 512; int* total = ldsI + 1024; int* before = ldsI + 1056; int* pstart = ldsI + 1088;
    const int* WCNT = (const int*)(p.ws + WS_WCNT); const int* TOPI = (const int*)(p.ws + WS_TOPI); const float* TOPG = (const float*)(p.ws + WS_TOPG);
    int* SLOT_TOK = (int*)(p.ws + WS_SLOTTOK); float* SLOT_GATE = (float*)(p.ws + WS_SLOTGATE); int* TOK_SLOT = (int*)(p.ws + WS_TOKSLOT); int* TILE_E = (int*)(p.ws + WS_TILE);
    const float* H2S = (const float*)(p.ws + WS_H2S); float* SLOT_SA = (float*)(p.ws + WS_SLOTSA);
    const int t = threadIdx.x, e = t & 31, part = t >> 5, gw0 = bid * 8, nwav = nb * 8, per = nb / 16;
    const int* BCNT = (const int*)(p.ws + WS_BCNT);
    int sT = 0, sB = 0;
    { int c[16];
#pragma unroll
      for (int q = 0; q < 16; ++q) c[q] = (q < per) ? BCNT[(part * per + q) * 32 + e] : 0;
#pragma unroll
      for (int q = 0; q < 16; ++q) { sT += c[q]; if (part * per + q < bid) sB += c[q]; } }
    partT[part * 32 + e] = sT; partB[part * 32 + e] = sB;
    __syncthreads();
    if (t < 32) { int a = 0, bsum = 0; for (int q = 0; q < 16; ++q) { a += partT[q * 32 + t]; bsum += partB[q * 32 + t]; } total[t] = a; before[t] = bsum; }
    __syncthreads();
    if (t == 0) { int acc = 0; for (int q = 0; q < 32; ++q) { pstart[q] = acc; acc += ((total[q] + 255) / 256) * 256; } pstart[32] = acc; }
    __syncthreads();
    const int lane = t & 63, wave = t >> 6, my_e = (lane >> 1) & 31, rpw = T / nwav;
    int base = pstart[my_e] + before[my_e];
    for (int w = 0; w < wave; ++w) base += WCNT[(gw0 + w) * 32 + my_e];
    int run = 0;
    const int rb0 = (gw0 + wave) * rpw;
    for (int r8 = 0; r8 < rpw; r8 += 8) { int4 tiv[8]; float4 tgv[8]; float sav[8];
#pragma unroll
        for (int q = 0; q < 8; ++q) { tiv[q] = *(const int4*)(TOPI + (rb0 + r8 + q) * 4); tgv[q] = *(const float4*)(TOPG + (rb0 + r8 + q) * 4); sav[q] = H2S[rb0 + r8 + q]; }
#pragma unroll
        for (int q = 0; q < 8; ++q) { const int r = rb0 + r8 + q;
            const int tia[4] = {tiv[q].x, tiv[q].y, tiv[q].z, tiv[q].w}; const float tga[4] = {tgv[q].x, tgv[q].y, tgv[q].z, tgv[q].w}; int sl[4];
#pragma unroll
            for (int k = 0; k < 4; ++k) { const int ek = tia[k]; sl[k] = __shfl(base + run, 2 * ek); if (my_e == ek) run++; }
            if (lane == 0) { SLOT_TOK[sl[0]] = r; SLOT_TOK[sl[1]] = r; SLOT_TOK[sl[2]] = r; SLOT_TOK[sl[3]] = r;
                SLOT_GATE[sl[0]] = tga[0]; SLOT_GATE[sl[1]] = tga[1]; SLOT_GATE[sl[2]] = tga[2]; SLOT_GATE[sl[3]] = tga[3]; *(int4*)(TOK_SLOT + r * 4) = make_int4(sl[0], sl[1], sl[2], sl[3]);
                SLOT_SA[sl[0]] = sav[q]; SLOT_SA[sl[1]] = sav[q]; SLOT_SA[sl[2]] = sav[q]; SLOT_SA[sl[3]] = sav[q]; } }
    }
    if (bid == 0) {
        for (int q = wave; q < 32; q += 8) { const int ps = pstart[q], pe = pstart[q + 1];
            for (int s = ps + total[q] + lane; s < pe; s += 64) { SLOT_TOK[s] = T; SLOT_GATE[s] = 0.f; SLOT_SA[s] = 0.f; }
            for (int tl = ps / 256 + lane; tl < pe / 256; tl += 64) TILE_E[tl] = q; }
        if (t == 0) TILE_E[1023] = pstart[32] / 256;
    }
}
__device__ __forceinline__ void ph_final(const P& p, int bid, int nb) {
    const int lane = threadIdx.x & 63, wave = threadIdx.x >> 6, gw = bid * 8 + wave, ngw = nb * 8;
    const float* gfin = p.in[30]; const float* mod = (const float*)(p.ws + WS_MOD); const bf16* XM = (const bf16*)(p.ws + WS_XM);
    const bf16* YB = (const bf16*)(p.ws + WS_YB); const int* TOK_SLOT = (const int*)(p.ws + WS_TOKSLOT);
    float4 gf[4];
#pragma unroll
    for (int j = 0; j < 4; ++j) gf[j] = *(const float4*)(gfin + 4 * lane + 256 * j);
    uint2 yc[4][4], yn[4][4], ym[4][4]; uint2 xc[4], xn[4], xm[4]; float4 gc[4], gn[4], gm[4]; int4 sl1, sl2;
#define FIN_LOAD(Y, X, GG, SL, R) do { const int sla_[4] = {SL.x, SL.y, SL.z, SL.w}; const int b_ = (R) / SEQ; _Pragma("unroll") for (int j = 0; j < 4; ++j) { const int col = 4 * lane + 256 * j; \
        { typedef unsigned fin_u32x2 __attribute__((ext_vector_type(2))); const fin_u32x2 w_ = __builtin_nontemporal_load((const fin_u32x2*)(XM + (size_t)(R) * DM + col)); X[j] = make_uint2(w_[0], w_[1]); } GG[j] = *(const float4*)(mod + b_ * NMOD + 5120 + col); _Pragma("unroll") for (int k = 0; k < 4; ++k) { typedef unsigned fin_u32x2 __attribute__((ext_vector_type(2))); const fin_u32x2 w_ = __builtin_nontemporal_load((const fin_u32x2*)(YB + (size_t)sla_[k] * DM + col)); Y[k][j] = make_uint2(w_[0], w_[1]); } } } while (0)
    int r = gw;
#define FIN_CL(q) (((q) < T) ? (q) : r)
    sl1 = *(const int4*)(TOK_SLOT + r * 4);
    FIN_LOAD(yc, xc, gc, sl1, r);
    { const int r1 = FIN_CL(r + ngw); sl1 = *(const int4*)(TOK_SLOT + r1 * 4); FIN_LOAD(yn, xn, gn, sl1, r1); }
    sl1 = *(const int4*)(TOK_SLOT + FIN_CL(r + 2 * ngw) * 4);
    for (; r < T; r += ngw) {
        const int r2 = FIN_CL(r + 2 * ngw), r3 = FIN_CL(r + 3 * ngw);
        sl2 = *(const int4*)(TOK_SLOT + r3 * 4);
        FIN_LOAD(ym, xm, gm, sl1, r2);
        float4 v[4]; float ss = 0.f;
#pragma unroll
        for (int j = 0; j < 4; ++j) { float f0 = 0.f, f1 = 0.f, f2 = 0.f, f3 = 0.f;
#pragma unroll
            for (int k = 0; k < 4; ++k) { const uint2 y = yc[k][j];
                f0 += __uint_as_float(y.x << 16); f1 += __uint_as_float(y.x & 0xffff0000u); f2 += __uint_as_float(y.y << 16); f3 += __uint_as_float(y.y & 0xffff0000u); }
            const float4 g2 = gc[j];
            v[j].x = __uint_as_float(xc[j].x << 16) + g2.x * f0; v[j].y = __uint_as_float(xc[j].x & 0xffff0000u) + g2.y * f1; v[j].z = __uint_as_float(xc[j].y << 16) + g2.z * f2; v[j].w = __uint_as_float(xc[j].y & 0xffff0000u) + g2.w * f3;
            ss += v[j].x * v[j].x + v[j].y * v[j].y + v[j].z * v[j].z + v[j].w * v[j].w; }
        ss = wave_sum(ss); const float rs = 1.f / sqrtf(ss * (1.f / DM) + EPS);
#pragma unroll
        for (int j = 0; j < 4; ++j) { const int col = 4 * lane + 256 * j;
            *(float4*)(p.out + (size_t)r * DM + col) = make_float4(v[j].x * rs * gf[j].x, v[j].y * rs * gf[j].y, v[j].z * rs * gf[j].z, v[j].w * rs * gf[j].w); }
#pragma unroll
        for (int j = 0; j < 4; ++j) { xc[j] = xn[j]; gc[j] = gn[j]; xn[j] = xm[j]; gn[j] = gm[j];
#pragma unroll
            for (int k = 0; k < 4; ++k) { yc[k][j] = yn[k][j]; yn[k][j] = ym[k][j]; } }
        sl1 = sl2;
    }
#undef FIN_CL
#undef FIN_LOAD
}

namespace pg8 {
#define PG8_LAS __attribute__((address_space(3)))
typedef unsigned short bf16_t;
typedef short bf16x8 __attribute__((ext_vector_type(8)));
typedef float f32x4 __attribute__((ext_vector_type(4)));
typedef unsigned u32x4 __attribute__((ext_vector_type(4)));
typedef int i32x4 __attribute__((ext_vector_type(4)));
typedef unsigned u32x2 __attribute__((ext_vector_type(2)));
template <bool I8> struct AccT { typedef f32x4 type; }; template <> struct AccT<true> { typedef i32x4 type; };
constexpr int BM = 256, BK = 64, HALF = 128, HTB = HALF * BK * 2  , STAGE_BYTES = 8 * HTB, NXCD = 8, WGM = 8;

__host__ __device__ __forceinline__ int lds_byte(int r, int c) { const int st = (r >> 4) * 2 + (c >> 5), rr = r & 15, cc = c & 31, ob = rr * 64 + cc * 2; return st * 1024 + (ob ^ (((ob >> 9) & 1) << 5)); }
__host__ __device__ __forceinline__ void stage_rc(int b, int& R, int& C) { const int st = b / 1024, sb = b % 1024, swz = sb ^ (((sb >> 9) & 1) << 5); R = (st >> 1) * 16 + swz / 64; C = (st & 1) * 32 + (swz % 64) / 2; }
__host__ __device__ __forceinline__ int perm32(int rho) { const int n = rho >> 4, i = rho & 15; return 8 * (i >> 2) + 4 * n + (i & 3); }

struct Unit { int pm, pn; };
struct GemmG { const char* A; const char* Bt; size_t a_kstep, a_hstep, a_tstep; int ldb; int K; const int* gidx; unsigned g_row; };
struct AoRow { int lda; __device__ __forceinline__ unsigned operator()(int R, int C) const { return (unsigned)(R * lda + C) * 2u; } };
struct AoGrp { __device__ __forceinline__ unsigned operator()(int R, int C) const { return (unsigned)(((C >> 4) * T + R) * 16 + (C & 15)) * 2u; } };

struct StaticOrder {
    int nM, nN, nwg, G, c;
    __host__ __device__ void init(int M, int N, int G_, int c_) { nM = M / BM; nN = N / BM; nwg = nM * nN; G = G_; c = c_; }
    __host__ __device__ bool next(int i, Unit& u) const {
        const long L = (long)i * G + c; if (L >= nwg) return false;
        int wgid = (int)L; { const int q = nwg / NXCD, r = nwg % NXCD, xcd = wgid % NXCD, off = wgid / NXCD; wgid = (xcd < r ? xcd * (q + 1) : r * (q + 1) + (xcd - r) * q) + off; }
        const int nig = WGM * nN, gid = wgid / nig, fm = gid * WGM, gsz = (nM - fm) < WGM ? (nM - fm) : WGM;
        u.pm = fm + ((wgid % nig) % gsz); u.pn = (wgid % nig) / gsz; return true;
    }
};
typedef float f32x2_t __attribute__((ext_vector_type(2))); typedef __bf16 bf16x2_t __attribute__((ext_vector_type(2)));
__device__ __forceinline__ unsigned cvt_pk_bf16(float lo, float hi) { const f32x2_t v = {lo, hi}; const bf16x2_t b = __builtin_convertvector(v, bf16x2_t); return __builtin_bit_cast(unsigned, b); }
__device__ __forceinline__ u32x4 pack8(const f32x4 a, const f32x4 b) { u32x4 w; w.x = cvt_pk_bf16(a[0], a[1]); w.y = cvt_pk_bf16(a[2], a[3]); w.z = cvt_pk_bf16(b[0], b[1]); w.w = cvt_pk_bf16(b[2], b[3]); return w; }
__device__ __forceinline__ f32x4 unpack_lo(const u32x4 w) { return (f32x4){__uint_as_float(w.x << 16), __uint_as_float(w.x & 0xffff0000u), __uint_as_float(w.y << 16), __uint_as_float(w.y & 0xffff0000u)}; }
__device__ __forceinline__ f32x4 unpack_hi(const u32x4 w) { return (f32x4){__uint_as_float(w.z << 16), __uint_as_float(w.z & 0xffff0000u), __uint_as_float(w.w << 16), __uint_as_float(w.w & 0xffff0000u)}; }
__device__ __forceinline__ float fsig(float v) { return __builtin_amdgcn_rcpf(1.f + __builtin_amdgcn_exp2f(-1.4426950408889634f * v)); }
__device__ __forceinline__ f32x4 fsig4(const f32x4 v) { return (f32x4){fsig(v[0]), fsig(v[1]), fsig(v[2]), fsig(v[3])}; }

template <class Epi, class Sched, class AO, bool GATHER = false, bool ALIGN_EPI = true, bool I8 = false>
__device__ __forceinline__ void gemm_phase(PG8_LAS unsigned char* lds, const GemmG g, const AO& ao, const Sched& S, const Epi& E) {
    const int tid = threadIdx.x, wid = __builtin_amdgcn_readfirstlane(tid >> 6), lane = tid & 63, wr = wid >> 2, wc = wid & 3, fr = lane & 15, fq = lane >> 4;
    const int K = g.K, nt = K / BK;
    unsigned voffB[2]; unsigned oc[2][2], on[2][2]; int RA[2]; unsigned CA2[2];
#pragma unroll
    for (int i = 0; i < 2; ++i) { int R, C; stage_rc(tid * 16 + i * 8192, R, C); const int Rb = (R & ~31) + perm32(R & 31);
        voffB[i] = (unsigned)(Rb * g.ldb + C) * 2u; RA[i] = R; CA2[i] = (unsigned)C * 2u;
        if constexpr (!GATHER) { oc[0][i] = ao(R, C); oc[1][i] = oc[0][i] + (unsigned)g.a_hstep; on[0][i] = oc[0][i]; on[1][i] = oc[1][i]; } }
    const size_t kstepA = g.a_kstep, kstepB = (size_t)(BK * 2);
    const size_t hstepB = (size_t)HALF * g.ldb * 2, tstepB = 2 * hstepB;
    const unsigned ldsw = (unsigned)wid * 1024u;
    const int aoff = lds_byte(wr * 64 + fr, fq * 8), boff = lds_byte(wc * 32 + fr, fq * 8);
#define PG8_SA(b, h) (((b) * 2 + (h)) * HTB)
#define PG8_SB(b, h) ((4 + (b) * 2 + (h)) * HTB)
#define PG8_STAGE_B(bufoff, gbase) do { _Pragma("unroll") for (int _i = 0; _i < 2; ++_i) \
        __builtin_amdgcn_global_load_lds((const unsigned*)((const char*)(gbase) + voffB[_i]), (PG8_LAS unsigned*)(lds + (bufoff) + ldsw + _i * 8192), 16, 0, 0); } while (0)
#define PG8_STAGE_A(bufoff, gbase, OFFS, h) do { _Pragma("unroll") for (int _i = 0; _i < 2; ++_i) \
        __builtin_amdgcn_global_load_lds((const unsigned*)((const char*)(gbase) + OFFS[h][_i]), (PG8_LAS unsigned*)(lds + (bufoff) + ldsw + _i * 8192), 16, 0, 0); } while (0)
#define PG8_LDA(dst, b, h) do { _Pragma("unroll") for (int m = 0; m < 4; ++m) _Pragma("unroll") for (int k = 0; k < 2; ++k) dst[m][k] = *(const PG8_LAS bf16x8*)(lds + PG8_SA(b, h) + aoff + m * 2048 + k * 1024); } while (0)
#define PG8_LDB(dst, b, h) do { _Pragma("unroll") for (int n = 0; n < 2; ++n) _Pragma("unroll") for (int k = 0; k < 2; ++k) dst[n][k] = *(const PG8_LAS bf16x8*)(lds + PG8_SB(b, h) + boff + n * 2048 + k * 1024); } while (0)
#define PG8_MMA(ai, bj, At, Bt) do { __builtin_amdgcn_s_setprio(1); _Pragma("unroll") for (int m = 0; m < 4; ++m) _Pragma("unroll") for (int n = 0; n < 2; ++n) _Pragma("unroll") for (int k = 0; k < 2; ++k) { \
        if constexpr (I8) acc[ai][bj][m][n] = __builtin_bit_cast(acc_t, __builtin_amdgcn_mfma_i32_16x16x64_i8(__builtin_bit_cast(i32x4, Bt[n][k]), __builtin_bit_cast(i32x4, At[m][k]), __builtin_bit_cast(i32x4, acc[ai][bj][m][n]), 0, 0, 0)); \
        else acc[ai][bj][m][n] = __builtin_bit_cast(acc_t, __builtin_amdgcn_mfma_f32_16x16x32_bf16(Bt[n][k], At[m][k], __builtin_bit_cast(f32x4, acc[ai][bj][m][n]), 0, 0, 0)); } __builtin_amdgcn_s_setprio(0); } while (0)
#define PG8_WAIT_V(n) asm volatile("s_waitcnt vmcnt(" #n ")" ::: "memory")
#define PG8_WAIT_L(n) asm volatile("s_waitcnt lgkmcnt(" #n ")" ::: "memory")
#define PG8_BAR __builtin_amdgcn_s_barrier()
#define PG8_SCHED __builtin_amdgcn_sched_barrier(0)
#define PG8_GIDX(dst, u) do { _Pragma("unroll") for (int _h = 0; _h < 2; ++_h) _Pragma("unroll") for (int _i = 0; _i < 2; ++_i) \
        dst[_h][_i] = (unsigned)g.gidx[(u).pm * BM + _h * HALF + RA[_i]] * g.g_row + CA2[_i]; } while (0)
    Unit cur, nxt; int ui = 0;
    if (!S.next(0, cur)) return;
    typedef typename AccT<I8>::type acc_t;
    acc_t acc[2][2][4][2];
#pragma unroll
    for (int a = 0; a < 2; ++a)
#pragma unroll
        for (int b = 0; b < 2; ++b)
#pragma unroll
            for (int m = 0; m < 4; ++m)
#pragma unroll
                for (int n = 0; n < 2; ++n) acc[a][b][m][n] = (acc_t){0, 0, 0, 0};
    bf16x8 At[4][2], B0[2][2], B1[2][2];
    if constexpr (GATHER) { PG8_GIDX(oc, cur); }
    const char* cA = GATHER ? g.A : g.A + (size_t)cur.pm * g.a_tstep; const char* cB = g.Bt + (size_t)cur.pn * tstepB;
    PG8_STAGE_B(PG8_SB(0, 0), cB); PG8_STAGE_B(PG8_SB(0, 1), cB + hstepB); PG8_STAGE_A(PG8_SA(0, 0), cA, oc, 0); PG8_STAGE_A(PG8_SA(0, 1), cA, oc, 1);
    if (wr == 1) PG8_BAR;
    PG8_WAIT_V(2); PG8_BAR;
    PG8_STAGE_B(PG8_SB(1, 0), cB + kstepB); PG8_STAGE_A(PG8_SA(1, 0), cA + kstepA, oc, 0); PG8_STAGE_B(PG8_SB(1, 1), cB + hstepB + kstepB);
    PG8_WAIT_V(6); PG8_BAR;
    for (;;) {
        const bool has_next = S.next(ui + 1, nxt);
        if constexpr (GATHER) { if (has_next) { PG8_GIDX(on, nxt); } else {
#pragma unroll
            for (int _h = 0; _h < 2; ++_h)
#pragma unroll
                for (int _i = 0; _i < 2; ++_i) on[_h][_i] = oc[_h][_i]; } }
        const char* nA = GATHER ? g.A : (has_next ? g.A + (size_t)nxt.pm * g.a_tstep : cA); const char* nB = has_next ? g.Bt + (size_t)nxt.pn * tstepB : cB;
#pragma unroll 1
        for (int t = 0; t < nt; t += 2) {
            const bool last = (t == nt - 2);
            const char* a1 = cA + (size_t)(t + 1) * kstepA;
            const char* a2 = last ? nA : cA + (size_t)(t + 2) * kstepA; const char* b2 = last ? nB : cB + (size_t)(t + 2) * kstepB;
            const char* a3 = a2 + kstepA; const char* b3 = b2 + kstepB;
            unsigned o2[2][2];
#pragma unroll
            for (int _h = 0; _h < 2; ++_h)
#pragma unroll
                for (int _i = 0; _i < 2; ++_i) o2[_h][_i] = (GATHER && last) ? on[_h][_i] : oc[_h][_i];
            PG8_LDB(B0, 0, 0); PG8_LDB(B1, 0, 1); PG8_SCHED; PG8_LDA(At, 0, 0); PG8_STAGE_A(PG8_SA(1, 1), a1, oc, 1);
            PG8_WAIT_V(8); PG8_WAIT_L(0); PG8_BAR; PG8_MMA(0, 0, At, B0); PG8_MMA(0, 1, At, B1); PG8_BAR; PG8_SCHED;
            PG8_LDA(At, 0, 1); PG8_STAGE_B(PG8_SB(0, 0), b2); PG8_STAGE_B(PG8_SB(0, 1), b2 + hstepB); PG8_STAGE_A(PG8_SA(0, 0), a2, o2, 0);
            PG8_WAIT_V(8); PG8_WAIT_L(0); PG8_BAR; PG8_MMA(1, 0, At, B0); PG8_MMA(1, 1, At, B1); PG8_BAR; PG8_SCHED;
            PG8_LDB(B0, 1, 0); PG8_LDB(B1, 1, 1); PG8_SCHED; PG8_LDA(At, 1, 0); PG8_STAGE_A(PG8_SA(0, 1), a2, o2, 1);
            PG8_WAIT_V(8); PG8_WAIT_L(0); PG8_BAR; PG8_MMA(0, 0, At, B0); PG8_MMA(0, 1, At, B1); PG8_BAR; PG8_SCHED;
            PG8_LDA(At, 1, 1); PG8_STAGE_B(PG8_SB(1, 0), b3); PG8_STAGE_B(PG8_SB(1, 1), b3 + hstepB); PG8_STAGE_A(PG8_SA(1, 0), a3, o2, 0);
            PG8_WAIT_V(8); PG8_WAIT_L(0); PG8_BAR; PG8_MMA(1, 0, At, B0); PG8_MMA(1, 1, At, B1); PG8_BAR; PG8_SCHED;
        }
        if constexpr (ALIGN_EPI) { if (wr == 0) PG8_BAR; }
        E(acc, cur, wr, wc, fr, fq);
        if (!has_next) break;
#pragma unroll
        for (int a = 0; a < 2; ++a)
#pragma unroll
            for (int b = 0; b < 2; ++b)
#pragma unroll
                for (int m = 0; m < 4; ++m)
#pragma unroll
                    for (int n = 0; n < 2; ++n) acc[a][b][m][n] = (acc_t){0, 0, 0, 0};
        cur = nxt; cA = nA; cB = nB; ++ui;
#pragma unroll
        for (int _h = 0; _h < 2; ++_h)
#pragma unroll
            for (int _i = 0; _i < 2; ++_i) oc[_h][_i] = on[_h][_i];
        if constexpr (ALIGN_EPI) { if (wr == 1) PG8_BAR; }
    }
    PG8_WAIT_V(0);
    if constexpr (!ALIGN_EPI) { if (wr == 0) PG8_BAR; }
    PG8_BAR;
#undef PG8_SA
#undef PG8_SB
#undef PG8_STAGE_A
#undef PG8_STAGE_B
#undef PG8_LDA
#undef PG8_LDB
#undef PG8_MMA
#undef PG8_WAIT_V
#undef PG8_WAIT_L
#undef PG8_BAR
#undef PG8_SCHED
#undef PG8_GIDX
}

#define EPI_ROWS(ai, m) (u.pm * BM + (ai) * HALF + wr * 64 + (m) * 16 + fr)
struct EpiProj {
    bf16_t* UH; bf16_t* KB; bf16_t* VB; bf16_t* QB; unsigned char* GT; const float* qg; const float* kg; const float* rope; const float* sa; const float* sb;
    __device__ __forceinline__ void operator()(const i32x4 (&acci)[2][2][4][2], const Unit& u, int wr, int wc, int fr, int fq) const {
        asm volatile("" : "+v"(fr), "+v"(fq));
        const int pn = u.pn;
        const float* sbp = sb + pn * BM + wc * 32 + 8 * fq;
        float sar[2][4]; f32x4 sbv[2][2];
#pragma unroll
        for (int ai = 0; ai < 2; ++ai)
#pragma unroll
            for (int m = 0; m < 4; ++m) sar[ai][m] = sa[EPI_ROWS(ai, m)];
#pragma unroll
        for (int bj = 0; bj < 2; ++bj)
#pragma unroll
            for (int n = 0; n < 2; ++n) sbv[bj][n] = *(const f32x4*)(sbp + bj * HALF + 4 * n);
#define ACCF(ai, bj, m, n) (__builtin_convertvector(acci[ai][bj][m][n], f32x4) * (sbv[bj][n] * sa_r))
        if (pn < 2) {
#pragma unroll
            for (int ai = 0; ai < 2; ++ai)
#pragma unroll
                for (int m = 0; m < 4; ++m) { const int row = EPI_ROWS(ai, m); const float sa_r = sar[ai][m];
#pragma unroll
                    for (int bj = 0; bj < 2; ++bj) { const int c0 = pn * 256 + bj * 128 + wc * 32 + 8 * fq;
                        *(u32x4*)(UH + ((size_t)(c0 >> 4) * NCHUNK_PAD + (row >> 4)) * 512 + (row & 15) * 16 + (c0 & 15)) = pack8(ACCF(ai, bj, m, 0), ACCF(ai, bj, m, 1)); } }
        } else if (pn < 5) {
            const bool isq = pn >= 3, isv = (pn == 2) && (wc >= 2), lat = u.pm < (T / BM);
            const float* gn = isq ? qg : kg;
            const float osc = isq ? C2 : 1.f;
#pragma unroll
            for (int ai = 0; ai < 2; ++ai)
#pragma unroll
                for (int m = 0; m < 4; ++m) { const int row = EPI_ROWS(ai, m); const float sa_r = sar[ai][m];
                    int b, spos; if (lat) { b = row >> 13; spos = LC + (row & (SEQ - 1)); } else { const int rr = row - T; b = rr >> 8; spos = rr & (LC - 1); }
                    if (isv) {
                        bf16_t* o = VB + ((size_t)(b * 2 + (wc - 2)) * SKV + spos) * 64 + 8 * fq;
#pragma unroll
                        for (int bj = 0; bj < 2; ++bj) *(u32x4*)(o + 32 * bj) = pack8(ACCF(ai, bj, m, 0), ACCF(ai, bj, m, 1));
                    } else {
                        float ss = 0.f;
#pragma unroll
                        for (int bj = 0; bj < 2; ++bj)
#pragma unroll
                            for (int n = 0; n < 2; ++n) { const f32x4 x = ACCF(ai, bj, m, n); ss += (x[0] * x[0] + x[1] * x[1]) + (x[2] * x[2] + x[3] * x[3]); }
                        ss += __shfl_xor(ss, 16); ss += __shfl_xor(ss, 32);
                        const float rs = osc / sqrtf(ss * (1.f / 64.f) + EPS);
                        bf16_t* o = isq ? QB + (size_t)row * 512 + (4 * (pn - 3) + wc) * 64 + 8 * fq : KB + ((size_t)(b * 2 + wc) * SKV + spos) * 64 + 8 * fq;
                        const int t = row & (SEQ - 1), rid = t >> 6, cid = t & 63;
#pragma unroll
                        for (int bj = 0; bj < 2; ++bj) {
                            const f32x4 gv0 = *(const f32x4*)(gn + 32 * bj + 8 * fq), gv1 = *(const f32x4*)(gn + 32 * bj + 8 * fq + 4);
                            f32x4 y0 = ACCF(ai, bj, m, 0) * gv0 * rs, y1 = ACCF(ai, bj, m, 1) * gv1 * rs;
                            if (lat) { const float* rp = rope + (bj == 0 ? rid * 16 : 4096 + cid * 16) + 4 * fq; const f32x4 cs = *(const f32x4*)rp, sn = *(const f32x4*)(rp + (bj == 0 ? 2048 : 1024));
                                const f32x4 z0 = (f32x4){y0[0] * cs[0] - y0[1] * sn[0], y0[0] * sn[0] + y0[1] * cs[0], y0[2] * cs[1] - y0[3] * sn[1], y0[2] * sn[1] + y0[3] * cs[1]};
                                const f32x4 z1 = (f32x4){y1[0] * cs[2] - y1[1] * sn[2], y1[0] * sn[2] + y1[1] * cs[2], y1[2] * cs[3] - y1[3] * sn[3], y1[2] * sn[3] + y1[3] * cs[3]};
                                y0 = z0; y1 = z1; }
                            *(u32x4*)(o + 32 * bj) = pack8(y0, y1); }
                    } }
        } else {
#pragma unroll
            for (int ai = 0; ai < 2; ++ai)
#pragma unroll
                for (int m = 0; m < 4; ++m) { const int row = EPI_ROWS(ai, m); const float sa_r = sar[ai][m];
#pragma unroll
                    for (int bj = 0; bj < 2; ++bj)
                        { const f32x4 s0 = fsig4(ACCF(ai, bj, m, 0)) * 255.f, s1 = fsig4(ACCF(ai, bj, m, 1)) * 255.f;
                          u32x2 w; w.x = (unsigned)__float2int_rn(s0[0]) | ((unsigned)__float2int_rn(s0[1]) << 8) | ((unsigned)__float2int_rn(s0[2]) << 16) | ((unsigned)__float2int_rn(s0[3]) << 24);
                          w.y = (unsigned)__float2int_rn(s1[0]) | ((unsigned)__float2int_rn(s1[1]) << 8) | ((unsigned)__float2int_rn(s1[2]) << 16) | ((unsigned)__float2int_rn(s1[3]) << 24);
                          *(u32x2*)(GT + (size_t)row * 2048 + (pn - 5) * 256 + bj * 128 + wc * 32 + 8 * fq) = w; } }
        }
    }
#undef ACCF
};
struct EpiGlu {
    const bf16_t* SG; const float* bias; bf16_t* GO;
    __device__ __forceinline__ void operator()(const f32x4 (&acc)[2][2][4][2], const Unit& u, int wr, int wc, int fr, int fq) const {
#pragma unroll
        for (int bj = 0; bj < 2; ++bj) { const int c0 = u.pn * BM + bj * HALF + wc * 32 + 8 * fq;
            const f32x4 b0 = *(const f32x4*)(bias + c0), b1 = *(const f32x4*)(bias + c0 + 4);
            u32x4 sw[2][4];
#pragma unroll
            for (int ai = 0; ai < 2; ++ai)
#pragma unroll
                for (int m = 0; m < 4; ++m) sw[ai][m] = *(const u32x4*)(SG + ((size_t)(c0 >> 4) * T + EPI_ROWS(ai, m)) * 16 + (c0 & 15));
#pragma unroll
            for (int ai = 0; ai < 2; ++ai)
#pragma unroll
                for (int m = 0; m < 4; ++m) { const int row = EPI_ROWS(ai, m);
                    const f32x4 s0 = unpack_lo(sw[ai][m]), s1 = unpack_hi(sw[ai][m]);
                    *(u32x4*)(GO + (size_t)row * 1024 + c0) = pack8(s0 * fsig4(acc[ai][bj][m][0] + b0), s1 * fsig4(acc[ai][bj][m][1] + b1)); } }
    }
};
template <int MODE> struct EpiMerge {
    const unsigned char* GT; bf16_t* M1; bf16_t* MG;
    __device__ __forceinline__ void operator()(const f32x4 (&acc)[2][2][4][2], const Unit& u, int wr, int wc, int fr, int fq) const {
        u32x2 gw[2][4][2];
#pragma unroll
        for (int ai = 0; ai < 2; ++ai)
#pragma unroll
            for (int m = 0; m < 4; ++m)
#pragma unroll
                for (int bj = 0; bj < 2; ++bj) { const int c0 = u.pn * BM + bj * HALF + wc * 32 + 8 * fq; gw[ai][m][bj] = *(const u32x2*)(GT + (size_t)EPI_ROWS(ai, m) * 2048 + MODE * 1024 + c0); }
#pragma unroll
        for (int ai = 0; ai < 2; ++ai) { u32x4 aw[4][2];
            if (MODE == 1) {
#pragma unroll
                for (int m = 0; m < 4; ++m)
#pragma unroll
                    for (int bj = 0; bj < 2; ++bj) aw[m][bj] = *(const u32x4*)(M1 + (size_t)EPI_ROWS(ai, m) * 1024 + u.pn * BM + bj * HALF + wc * 32 + 8 * fq); }
#pragma unroll
            for (int m = 0; m < 4; ++m) { const int row = EPI_ROWS(ai, m);
#pragma unroll
                for (int bj = 0; bj < 2; ++bj) { const int c0 = u.pn * BM + bj * HALF + wc * 32 + 8 * fq; const u32x2 w = gw[ai][m][bj];
                    const f32x4 g0 = (f32x4){(float)(w.x & 255u), (float)((w.x >> 8) & 255u), (float)((w.x >> 16) & 255u), (float)(w.x >> 24)} * (1.f / 255.f);
                    const f32x4 g1 = (f32x4){(float)(w.y & 255u), (float)((w.y >> 8) & 255u), (float)((w.y >> 16) & 255u), (float)(w.y >> 24)} * (1.f / 255.f);
                    const f32x4 v0 = g0 * acc[ai][bj][m][0], v1 = g1 * acc[ai][bj][m][1];
                    if (MODE == 0) { *(u32x4*)(M1 + (size_t)row * 1024 + c0) = pack8(v0, v1); }
                    else { *(u32x4*)(MG + (size_t)row * 1024 + c0) = pack8(unpack_lo(aw[m][bj]) + v0, unpack_hi(aw[m][bj]) + v1); } } } }
    }
};
struct EpiOut {
    const float* x; const float* mod; bf16_t* XM;
    __device__ __forceinline__ void operator()(const f32x4 (&acc)[2][2][4][2], const Unit& u, int wr, int wc, int fr, int fq) const {
        const int b = (u.pm * BM) / SEQ; f32x4 gg[2][2];
#pragma unroll
        for (int bj = 0; bj < 2; ++bj) { const int c0 = u.pn * BM + bj * HALF + wc * 32 + 8 * fq; gg[bj][0] = *(const f32x4*)(mod + b * NMOD + 2048 + c0); gg[bj][1] = *(const f32x4*)(mod + b * NMOD + 2048 + c0 + 4); }
#define EO_BATCH(I0, I1) do { f32x4 xa[(I1) - (I0)][2]; \
        _Pragma("unroll") for (int it = (I0); it < (I1); ++it) { const int bj = it >> 3, ai = (it >> 2) & 1, m = it & 3; const size_t off = (size_t)EPI_ROWS(ai, m) * 1024 + u.pn * BM + bj * HALF + wc * 32 + 8 * fq; \
            xa[it - (I0)][0] = *(const f32x4*)(x + off); xa[it - (I0)][1] = *(const f32x4*)(x + off + 4); } \
        _Pragma("unroll") for (int it = (I0); it < (I1); ++it) { const int bj = it >> 3, ai = (it >> 2) & 1, m = it & 3; const int c0 = u.pn * BM + bj * HALF + wc * 32 + 8 * fq; const size_t off = (size_t)EPI_ROWS(ai, m) * 1024 + c0; \
            *(u32x4*)(XM + off) = pack8(xa[it - (I0)][0] + gg[bj][0] * acc[ai][bj][m][0], xa[it - (I0)][1] + gg[bj][1] * acc[ai][bj][m][1]); } } while (0)
        EO_BATCH(0, 6); EO_BATCH(6, 11); EO_BATCH(11, 16);
#undef EO_BATCH
    }
};
struct EpiGU {
    const float* bgu; bf16_t* ACT;
    __device__ __forceinline__ void operator()(const f32x4 (&acc)[2][2][4][2], const Unit& u, int wr, int wc, int fr, int fq) const {
        const int e = u.pn >> 3, jc = (u.pn & 7) * 128 + wc * 32 + 8 * fq; const float* bp = bgu + e * 2048 + jc;
        const f32x4 bg0 = *(const f32x4*)bp, bg1 = *(const f32x4*)(bp + 4), bu0 = *(const f32x4*)(bp + 1024), bu1 = *(const f32x4*)(bp + 1028);
#pragma unroll
        for (int ai = 0; ai < 2; ++ai)
#pragma unroll
            for (int m = 0; m < 4; ++m) { const int row = EPI_ROWS(ai, m); f32x4 o[2];
#pragma unroll
                for (int n = 0; n < 2; ++n) { const f32x4 gt = acc[ai][0][m][n] + (n ? bg1 : bg0), up = acc[ai][1][m][n] + (n ? bu1 : bu0);
#pragma unroll
                    for (int j = 0; j < 4; ++j) { const float gq = fminf(gt[j], 7.f), uq = fminf(fmaxf(up[j], -7.f), 7.f); o[n][j] = (uq + 1.f) * (gq * fsig(1.702f * gq)); } }
                *(u32x4*)(ACT + (size_t)row * 1024 + jc) = pack8(o[0], o[1]); }
    }
};
struct EpiGU8 {
    const float* bgu; const float* sa; const float* sb; bf16_t* ACT;
    __device__ __forceinline__ void operator()(const i32x4 (&acc)[2][2][4][2], const Unit& u, int wr, int wc, int fr, int fq) const {
        const int e = u.pn >> 3, jl = wc * 32 + 8 * fq, jc = (u.pn & 7) * 128 + jl; const float* bp = bgu + e * 2048 + jc; const float* sp = sb + e * 2048 + (u.pn & 7) * 256 + jl;
        const f32x4 bg0 = *(const f32x4*)bp, bg1 = *(const f32x4*)(bp + 4), bu0 = *(const f32x4*)(bp + 1024), bu1 = *(const f32x4*)(bp + 1028);
        const f32x4 sg0 = *(const f32x4*)sp, sg1 = *(const f32x4*)(sp + 4), su0 = *(const f32x4*)(sp + 128), su1 = *(const f32x4*)(sp + 132);
        float sr[2][4];
#pragma unroll
        for (int ai = 0; ai < 2; ++ai)
#pragma unroll
            for (int m = 0; m < 4; ++m) sr[ai][m] = sa[EPI_ROWS(ai, m)];
#pragma unroll
        for (int ai = 0; ai < 2; ++ai)
#pragma unroll
            for (int m = 0; m < 4; ++m) { const int row = EPI_ROWS(ai, m); f32x4 o[2];
#pragma unroll
                for (int n = 0; n < 2; ++n) { const f32x4 sg = (n ? sg1 : sg0) * sr[ai][m], su = (n ? su1 : su0) * sr[ai][m];
#pragma unroll
                    for (int j = 0; j < 4; ++j) { const float gt = (float)acc[ai][0][m][n][j] * sg[j] + (n ? bg1 : bg0)[j], up = (float)acc[ai][1][m][n][j] * su[j] + (n ? bu1 : bu0)[j];
                        const float gq = fminf(gt, 7.f), uq = fminf(fmaxf(up, -7.f), 7.f);
                        const float sw = gq * __builtin_amdgcn_rcpf(1.f + __builtin_amdgcn_exp2f(gq * (-1.702f * 1.4426950408889634f)));
                        o[n][j] = __builtin_fmaf(uq, sw, sw); } }
                *(u32x4*)(ACT + (size_t)row * 1024 + jc) = pack8(o[0], o[1]); }
    }
};
struct EpiDown {
    const float* bd; const float* sgate; bf16_t* YB;
    __device__ __forceinline__ void operator()(const f32x4 (&acc)[2][2][4][2], const Unit& u, int wr, int wc, int fr, int fq) const {
        const int e = u.pn >> 2; float gt[2][4]; f32x4 bb[2][2];
#pragma unroll
        for (int bj = 0; bj < 2; ++bj) { const float* bp = bd + e * 1024 + (u.pn & 3) * BM + bj * HALF + wc * 32 + 8 * fq; bb[bj][0] = *(const f32x4*)bp; bb[bj][1] = *(const f32x4*)(bp + 4); }
#pragma unroll
        for (int ai = 0; ai < 2; ++ai)
#pragma unroll
            for (int m = 0; m < 4; ++m) gt[ai][m] = sgate[EPI_ROWS(ai, m)];
#pragma unroll
        for (int ai = 0; ai < 2; ++ai)
#pragma unroll
            for (int m = 0; m < 4; ++m) { const int row = EPI_ROWS(ai, m);
#pragma unroll
                for (int bj = 0; bj < 2; ++bj) { const int c0 = (u.pn & 3) * BM + bj * HALF + wc * 32 + 8 * fq;
                    *(u32x4*)(YB + (size_t)row * 1024 + c0) = pack8((acc[ai][bj][m][0] + bb[bj][0]) * gt[ai][m], (acc[ai][bj][m][1] + bb[bj][1]) * gt[ai][m]); } }
    }
};
struct EpiSloc {
    bf16_t* SL;
    __device__ __forceinline__ void operator()(const f32x4 (&acc)[2][2][4][2], const Unit& u, int wr, int wc, int fr, int fq) const {
#pragma unroll
        for (int ai = 0; ai < 2; ++ai)
#pragma unroll
            for (int m = 0; m < 4; ++m) { const int row = EPI_ROWS(ai, m);
#pragma unroll
                for (int bj = 0; bj < 2; ++bj) *(u32x4*)(SL + (size_t)row * 256 + bj * HALF + wc * 32 + 8 * fq) = pack8(acc[ai][bj][m][0], acc[ai][bj][m][1]); }
    }
};
struct EpiS5Y {
    bf16_t* SG;
    __device__ __forceinline__ f32x4 gelu4(const f32x4 x) const { f32x4 r;
#pragma unroll
        for (int j = 0; j < 4; ++j) { const float v = x[j], u2 = 1.5957691216057308f * (v + 0.044715f * v * v * v); r[j] = v * fsig(u2); } return r; }
    __device__ __forceinline__ void operator()(const f32x4 (&acc)[2][2][4][2], const Unit& u, int wr, int wc, int fr, int fq) const {
        const int grp = u.pn, mt = u.pm - 9 * grp;
#pragma unroll
        for (int ai = 0; ai < 2; ++ai)
#pragma unroll
            for (int m = 0; m < 4; ++m) { const int chunk = mt * BM + ai * HALF + wr * 64 + m * 16 + fr;
#pragma unroll
                for (int bj = 0; bj < 2; ++bj) { const int col = bj * HALF + wc * 32 + 8 * fq; const int tok = chunk * 16 + (col >> 4);
                    *(u32x4*)(SG + ((size_t)grp * T + tok) * 16 + (col & 15)) = pack8(gelu4(acc[ai][bj][m][0]), gelu4(acc[ai][bj][m][1])); } }
    }
};
#undef EPI_ROWS
struct SchedProj {
    StaticOrder so; int G, c;
    __device__ void init(int G_, int c_) { so.init(T, DIN, G_, c_); G = G_; c = c_; }
    __device__ bool next(int i, Unit& u) const { const int L = i * G + c; if (L < so.nwg) return so.next(i, u); const int r = L - so.nwg; if (r >= 12) return false; u.pm = T / BM + r / 3; u.pn = r % 3; return true; }
};
struct SchedS5 {
    int mper, G, c;
    __device__ bool next(int i, Unit& u) const { const int L = i * G + c; if (L >= 32 * mper) return false; const int grp = L / mper; u.pm = 9 * grp + (L % mper); u.pn = grp; return true; }
};
struct SchedMoE {
    const PG8_LAS int* tile_e; int ntiles, nN, G, c, rev, TB;
    __device__ bool next(int i, Unit& u) const {
        const int x = c & 7, j = c >> 3, TA = 32 / TB;
        const int npg = nN / TB;
        const int pn = TB * (x % npg) + (j % TB);
        const int tile = (8 / npg) * TA * i + TA * (x / npg) + (j / TB);
        if (tile >= ntiles) return false;
        u.pm = rev ? ntiles - 1 - tile : tile; u.pn = tile_e[u.pm] * nN + pn; return true; }
};
}

#include <hip/hip_bf16.h>
#include <cmath>

namespace attn_body {
using bf16=__hip_bfloat16;
using bf16x8=__attribute__((ext_vector_type(8)))short;
using s16x4=__attribute__((ext_vector_type(4)))short;
using f32x16=__attribute__((ext_vector_type(16)))float;
using u32x4=__attribute__((ext_vector_type(4)))unsigned;
constexpr int D=64,QP=512,KP=64,OP=1024,ASEQ=8192,ASKV=8448;
constexpr int NW=8,QBLK=32,QB=QBLK*NW,KVBLK=64,NQB=ASEQ/QB;
constexpr int ATTN_UNIT_ROWS=QB;
__device__ __forceinline__ int crow(int r,int hi){return (r&3)+8*(r>>2)+4*hi;}
#define SBAR() __builtin_amdgcn_sched_barrier(0)
__device__ __forceinline__ void cmask(f32x16&p0,f32x16&p1,int jb,int qrel,int hi){
  const float NEG=-INFINITY; int kb=64*jb+4*hi;
  #pragma unroll
  for(int r=0;r<16;++r){int kv=kb+(r&3)+8*(r>>2); if(kv>qrel)p0[r]=NEG; if(kv+32>qrel)p1[r]=NEG;}
}

constexpr int NSLOT=3, SLOTB=8192;
constexpr int LDS_K=0, LDS_V=NSLOT*SLOTB, LDS_WS=2*NSLOT*SLOTB, LDS_OST=LDS_WS+NW*64*4, LDS_BYTES=LDS_OST+NW*4096;
constexpr float C2=0.125f*1.4426950408889634f;
__device__ __forceinline__ void glds16(const void*gsrc,unsigned lds_dst){unsigned keep;
  asm volatile("s_mov_b32 %0, m0\n\ts_mov_b32 m0, %2\n\ts_nop 0\n\tglobal_load_lds_dwordx4 %1, off\n\ts_mov_b32 m0, %0":"=&s"(keep):"v"(gsrc),"s"(lds_dst):"memory");}
__device__ __forceinline__ float max3f(float a,float b,float c){float r;asm("v_max3_f32 %0, %1, %2, %3":"=v"(r):"v"(a),"v"(b),"v"(c));return r;}
__device__ __forceinline__ float max2f(float a,float b){float r;asm("v_max_f32_e32 %0, %1, %2":"=v"(r):"v"(a),"v"(b));return r;}
__device__ __forceinline__ float fadd_s(float a,float b){float r;asm("v_add_f32_e32 %0, %1, %2":"=v"(r):"v"(a),"v"(b));return r;}
__device__ __forceinline__ float fsub_s(float a,float b){float r;asm("v_sub_f32_e32 %0, %1, %2":"=v"(r):"v"(a),"v"(b));return r;}
typedef float f32x2_t __attribute__((ext_vector_type(2))); typedef __bf16 bf16x2_t __attribute__((ext_vector_type(2)));
__device__ __forceinline__ unsigned cvtpk_s(float lo,float hi){f32x2_t v={lo,hi};bf16x2_t b=__builtin_convertvector(v,bf16x2_t);return __builtin_bit_cast(unsigned,b);}
#define WAIT_BAR(N) asm volatile("s_waitcnt vmcnt(" #N ") lgkmcnt(0)\n\ts_barrier":::"memory")

__device__ __forceinline__ void qkt(f32x16&p0,f32x16&p1,const char*Kslot,const bf16x8*qr,const f32x16&negm,int r32,int hi){
  const char*kb=Kslot+hi*1024+r32*16;
  #pragma unroll
  for(int d0=0;d0<4;++d0){
    const bf16x8 b0=*reinterpret_cast<const bf16x8*>(kb+d0*2048);
    const bf16x8 b1=*reinterpret_cast<const bf16x8*>(kb+d0*2048+512);
    if(d0==0){p0=__builtin_amdgcn_mfma_f32_32x32x16_bf16(b0,qr[0],negm,0,0,0);p1=__builtin_amdgcn_mfma_f32_32x32x16_bf16(b1,qr[0],negm,0,0,0);}
    else{p0=__builtin_amdgcn_mfma_f32_32x32x16_bf16(b0,qr[d0],p0,0,0,0);p1=__builtin_amdgcn_mfma_f32_32x32x16_bf16(b1,qr[d0],p1,0,0,0);}}
}
typedef __attribute__((address_space(3))) const char* lds_cptr;
typedef short v4i16_t __attribute__((ext_vector_type(4)));
__device__ __forceinline__ void kload8(bf16x8*kf,lds_cptr kp){
  kf[0]=*(const __attribute__((address_space(3))) bf16x8*)(kp);      kf[1]=*(const __attribute__((address_space(3))) bf16x8*)(kp+512);
  kf[2]=*(const __attribute__((address_space(3))) bf16x8*)(kp+2048); kf[3]=*(const __attribute__((address_space(3))) bf16x8*)(kp+2560);
  kf[4]=*(const __attribute__((address_space(3))) bf16x8*)(kp+4096); kf[5]=*(const __attribute__((address_space(3))) bf16x8*)(kp+4608);
  kf[6]=*(const __attribute__((address_space(3))) bf16x8*)(kp+6144); kf[7]=*(const __attribute__((address_space(3))) bf16x8*)(kp+6656);
}
__device__ __forceinline__ void kload2(bf16x8*kf,lds_cptr kp,int j){ kf[2*j]=*(const __attribute__((address_space(3))) bf16x8*)(kp+j*2048); kf[2*j+1]=*(const __attribute__((address_space(3))) bf16x8*)(kp+j*2048+512); }
__device__ __forceinline__ s16x4 vtr(lds_cptr p){ return __builtin_bit_cast(s16x4,__builtin_amdgcn_ds_read_tr16_b64_v4i16((__attribute__((address_space(3))) v4i16_t*)p)); }
__device__ __forceinline__ float rowmax(const f32x16&p0,const f32x16&p1){
  float a=max3f(p0[0],p0[1],p1[0]),b=max3f(p0[2],p0[3],p1[1]);a=max3f(a,p1[2],p1[3]);
  #pragma unroll
  for(int r=4;r<16;r+=4){a=max3f(a,p0[r],p0[r+1]);b=max3f(b,p0[r+2],p0[r+3]);a=max3f(a,p1[r],p1[r+1]);b=max3f(b,p1[r+2],p1[r+3]);}
  const float m=max2f(a,b);
  auto rr=__builtin_amdgcn_permlane32_swap(__float_as_uint(m),__float_as_uint(m),false,false);
  return max2f(__uint_as_float(rr[0]),__uint_as_float(rr[1]));
}
__device__ __forceinline__ void pv(f32x16*o,int vb,bf16x8 pa0,bf16x8 pa1,bf16x8 pa2,bf16x8 pa3){
  #pragma unroll
  for(int d0=0;d0<2;++d0){s16x4 lo[4],hi[4];
    #pragma unroll
    for(int ks=0;ks<4;++ks){
      asm volatile("ds_read_b64_tr_b16 %0,%1 offset:%c2":"=&v"(lo[ks]):"v"(vb),"i"(d0*4096+ks*1024):"memory");
      asm volatile("ds_read_b64_tr_b16 %0,%1 offset:%c2":"=&v"(hi[ks]):"v"(vb),"i"(d0*4096+ks*1024+512):"memory");}
    asm volatile("s_waitcnt lgkmcnt(0)":::"memory");SBAR();
    #define PK(k) (bf16x8){lo[k][0],lo[k][1],lo[k][2],lo[k][3],hi[k][0],hi[k][1],hi[k][2],hi[k][3]}
    o[d0]=__builtin_amdgcn_mfma_f32_32x32x16_bf16(pa0,PK(0),o[d0],0,0,0);
    o[d0]=__builtin_amdgcn_mfma_f32_32x32x16_bf16(pa1,PK(1),o[d0],0,0,0);
    o[d0]=__builtin_amdgcn_mfma_f32_32x32x16_bf16(pa2,PK(2),o[d0],0,0,0);
    o[d0]=__builtin_amdgcn_mfma_f32_32x32x16_bf16(pa3,PK(3),o[d0],0,0,0);
    #undef PK
  }
}

#ifndef ATTN_STORE16
#define ATTN_STORE16(p,v) (*(u32x4*)(p)=(v))
#endif
template<int THRL> __device__ __forceinline__ void attn_unit(int b,int h,int qb,const bf16*Q,const bf16*__restrict__ K,const bf16*__restrict__ V,bf16*O,char*shm,float mref){
  const int tid=threadIdx.x,lane=tid&63,r32=lane&31,hi=lane>>5; const int wid=__builtin_amdgcn_readfirstlane(tid>>6);
  const long rowbase=(long)b*ASEQ; const int q0=qb*QB;
  const bf16*Qw=Q+(rowbase+q0+wid*QBLK)*QP+h*D;
  const bf16*Kh=K+(long)(b*2+(h>>2))*ASKV*KP,*Vh=V+(long)(b*2+(h>>2))*ASKV*KP;
  const unsigned lds0=(unsigned)(uintptr_t)shm;
  float*wsf=(float*)(shm+LDS_WS)+wid*64;
  const bf16*ksrc=Kh+(long)lane*KP+wid*8;
  const bf16*vsrc=Vh+(long)(16*(wid&3)+(lane>>2))*KP+(wid>>2)*32+(lane&3)*8;
  const unsigned kdst=lds0+LDS_K+wid*1024, vdst=lds0+LDS_V+wid*1024;
  #define DMA_K(t,slot) glds16(ksrc+(long)(t)*KVBLK*KP,(unsigned)__builtin_amdgcn_readfirstlane(kdst+(slot)))
  #define DMA_V(t,slot) glds16(vsrc+(long)(t)*KVBLK*KP,(unsigned)__builtin_amdgcn_readfirstlane(vdst+(slot)))
  const int vb0=(int)(lds0+LDS_V)+((lane>>4)&1)*32+(lane&3)*8+(4*hi+((lane&15)>>2))*64;
  const char*Kbase=shm+LDS_K; bf16x8 kf[8];
  const lds_cptr shm3=(lds_cptr)shm; const lds_cptr kp0=shm3+LDS_K+hi*1024+r32*16; const lds_cptr vp0=shm3+LDS_V+((lane>>4)&1)*32+(lane&3)*8+(4*hi+((lane&15)>>2))*64;
  const int NT=ASKV/KVBLK;
  DMA_K(0,0);DMA_V(0,0);DMA_K(1,SLOTB);
  bf16x8 qr[4];
  #pragma unroll
  for(int d0=0;d0<4;++d0)qr[d0]=*reinterpret_cast<const bf16x8*>(&Qw[(long)r32*QP+d0*16+hi*8]);
  float l_reg=0.f;f32x16 o[2];o[0]=f32x16{};o[1]=f32x16{};f32x16 negm;
  _Pragma("unroll") for(int r=0;r<16;++r)negm[r]=-mref; asm volatile("":"+v"(negm));
  const int qrel=wid*QBLK+r32;
  #define CMASK(P0,P1,t) do{}while(0)
  #define START(P0,P1) do{ _Pragma("unroll") for(int r=0;r<16;++r)P0[r]=__builtin_amdgcn_exp2f(P0[r]); }while(0)
  #define RESC() do{}while(0)
  f32x16 pA0,pA1,pB0,pB1;
  int sl_prev=0,sl_cur=0,sl_next=SLOTB;
  #define ROT() do{sl_prev=sl_cur;sl_cur=sl_next;sl_next=(sl_next==(NSLOT-1)*SLOTB)?0:sl_next+SLOTB;}while(0)
  DMA_K(2,2*SLOTB);
  WAIT_BAR(3);
  qkt(pA0,pA1,Kbase,qr,negm,r32,hi);asm volatile("s_nop 15\n\ts_nop 7":"+v"(pA0),"+v"(pA1));CMASK(pA0,pA1,0);
  START(pA0,pA1);
  _Pragma("unroll") for(int r=0;r<16;++r)pA1[r]=__builtin_amdgcn_exp2f(pA1[r]);
  WAIT_BAR(0);
  DMA_K(3,0);DMA_V(1,SLOTB);
  ROT();
  kload8(kf,kp0+sl_cur);
  WAIT_BAR(2);
  s16x4 vlo[8],vhi[8]; u32x4 pw0,pw1,pw2,pw3;
  #define PKW(P,B) cvtpk_s(P[B],P[B+1])
  #define PAF(k) __builtin_bit_cast(bf16x8,pw##k)
  #define VFR(i) (bf16x8){vlo[i][0],vlo[i][1],vlo[i][2],vlo[i][3],vhi[i][0],vhi[i][1],vhi[i][2],vhi[i][3]}
  #define PIN(x) asm volatile("":"+v"(x))
  #define MX3(a,b,c) __builtin_fmaxf(__builtin_fmaxf((a),(b)),(c))
  #define GAPA(MF,A0,A1,A2,A3,W0,W1,PW) do{ MF; sacc+=A0; sacc+=A1; sacc+=A2; sacc+=A3; PIN(sacc); W0; W1; PIN(PW); SBAR(); }while(0)
  #define EX(v) __builtin_amdgcn_exp2f(v)
  #define GAPB(MF,X,B) do{ MF; X[B]=EX(X[B]); X[B+1]=EX(X[B+1]); X[B+2]=EX(X[B+2]); X[B+3]=EX(X[B+3]); PIN(X); SBAR(); }while(0)
  #define VRD(i) do{ vlo[i]=vtr(vp_+(((i)>>2)*4096+((i)&3)*1024)); vhi[i]=vtr(vp_+(((i)>>2)*4096+((i)&3)*1024+512)); }while(0)
  #define KRD(G,j) do{ if(G){ kload2(kf,kp0+sl_next,j); SBAR(); } }while(0)
  #define STEP(C0,C1,P0,P1,t,GK,GV,GL) do{ SBAR(); \
    const lds_cptr vp_=vp0+sl_prev; \
    VRD(0); SBAR(); float sacc=(P0[0]+P0[1]); \
    GAPA(C0=__builtin_amdgcn_mfma_f32_32x32x16_bf16(kf[0],qr[0],negm,0,0,0), P0[2],P0[3],P0[4],P0[5],     pw0[0]=PKW(P0,0), pw0[1]=PKW(P0,2), pw0); \
    VRD(4); SBAR(); GAPA(C1=__builtin_amdgcn_mfma_f32_32x32x16_bf16(kf[1],qr[0],negm,0,0,0), P0[6],P0[7],P0[8],P0[9],     pw0[2]=PKW(P0,4), pw0[3]=PKW(P0,6), pw0); \
    VRD(1); SBAR(); GAPA(C0=__builtin_amdgcn_mfma_f32_32x32x16_bf16(kf[2],qr[1],C0,0,0,0),   P0[10],P0[11],P0[12],P0[13], pw1[0]=PKW(P0,8), pw1[1]=PKW(P0,10), pw1); \
    VRD(5); SBAR(); GAPA(C1=__builtin_amdgcn_mfma_f32_32x32x16_bf16(kf[3],qr[1],C1,0,0,0),   P0[14],P0[15],P1[0],P1[1],   pw1[2]=PKW(P0,12),pw1[3]=PKW(P0,14), pw1); \
    VRD(2); SBAR(); GAPA(C0=__builtin_amdgcn_mfma_f32_32x32x16_bf16(kf[4],qr[2],C0,0,0,0),   P1[2],P1[3],P1[4],P1[5],     pw2[0]=PKW(P1,0), pw2[1]=PKW(P1,2), pw2); \
    VRD(6); SBAR(); GAPA(C1=__builtin_amdgcn_mfma_f32_32x32x16_bf16(kf[5],qr[2],C1,0,0,0),   P1[6],P1[7],P1[8],P1[9],     pw2[2]=PKW(P1,4), pw2[3]=PKW(P1,6), pw2); \
    VRD(3); SBAR(); GAPA(C0=__builtin_amdgcn_mfma_f32_32x32x16_bf16(kf[6],qr[3],C0,0,0,0),   P1[10],P1[11],P1[12],P1[13], pw3[0]=PKW(P1,8), pw3[1]=PKW(P1,10), pw3); \
    VRD(7); SBAR(); GAPA(C1=__builtin_amdgcn_mfma_f32_32x32x16_bf16(kf[7],qr[3],C1,0,0,0),   P1[14],P1[15],0.f,0.f,       pw3[2]=PKW(P1,12),pw3[3]=PKW(P1,14), pw3); \
    l_reg+=sacc; \
    if(GK){DMA_K((t)+3,sl_cur);} if(GV){DMA_V((t)+1,sl_next);} \
    CMASK(C0,C1,t); \
    SBAR(); \
    GAPB(o[0]=__builtin_amdgcn_mfma_f32_32x32x16_bf16(PAF(0),VFR(0),o[0],0,0,0), C0,0); \
    GAPB(o[1]=__builtin_amdgcn_mfma_f32_32x32x16_bf16(PAF(0),VFR(4),o[1],0,0,0), C0,4); \
    KRD(GL,0); GAPB(o[0]=__builtin_amdgcn_mfma_f32_32x32x16_bf16(PAF(1),VFR(1),o[0],0,0,0), C0,8); \
    KRD(GL,1); GAPB(o[1]=__builtin_amdgcn_mfma_f32_32x32x16_bf16(PAF(1),VFR(5),o[1],0,0,0), C0,12); \
    KRD(GL,2); GAPB(o[0]=__builtin_amdgcn_mfma_f32_32x32x16_bf16(PAF(2),VFR(2),o[0],0,0,0), C1,0); \
    KRD(GL,3); GAPB(o[1]=__builtin_amdgcn_mfma_f32_32x32x16_bf16(PAF(2),VFR(6),o[1],0,0,0), C1,4); \
    GAPB(o[0]=__builtin_amdgcn_mfma_f32_32x32x16_bf16(PAF(3),VFR(3),o[0],0,0,0), C1,8); \
    GAPB(o[1]=__builtin_amdgcn_mfma_f32_32x32x16_bf16(PAF(3),VFR(7),o[1],0,0,0), C1,12); \
    }while(0)
  int t=1;
  #undef CMASK
  #define CMASK(P0,P1,t) do{}while(0)
  for(;t+5<NT;t+=2){
    STEP(pB0,pB1,pA0,pA1,t,true,true,true);     WAIT_BAR(2); RESC(); ROT();
    STEP(pA0,pA1,pB0,pB1,t+1,true,true,true);   WAIT_BAR(2); RESC(); ROT();
  }
  #undef CMASK
  #define CMASK(P0,P1,t) do{}while(0)
  #define ENDW(tt) do{ if((tt)+3<NT){WAIT_BAR(2);} else if((tt)+2<NT){WAIT_BAR(1);} else {WAIT_BAR(0);} }while(0)
  for(;t+1<NT;t+=2){
    STEP(pB0,pB1,pA0,pA1,t,(t+3<NT),(t+1<NT),(t+1<NT));       ENDW(t);   RESC(); ROT();
    STEP(pA0,pA1,pB0,pB1,t+1,(t+4<NT),(t+2<NT),(t+2<NT));     ENDW(t+1); RESC(); ROT();
  }
  STEP(pB0,pB1,pA0,pA1,NT-1,false,false,false); RESC();
  { float sacc=pB0[0]+pB0[1]; _Pragma("unroll") for(int r=2;r<16;++r)sacc+=pB0[r]; _Pragma("unroll") for(int r=0;r<16;++r)sacc+=pB1[r]; l_reg+=sacc;
    pw0=(u32x4){PKW(pB0,0),PKW(pB0,2),PKW(pB0,4),PKW(pB0,6)};pw1=(u32x4){PKW(pB0,8),PKW(pB0,10),PKW(pB0,12),PKW(pB0,14)};pw2=(u32x4){PKW(pB1,0),PKW(pB1,2),PKW(pB1,4),PKW(pB1,6)};pw3=(u32x4){PKW(pB1,8),PKW(pB1,10),PKW(pB1,12),PKW(pB1,14)};
    SBAR(); pv(o,vb0+sl_cur,PAF(0),PAF(1),PAF(2),PAF(3)); }
  #undef PKW
  #undef PAF
  #undef VFR
  #undef PIN
  #undef MX3
  #undef GAPA
  #undef GAPB
  #undef EX
  #undef VRD
  #undef KRD
  #undef STEP
  #undef ENDW
  {auto rr=__builtin_amdgcn_permlane32_swap(__float_as_uint(l_reg),__float_as_uint(l_reg),false,false);l_reg=__uint_as_float(rr[0])+__uint_as_float(rr[1]);}
  if(hi==0)wsf[32+r32]=l_reg;asm volatile("s_waitcnt lgkmcnt(0)":::"memory");
  float rli[16];
  #pragma unroll
  for(int r=0;r<16;++r)rli[r]=__builtin_amdgcn_rcpf(wsf[32+crow(r,hi)]);
  bf16*Ow=O+(rowbase+q0+wid*QBLK)*OP+h*D;
  { bf16*stg=(bf16*)(shm+LDS_OST)+wid*2048;
    #pragma unroll
    for(int r=0;r<16;++r){const int orow=crow(r,hi);
      #pragma unroll
      for(int d0=0;d0<2;++d0)stg[orow*64+d0*32+r32]=__float2bfloat16(o[d0][r]*rli[r]);}
    asm volatile("s_waitcnt lgkmcnt(0)":::"memory");
    #pragma unroll
    for(int i=0;i<4;++i){const int row=i*8+(lane>>3),ch=lane&7; const u32x4 v=*(const u32x4*)(stg+row*64+ch*8); ATTN_STORE16(Ow+(long)row*OP+ch*8,v);} }
  asm volatile("s_waitcnt lgkmcnt(0)\n\ts_barrier":::"memory");
  #undef DMA_K
  #undef DMA_V
  #undef CMASK
  #undef START
  #undef RESC
  #undef ROT
}
constexpr int ATTN_LDS_BYTES=LDS_BYTES;
struct AttnTensors { const bf16* Q; const bf16* K; const bf16* V; bf16* O; float mref; };
struct AttnUnit { int bh; int qb; };
struct StaticOrder {
  int vcu;
  __device__ __forceinline__ explicit StaticOrder(int grid,int block):vcu((block%8)*(grid/8)+block/8){}
  __device__ __forceinline__ bool next(int i,AttnUnit&u)const{ if(i>=4)return false; const int s=vcu&7; u.bh=vcu>>3; u.qb=(i==0)?s:(i==1)?15-s:(i==2)?16+s:31-s; return true; }
  __device__ __forceinline__ void a_ready(const AttnUnit&)const{}
  __device__ __forceinline__ void done(const AttnUnit&)const{}
};
template<class Sched,int THRL=8> __device__ __forceinline__ void attn_phase(char*lds,const AttnTensors&T,const Sched&S){
  AttnUnit u;
  for(int i=0;S.next(i,u);++i){ S.a_ready(u); attn_unit<THRL>(u.bh>>3,u.bh&7,u.qb,T.Q,T.K,T.V,T.O,lds,T.mref); S.done(u); }
}
#undef SBAR
#undef WAIT_BAR
}

#define LAS __attribute__((address_space(3)))

#define XB_TMO      128
#define XB_XCNT(j)  (256  + 64 * (j))
#define XB_XSUB(j)  (1280 + 64 * (j))
#define XB_XGEN(j)  (2304 + 64 * (j))
#define XB_TOP      3328
#define XB_TOPGEN   3392
#define XCD_BAR_WORDS 3456
#define XB_SPIN_CAP (1u << 18)

__device__ __forceinline__ unsigned xb_ld(unsigned* p)              { return __hip_atomic_load(p, __ATOMIC_RELAXED, __HIP_MEMORY_SCOPE_AGENT); }
__device__ __forceinline__ unsigned xb_add(unsigned* p, unsigned v) { return __hip_atomic_fetch_add(p, v, __ATOMIC_RELAXED, __HIP_MEMORY_SCOPE_AGENT); }
__device__ __forceinline__ unsigned xb_xcc_id() { return (unsigned)__builtin_amdgcn_s_getreg((3 << 11) | 20) & 0xFu; }
#define XB_SPIN(cond, bar) do { unsigned _sp = 0; while (cond) { __builtin_amdgcn_s_sleep(1); \
    if ((++_sp & 255u) == 0u) { if (xb_ld(&(bar)[XB_TMO])) break; if (_sp > XB_SPIN_CAP) { atomicAdd(&(bar)[XB_TMO], 1u); break; } } } } while (0)

struct XcdBarrier {
    unsigned* bar; unsigned x;
    volatile LAS unsigned* st;
};

__device__ __forceinline__ XcdBarrier xcd_barrier_post(unsigned* bar, volatile LAS unsigned* st) {
    XcdBarrier b; b.bar = bar; b.x = xb_xcc_id(); b.st = st;
    if (threadIdx.x == 0) (void)xb_add(&bar[XB_XCNT(b.x)], 1u);
    return b;
}
__device__ __forceinline__ void xcd_barrier_complete(unsigned* bar, unsigned x, unsigned& nloc, unsigned& nx) {
    const unsigned G = gridDim.x * gridDim.y * gridDim.z;
    unsigned sum, cnt, mine, sp = 0u;
    for (;;) {
        sum = 0u; cnt = 0u; mine = 0u;
#pragma unroll
        for (unsigned j = 0; j < 16; ++j) { const unsigned c = xb_ld(&bar[XB_XCNT(j)]); sum += c; cnt += (c > 0u) ? 1u : 0u; mine = (j == x) ? c : mine; }
        if (sum == G) break;
        __builtin_amdgcn_s_sleep(1);
        if ((++sp & 255u) == 0u) { if (xb_ld(&bar[XB_TMO])) break; if (sp > XB_SPIN_CAP) { atomicAdd(&bar[XB_TMO], 1u); break; } }
    }
    nloc = mine > 0u ? mine : 1u; nx = cnt > 0u ? cnt : 1u;
}

__device__ __forceinline__ void xcd_barrier(const XcdBarrier& b) {
    asm volatile("s_waitcnt vmcnt(0)" ::: "memory");
    __syncthreads();
    if (threadIdx.x == 0) {
        unsigned* bar = b.bar;
        __builtin_amdgcn_s_waitcnt(0);
        unsigned nloc = b.st[0], nx = b.st[1];
        if (nloc == 0u) { xcd_barrier_complete(bar, b.x, nloc, nx); b.st[0] = nloc; b.st[1] = nx; }
        const unsigned old = xb_add(&bar[XB_XSUB(b.x)], 1u);
        const unsigned gen = old / nloc;
        if (old + 1u == (gen + 1u) * nloc) {
            __builtin_amdgcn_fence(__ATOMIC_RELEASE, "agent");
            asm volatile("s_waitcnt vmcnt(0)" ::: "memory");
            const unsigned og = xb_add(&bar[XB_TOP], 1u);
            const unsigned tg = og / nx;
            if (og + 1u == (tg + 1u) * nx) xb_add(&bar[XB_TOPGEN], 1u);
            else XB_SPIN(xb_ld(&bar[XB_TOPGEN]) == tg, bar);
            __builtin_amdgcn_fence(__ATOMIC_ACQUIRE, "agent");
            xb_add(&bar[XB_XGEN(b.x)], 1u);
            asm volatile("s_waitcnt vmcnt(0)" ::: "memory");
        } else {
            XB_SPIN(xb_ld(&bar[XB_XGEN(b.x)]) == gen, bar);
            __builtin_amdgcn_fence(__ATOMIC_ACQUIRE, "agent");
            asm volatile("s_waitcnt vmcnt(0)" ::: "memory");
        }
    }
    __syncthreads();
}

#undef LAS

constexpr int NWAVES = 8;
constexpr int RING_OFF = 0, RING_BYTES = 131072;
constexpr int LDSCTL_OFF = RING_BYTES;
constexpr int LDS_TILE_OFF = LDSCTL_OFF + 4096;
constexpr int LDS_BYTES = 147456;
#define LAS __attribute__((address_space(3)))
#define GAS __attribute__((address_space(1)))
typedef unsigned v4u __attribute__((ext_vector_type(4)));

__device__ __forceinline__ int proj_perm(int n) {
    if (n < COL_K || n >= COL_GATE) return n;
    if (n < COL_Q) { const int r = n - COL_K, hs = r >> 6, d = r & 63; return COL_K + 128 * (d >> 5) + 32 * hs + (d & 31); }
    const int r = n - COL_Q, h = r >> 6, d = r & 63; return COL_Q + 256 * (h >> 2) + 128 * (d >> 5) + 32 * (h & 3) + (d & 31);
}
__device__ __forceinline__ int gu_perm(int c) { const int jc = c & 1023, up = c >> 10; return 256 * (jc >> 7) + 128 * up + (jc & 127); }
typedef float wc_f32x4 __attribute__((ext_vector_type(4)));
struct WcMat { const float* W; bf16* WT; int N, ldk, koff, mode, local; };
__device__ __forceinline__ WcMat wc_decode(const P& p, int it) {
    constexpr int I_GLU = 8 * 2, I_SSM = 8 * 4, I_D1 = 16 * 4;
    int r = it; WcMat m;
    if (r < 32 * I_D1) { const int e = r / I_D1; m = WcMat{p.in[28] + (size_t)e * 1024 * 1024, (bf16*)(p.ws + WS_WD) + (size_t)e * 1024 * 1024, 1024, 1024, 0, 0, r % I_D1}; return m; } r -= 32 * I_D1;
    if (r < I_GLU) { m = WcMat{p.in[17], (bf16*)(p.ws + WS_WGLU), 512, 512, 0, 0, r}; return m; } r -= I_GLU;
    if (r < I_SSM) { m = WcMat{p.in[19], (bf16*)(p.ws + WS_W12), 1024, 1024, 0, 0, r}; return m; } r -= I_SSM;
    if (r < I_SSM) { m = WcMat{p.in[22], (bf16*)(p.ws + WS_W12), 1024, 1024, 512, 0, r}; return m; } r -= I_SSM;
    m = WcMat{p.in[23], (bf16*)(p.ws + WS_WOUT), 1024, 1024, 0, 0, r}; return m;
}
#define WQ_LOAD(V, item) do { const bool gu_ = (item) < 2048, wd_ = (item) >= 2152; const int e_ = wd_ ? ((item) - 2152) >> 5 : (item) >> 6, sn_ = gu_ ? (item) & 63 : wd_ ? ((item) - 2152) & 31 : (item) - 2048; const int N_ = gu_ ? 2048 : wd_ ? 1024 : DIN; \
        const float* src_ = (gu_ ? p.in[26] + (size_t)e_ * 1024 * 2048 : wd_ ? p.in[28] + (size_t)e_ * 1024 * 1024 : p.in[8]) + (size_t)(2 * (t >> 3)) * N_ + 32 * sn_ + 4 * (t & 7); \
        _Pragma("unroll") for (int i_ = 0; i_ < 16; ++i_) V[i_] = *(const wc_f32x4*)(src_ + (size_t)(128 * (i_ >> 1) + (i_ & 1)) * N_); } while (0)
__device__ __forceinline__ void wq_init(LAS unsigned char* lds) { if (threadIdx.x < 64) ((LAS unsigned*)(lds + 65536))[threadIdx.x] = 0u; __syncthreads(); }
__device__ __forceinline__ void wq_park(const wc_f32x4 (&v)[16], bool wd, int par, LAS unsigned char* lds) {
    const int t = threadIdx.x; LAS unsigned* cmax = (LAS unsigned*)(lds + 65536) + 32 * par;
    wc_f32x4 m4 = {0.f, 0.f, 0.f, 0.f};
#pragma unroll
    for (int m = 0; m < 8; ++m) { const wc_f32x4 a = v[2 * m], b = v[2 * m + 1];
#pragma unroll
        for (int c = 0; c < 4; ++c) m4[c] = fmaxf(m4[c], fmaxf(fabsf(a[c]), fabsf(b[c])));
        typedef unsigned wc_u32x4 __attribute__((ext_vector_type(4)));
        *(LAS wc_u32x4*)(lds + (((t >> 3) + 64 * m) * 32 + 4 * (t & 7)) * 4) = (wc_u32x4){pg8::cvt_pk_bf16(a[0], b[0]), pg8::cvt_pk_bf16(a[1], b[1]), pg8::cvt_pk_bf16(a[2], b[2]), pg8::cvt_pk_bf16(a[3], b[3])}; }
    if (!wd) {
#pragma unroll
        for (int j = 0; j < 4; ++j) __hip_atomic_fetch_max(cmax + 4 * (t & 7) + j, __float_as_uint(m4[j]), __ATOMIC_RELAXED, __HIP_MEMORY_SCOPE_WORKGROUP); }
}
__device__ __forceinline__ void wq_finish(const P& p, int item, int par, LAS unsigned char* lds) {
    const bool gu = item < 2048, wd = item >= 2152; const int t = threadIdx.x, e = item >> 6, sn = gu ? item & 63 : item - 2048;
    LAS unsigned* cmax = (LAS unsigned*)(lds + 65536) + 32 * par; LAS unsigned* cnext = (LAS unsigned*)(lds + 65536) + 32 * (par ^ 1);
    const LAS unsigned* img = (const LAS unsigned*)lds;
    __syncthreads();
    const int n = t & 31, cg = t >> 5;
    if (wd) {
        const int ed = (item - 2152) >> 5, sd = (item - 2152) & 31;
        bf16* dst = (bf16*)(p.ws + WS_WD) + ((size_t)ed * 1024 + 32 * sd + n) * 1024;
#pragma unroll
        for (int j = 0; j < 4; ++j) { const int c = cg + 16 * j; unsigned o8[8];
#pragma unroll
            for (int w = 0; w < 8; ++w) o8[w] = img[(8 * c + w) * 32 + n];
            *(uint4*)(dst + 16 * c) = make_uint4(o8[0], o8[1], o8[2], o8[3]); *(uint4*)(dst + 16 * c + 8) = make_uint4(o8[4], o8[5], o8[6], o8[7]); }
    } else {
        const float am = __uint_as_float(cmax[n]), inv = am > 0.f ? 126.5f / am : 0.f;
        if (t < 32) cnext[t] = 0u;
        const int c0 = 32 * sn + n, drow = gu ? gu_perm(c0) : proj_perm(c0);
        signed char* dst = gu ? (signed char*)(p.ws + WS_WGQ) + ((size_t)e * 2048 + drow) * 1024 : (signed char*)(p.ws + WS_WIN) + (size_t)drow * 1024;
        if (cg == 0) { if (gu) ((float*)(p.ws + WS_WGS))[e * 2048 + drow] = am * (1.f / 126.5f); else ((float*)(p.ws + WS_WINS))[drow] = am * (1.f / 126.5f); }
#pragma unroll
        for (int j = 0; j < 4; ++j) { const int c = cg + 16 * j; unsigned o4[4];
#pragma unroll
            for (int w = 0; w < 4; ++w) { const unsigned d0 = img[(8 * c + 2 * w) * 32 + n], d1 = img[(8 * c + 2 * w + 1) * 32 + n];
                const float y0 = fmaf(__uint_as_float(d0 << 16), inv, 12582912.f), y1 = fmaf(__uint_as_float(d0 & 0xffff0000u), inv, 12582912.f);
                const float y2 = fmaf(__uint_as_float(d1 << 16), inv, 12582912.f), y3 = fmaf(__uint_as_float(d1 & 0xffff0000u), inv, 12582912.f);
                o4[w] = __builtin_amdgcn_perm(__float_as_uint(y1), __float_as_uint(y0), 0x0c0c0400u) | __builtin_amdgcn_perm(__float_as_uint(y3), __float_as_uint(y2), 0x04000c0cu); }
            *(uint4*)(dst + 16 * c) = make_uint4(o4[0], o4[1], o4[2], o4[3]); }
    }
    __syncthreads();
}
#define WC_LOAD(V, M) do { const int nblk_ = M.N >> 8, kb_ = M.local / nblk_, nb_ = M.local - kb_ * nblk_; const float* src_ = M.W + (size_t)(64 * kb_ + wave) * M.N + 256 * nb_ + 4 * lane; \
        _Pragma("unroll") for (int i_ = 0; i_ < 8; ++i_) V[i_] = *(const wc_f32x4*)(src_ + (size_t)(8 * i_) * M.N); } while (0)
#define WC_PROC(V, M, buf) do { const int nblk_ = M.N >> 8, kb_ = M.local / nblk_, nb_ = M.local - kb_ * nblk_, k0_ = 64 * kb_, n0_ = 256 * nb_; LAS float* scr_ = (LAS float*)(lds + (buf) * 65536); \
        _Pragma("unroll") for (int i_ = 0; i_ < 8; ++i_) { const int row_ = wave + 8 * i_; *(LAS wc_f32x4*)(scr_ + row_ * 256 + ((4 * lane) ^ (((row_ >> 3) & 7) << 2))) = V[i_]; } \
        __syncthreads(); const int c_ = lane & 7; \
        _Pragma("unroll") for (int j_ = 0; j_ < 4; ++j_) { const int n_ = 64 * j_ + 8 * wave + (lane >> 3); const LAS float* s_ = scr_ + (8 * c_) * 256 + (n_ ^ (c_ << 2)); \
            v4u o_; o_.x = pk2(s_[0 * 256], s_[1 * 256]); o_.y = pk2(s_[2 * 256], s_[3 * 256]); o_.z = pk2(s_[4 * 256], s_[5 * 256]); o_.w = pk2(s_[6 * 256], s_[7 * 256]); \
            const int dr_ = M.mode == 1 ? proj_perm(n0_ + n_) : M.mode == 2 ? gu_perm(n0_ + n_) : n0_ + n_; \
            *(v4u*)(M.WT + (size_t)dr_ * M.ldk + M.koff + k0_ + 8 * c_) = o_; } } while (0)
__device__ __forceinline__ void ph_wconv(const P& p, int bx, LAS unsigned char* lds) {
    const int lane = threadIdx.x & 63, wave = threadIdx.x >> 6, t = threadIdx.x;
    if (bx >= 224) { const int s0 = bx - 224; wc_f32x4 sa[16], sb[16];
        WQ_LOAD(sa, 2048 + s0); WQ_LOAD(sb, 2048 + s0 + 32); wq_init(lds); wq_park(sa, false, 0, lds); WQ_LOAD(sa, 2048 + s0 + 64); wq_finish(p, 2048 + s0, 0, lds); wq_park(sb, false, 1, lds); wq_finish(p, 2048 + s0 + 32, 1, lds); wq_park(sa, false, 0, lds); wq_finish(p, 2048 + s0 + 64, 0, lds); }
    else if (bx >= 64 && bx < 160) {
#pragma unroll 1
        for (int it = 96 + (bx - 64); it < 248; it += 96) {
            if (it < 104) { wc_f32x4 sa[16]; WQ_LOAD(sa, 2048 + it); wq_init(lds); wq_park(sa, false, 0, lds); wq_finish(p, 2048 + it, 0, lds); }
            else { wc_f32x4 wa[8]; const WcMat ma = wc_decode(p, 2048 + it - 104); WC_LOAD(wa, ma); WC_PROC(wa, ma, 0); __syncthreads(); } } }
}
__device__ __forceinline__ void wq_range12(const P& p, int id0, LAS unsigned char* lds) {
    const int t = threadIdx.x; wc_f32x4 sa[16], sb[16];
#define WQ_ID(q) ((q) < 8 ? id0 + (q) * 256 : id0 + (q) * 256 + 104)
    WQ_LOAD(sa, WQ_ID(0)); WQ_LOAD(sb, WQ_ID(1));
    wq_init(lds);
#pragma unroll 1
    for (int q = 0; q < 10; q += 2) {
        wq_park(sa, q >= 8, 0, lds); WQ_LOAD(sa, WQ_ID(q + 2)); wq_finish(p, WQ_ID(q), 0, lds);
        wq_park(sb, q >= 8, 1, lds); WQ_LOAD(sb, WQ_ID(q + 3)); wq_finish(p, WQ_ID(q + 1), 1, lds);
    }
    wq_park(sa, true, 0, lds); wq_finish(p, WQ_ID(10), 0, lds);
    wq_park(sb, true, 1, lds); wq_finish(p, WQ_ID(11), 1, lds);
#undef WQ_ID
}
__device__ __forceinline__ void ph_wexp(const P& p, int idx, LAS unsigned char* lds) {
    wq_range12(p, idx, lds);
    __syncthreads();
}
#undef WC_LOAD
#undef WC_PROC
#undef WQ_LOAD

__device__ __forceinline__ void ph_s5tab(const P& p, int g, int dir, int part, int nparts, float* L) {
    float* pw = L; float* Bb = L + 2176; float* Cc = Bb + 2048; float* Kt = Cc + 2048;
    const int tid = threadIdx.x, dg = dir * 32 + g;
    const float step = expf(p.in[11][dg]);
    for (int i = tid; i < 64 * 17; i += 512) { const int n = i / 17, tau = i - n * 17; const float zr = p.in[9][dg * 64 + n] * step, zi = p.in[10][dg * 64 + n] * step;
        const float e = expf(zr * (float)tau), a = zi * (float)tau; float sn, cs; sincosf(a, &sn, &cs); pw[i * 2] = e * cs; pw[i * 2 + 1] = e * sn; }
    for (int i = tid; i < 1024; i += 512) { const int n = i >> 4, q = i & 15; const float lr = p.in[9][dg * 64 + n], li = p.in[10][dg * 64 + n]; const float zr = lr * step, zi = li * step, e = expf(zr);
        float sn, cs; sincosf(zi, &sn, &cs); const float nr = e * cs - 1.f, ni = e * sn, den = lr * lr + li * li; const float cr = (nr * lr + ni * li) / den, ci = (ni * lr - nr * li) / den;
        const float br = p.in[12][(dg * 64 + n) * 16 + q], bi = p.in[13][(dg * 64 + n) * 16 + q]; Bb[i * 2] = cr * br - ci * bi; Bb[i * 2 + 1] = cr * bi + ci * br; }
    for (int i = tid; i < 1024; i += 512) { Cc[i * 2] = p.in[14][dg * 1024 + i]; Cc[i * 2 + 1] = p.in[15][dg * 1024 + i]; }
    __syncthreads();
    typedef float f2 __attribute__((ext_vector_type(2)));
    { const int tau = tid >> 5, pp = (tid >> 1) & 15, q0 = (tid & 1) * 8;
      float a[8] = {0.f, 0.f, 0.f, 0.f, 0.f, 0.f, 0.f, 0.f};
#pragma unroll 4
      for (int n = 0; n < 64; ++n) { const f2 c = *(const f2*)(Cc + (pp * 64 + n) * 2), w = *(const f2*)(pw + (n * 17 + tau) * 2); const float zr = c.x * w.x - c.y * w.y, zi = c.x * w.y + c.y * w.x;
#pragma unroll
          for (int q = 0; q < 8; ++q) { const f2 bq = *(const f2*)(Bb + (n * 16 + q0 + q) * 2); a[q] += zr * bq.x - zi * bq.y; } }
#pragma unroll
      for (int q = 0; q < 8; ++q) Kt[(tau * 16 + pp) * 16 + q0 + q] = a[q]; }
    __syncthreads();
    if (part == 0 && tid < 256) ((float*)(p.ws + WS_KD))[dg * 256 + tid] = Kt[tid];
    bf16* TCV = (bf16*)(p.ws + WS_TCV) + (size_t)g * 256 * 512;
    for (int i = part * 512 + tid; i < 256 * 256; i += 512 * nparts) { const int row = i >> 8, k = i & 255, ii = row >> 4, pp = row & 15, j = k >> 4, q = k & 15;
        if (dir == 0 ? (j < ii) : (j > ii)) TCV[row * 512 + k] = f2bf(Kt[((dir == 0 ? ii - j : j - ii) * 16 + pp) * 16 + q]); }
    for (int i = part * 512 + tid; i < 256 * 128; i += 512 * nparts) { const int row = i >> 7, kk = i & 127, ii = row >> 4, pp = row & 15, n = kk >> 1, ri = kk & 1, tau = dir == 0 ? ii + 1 : 16 - ii;
        const f2 c = *(const f2*)(Cc + (pp * 64 + n) * 2), w = *(const f2*)(pw + (n * 17 + tau) * 2);
        TCV[row * 512 + 256 + dir * 128 + kk] = f2bf(ri == 0 ? (c.x * w.x - c.y * w.y) : -(c.x * w.y + c.y * w.x)); }
    bf16* WS5 = (bf16*)(p.ws + WS_WS5) + (size_t)g * 256 * 256 + (size_t)dir * 128 * 256;
    for (int i = part * 512 + tid; i < 128 * 256; i += 512 * nparts) { const int row = i >> 8, k = i & 255, n = row >> 1, ri = row & 1, ii = k >> 4, q = k & 15, tau = dir == 0 ? 15 - ii : ii;
        const f2 w = *(const f2*)(pw + (n * 17 + tau) * 2), bq = *(const f2*)(Bb + (n * 16 + q) * 2);
        WS5[i] = f2bf(ri == 0 ? w.x * bq.x - w.y * bq.y : w.x * bq.y + w.y * bq.x); }
}
__device__ __forceinline__ void ph_s5diag(const P& p, int g) {
    const float* KD = (const float*)(p.ws + WS_KD); bf16* TCV = (bf16*)(p.ws + WS_TCV) + (size_t)g * 256 * 512;
    for (int i = threadIdx.x; i < 4096; i += 512) { const int ii = i >> 8, pp = (i >> 4) & 15, q = i & 15;
        const float v = KD[g * 256 + pp * 16 + q] + KD[(32 + g) * 256 + pp * 16 + q] + (pp == q ? p.in[16][g * 16 + pp] : 0.f);
        TCV[(ii * 16 + pp) * 512 + ii * 16 + q] = f2bf(v); }
}
__device__ __forceinline__ void ph_s5scan(const P& p, int bx, int G, float* L) {
    const int n = threadIdx.x & 63, s = threadIdx.x >> 6;
    for (int w = bx; w < 256; w += G) { const int b = w >> 6, g = (w >> 1) & 31, dir = w & 1, dg = dir * 32 + g;
        const float lr = p.in[9][dg * 64 + n], li = p.in[10][dg * 64 + n], step = expf(p.in[11][dg]); const float zr = 16.f * lr * step, zi = 16.f * li * step, ez = expf(zr);
        float sn_, cs_; sincosf(zi, &sn_, &cs_); const float ar = ez * cs_, ai = ez * sn_;
        const float ez64 = expf(64.f * zr); sincosf(64.f * zi, &sn_, &cs_); const float Ar = ez64 * cs_, Ai = ez64 * sn_;
        const bf16* sl = (const bf16*)(p.ws + WS_SL) + (size_t)g * NCHUNK_PAD * 256 + dir * 128 + 2 * n;
        bf16* hh = (bf16*)(p.ws + WS_UH) + (size_t)g * NCHUNK_PAD * 512 + 256 + dir * 128 + 2 * n;
        const int k0 = dir ? 511 - 64 * s : 64 * s; const long inc = dir ? -1 : 1;
        const bf16* ps = sl + (size_t)(b * 512 + k0) * 256; bf16* ph = hh + (size_t)(b * 512 + k0) * 512;
        unsigned v[64];
        {
          const int r = n & 15, kq = n >> 4;
          const bf16* ap = (const bf16*)(p.ws + WS_UH) + ((size_t)g * NCHUNK_PAD + 2048 + b * 16 + r) * 512 + 8 * kq;
          const bf16* bp = (const bf16*)(p.ws + WS_WS5) + ((size_t)g * 256 + dir * 128 + 16 * s + r) * 256 + 8 * kq;
          rt_u32x4 av[8], bv[8];
#pragma unroll
          for (int ks = 0; ks < 8; ++ks) { av[ks] = *(const rt_u32x4*)(ap + 32 * ks); bv[ks] = *(const rt_u32x4*)(bp + 32 * ks); }
          rt_f32x4 acc = {0.f, 0.f, 0.f, 0.f};
#pragma unroll
          for (int ks = 0; ks < 8; ++ks) acc = __builtin_amdgcn_mfma_f32_16x16x32_bf16(__builtin_bit_cast(rt_bf16x8, av[ks]), __builtin_bit_cast(rt_bf16x8, bv[ks]), acc, 0, 0, 0);
#pragma unroll
          for (int q = 0; q < 4; ++q) L[2048 + (4 * kq + q) * 128 + 16 * s + r] = acc[q]; }
#pragma unroll
        for (int u = 0; u < 64; ++u) { v[u] = *(const unsigned*)ps; ps += inc * 256; asm volatile("" : "+v"(ps)); }
        __syncthreads();
        float c0r = 0.f, c0i = 0.f;
#pragma unroll
        for (int u = 0; u < 16; ++u) { const int uu = dir ? 15 - u : u; const float x = L[2048 + uu * 128 + 2 * n], y = L[2048 + uu * 128 + 2 * n + 1]; const float nr = ar * c0r - ai * c0i + x, ni = ar * c0i + ai * c0r + y; c0r = nr; c0i = ni; }
        float sr = 0.f, si = 0.f;
#pragma unroll
        for (int u = 0; u < 64; ++u) { const float x = __uint_as_float(v[u] << 16), y = __uint_as_float(v[u] & 0xffff0000u); const float nr = ar * sr - ai * si + x, ni = ar * si + ai * sr + y; sr = nr; si = ni; }
        L[(s * 64 + n) * 2] = sr; L[(s * 64 + n) * 2 + 1] = si;
        __syncthreads();
        sr = c0r; si = c0i;
        for (int t = 0; t < s; ++t) { const float x = L[(t * 64 + n) * 2], y = L[(t * 64 + n) * 2 + 1]; const float nr = Ar * sr - Ai * si + x, ni = Ar * si + Ai * sr + y; sr = nr; si = ni; }
#pragma unroll
        for (int u = 0; u < 64; ++u) { *(unsigned*)ph = pk2(sr, si); ph += inc * 512; asm volatile("" : "+v"(ph));
            const float x = __uint_as_float(v[u] << 16), y = __uint_as_float(v[u] & 0xffff0000u); const float nr = ar * sr - ai * si + x, ni = ar * si + ai * sr + y; sr = nr; si = ni; }
        __syncthreads();
    }
}

__global__ void __launch_bounds__(NWAVES * 64, 2) mk_fwd(P p, int ph_lo, int ph_hi) {
    extern __shared__ __attribute__((aligned(16))) unsigned char lds_raw[];
    LAS unsigned char* lds = (LAS unsigned char*)lds_raw;
    const int tid = threadIdx.x, G = gridDim.x, bx = blockIdx.x;
    const int vcu = (G % 8 == 0) ? (bx % 8) * (G / 8) + bx / 8 : bx;
    for (int u = tid; u < 64; u += NWAVES * 64) ((LAS unsigned*)(lds + LDSCTL_OFF))[u] = 0u;
    __syncthreads();
    unsigned* barw = (unsigned*)(p.ws + WS_CTL) + 4096;
    XcdBarrier bar; bar.bar = barw; bar.x = 0; bar.st = nullptr;
    if (ph_hi - ph_lo > 1) bar = xcd_barrier_post(barw, (volatile LAS unsigned*)(lds + LDSCTL_OFF) + 8);
#define IN(k) (ph_lo <= (k) && (k) < ph_hi)
#define PH(k) if (IN(k))
#define SEAM(k) do { if (IN(k) && IN((k) + 1)) xcd_barrier(bar); } while (0)

    PH(0) {
        if (bx < 64) ph_s5tab(p, bx >> 1, bx & 1, 0, 2, (float*)lds_raw); else if (bx < 160) ph_mod(p, bx - 64, 96, (float*)lds_raw); else if (bx < 224) ph_s5tab(p, (bx - 160) >> 1, bx & 1, 1, 2, (float*)lds_raw);
        ph_rope(p, bx, G); __syncthreads(); ph_wconv(p, bx, lds);
    }
    SEAM(0);
    PH(1) { ph_h1(p, bx, G); if (bx < 32) ph_s5diag(p, bx); }
    SEAM(1);
    PH(2) {
        pg8::GemmG g{(const char*)(p.ws + WS_H1), (const char*)(p.ws + WS_WIN), 128, (size_t)128 * 1024, (size_t)256 * 1024, 512, 512, nullptr, 0u};
        pg8::SchedProj S; S.init(G, bx);
        pg8::EpiProj E{(bf16*)(p.ws + WS_UH), (bf16*)(p.ws + WS_KB), (bf16*)(p.ws + WS_VB), (bf16*)(p.ws + WS_QB), (unsigned char*)(p.ws + WS_GT), p.in[20], p.in[21], (const float*)(p.ws + WS_ROPE),
                       (const float*)(p.ws + WS_H1S), (const float*)(p.ws + WS_WINS)};
        pg8::gemm_phase<pg8::EpiProj, pg8::SchedProj, pg8::AoRow, false, true, true>(lds + RING_OFF, g, pg8::AoRow{512}, S, E);
    }
    SEAM(2);
    PH(3) {
        pg8::GemmG g{(const char*)(p.ws + WS_UH), (const char*)(p.ws + WS_WS5), 128, (size_t)128 * 512 * 2, (size_t)256 * 512 * 2, 256, 256, nullptr, 0u};
        pg8::SchedS5 S{8, G, bx};
        pg8::EpiSloc E{(bf16*)(p.ws + WS_SL)};
        pg8::gemm_phase(lds + RING_OFF, g, pg8::AoRow{512}, S, E);
    }
    SEAM(3);
    PH(4) { ph_s5scan(p, bx, G, (float*)lds_raw); }
    SEAM(4);
    PH(5) {
        pg8::GemmG g{(const char*)(p.ws + WS_UH), (const char*)(p.ws + WS_TCV), 128, (size_t)128 * 512 * 2, (size_t)256 * 512 * 2, 512, 512, nullptr, 0u};
        pg8::SchedS5 S{8, G, bx};
        pg8::EpiS5Y E{(bf16*)(p.ws + WS_SG)};
        pg8::gemm_phase(lds + RING_OFF, g, pg8::AoRow{512}, S, E);
    }
    PH(6) {
        float gq = 0.f, gk = 0.f;
        for (int d = 0; d < 64; ++d) { gq = fmaxf(gq, fabsf(p.in[20][d])); gk = fmaxf(gk, fabsf(p.in[21][d])); }
        const float mref = 64.f * C2 * gq * gk * 1.02f + 0.05f;
        const attn_body::AttnTensors AT{(const attn_body::bf16*)(p.ws + WS_QB), (const attn_body::bf16*)(p.ws + WS_KB), (const attn_body::bf16*)(p.ws + WS_VB), (attn_body::bf16*)(p.ws + WS_GO) + 512, mref};
        const attn_body::StaticOrder S(G, bx);
        const int kq = bx >> 3, jgap = kq & 3, widx = jgap * 64 + (kq >> 2) * 8 + (bx & 7);
        attn_body::AttnUnit u; int i = 0;
#pragma unroll 1
        for (; i < jgap; ++i) { S.next(i, u); attn_body::attn_unit<8>(u.bh >> 3, u.bh & 7, u.qb, AT.Q, AT.K, AT.V, AT.O, (char*)lds_raw + RING_OFF, AT.mref); }
        ph_wexp(p, widx, lds);
#pragma unroll 1
        for (; i < 4; ++i) { S.next(i, u); attn_body::attn_unit<8>(u.bh >> 3, u.bh & 7, u.qb, AT.Q, AT.K, AT.V, AT.O, (char*)lds_raw + RING_OFF, AT.mref); }
    }
    SEAM(6);
    PH(7) {
        pg8::GemmG g{(const char*)(p.ws + WS_SG), (const char*)(p.ws + WS_WGLU), (size_t)4 * T * 32, (size_t)128 * 32, (size_t)256 * 32, 512, 512, nullptr, 0u};
        pg8::StaticOrder S; S.init(T, 512, G, bx);
        pg8::EpiGlu E{(const bf16*)(p.ws + WS_SG), p.in[18], (bf16*)(p.ws + WS_GO)};
        pg8::gemm_phase(lds + RING_OFF, g, pg8::AoGrp{}, S, E);
    }
    SEAM(7);
    PH(8) {
        pg8::StaticOrder S; S.init(T, 1024, G, bx);
        { pg8::GemmG g{(const char*)(p.ws + WS_GO), (const char*)(p.ws + WS_W12), 128, (size_t)128 * 1024 * 2, (size_t)256 * 1024 * 2, 1024, 512, nullptr, 0u};
          pg8::EpiMerge<0> E{(const unsigned char*)(p.ws + WS_GT), (bf16*)(p.ws + WS_M1), (bf16*)(p.ws + WS_MG)};
          pg8::gemm_phase(lds + RING_OFF, g, pg8::AoRow{1024}, S, E); }
        { pg8::GemmG g{(const char*)(p.ws + WS_GO) + 1024, (const char*)(p.ws + WS_W12) + 1024, 128, (size_t)128 * 1024 * 2, (size_t)256 * 1024 * 2, 1024, 512, nullptr, 0u};
          pg8::EpiMerge<1> E{(const unsigned char*)(p.ws + WS_GT), (bf16*)(p.ws + WS_M1), (bf16*)(p.ws + WS_MG)};
          pg8::gemm_phase(lds + RING_OFF, g, pg8::AoRow{1024}, S, E); }
    }
    SEAM(8);
    PH(9) {
        pg8::GemmG g{(const char*)(p.ws + WS_MG), (const char*)(p.ws + WS_WOUT), 128, (size_t)128 * 1024 * 2, (size_t)256 * 1024 * 2, 1024, 1024, nullptr, 0u};
        pg8::StaticOrder S; S.init(T, 1024, G, bx);
        pg8::EpiOut E{p.in[0], (const float*)(p.ws + WS_MOD), (bf16*)(p.ws + WS_XM)};
        pg8::gemm_phase(lds + RING_OFF, g, pg8::AoRow{1024}, S, E);
    }
    SEAM(9);
    PH(10) { ph_route_a(p, bx, G, (float*)lds_raw); }
    SEAM(10);
    PH(11) { ph_route_b(p, bx, G, (int*)lds_raw); }
    SEAM(11);
    if (IN(12) || IN(13)) {
        const int* TILE_E = (const int*)(p.ws + WS_TILE); LAS int* lt = (LAS int*)(lds + LDS_TILE_OFF);
        for (int i = tid; i < 1024; i += NWAVES * 64) lt[i] = TILE_E[i];
        __syncthreads();
    }
    PH(12) {
        const LAS int* lt = (const LAS int*)(lds + LDS_TILE_OFF);
        pg8::GemmG g{(const char*)(p.ws + WS_H2), (const char*)(p.ws + WS_WGQ), 128, 0, 0, 512, 512, (const int*)(p.ws + WS_SLOTTOK), 1024u};
        pg8::SchedMoE S{lt, lt[1023], 8, G, bx, 0, 4};
        pg8::EpiGU8 E{p.in[27], (const float*)(p.ws + WS_SLOTSA), (const float*)(p.ws + WS_WGS), (bf16*)(p.ws + WS_ACT)};
        pg8::gemm_phase<pg8::EpiGU8, pg8::SchedMoE, pg8::AoRow, true, true, true>(lds + RING_OFF, g, pg8::AoRow{512}, S, E);
    }
    SEAM(12);
    PH(13) {
        const LAS int* lt = (const LAS int*)(lds + LDS_TILE_OFF);
        pg8::GemmG g{(const char*)(p.ws + WS_ACT), (const char*)(p.ws + WS_WD), 128, (size_t)128 * 1024 * 2, (size_t)256 * 1024 * 2, 1024, 1024, nullptr, 0u};
        pg8::SchedMoE S{lt, lt[1023], 4, G, bx, 1, 4};
        pg8::EpiDown E{p.in[29], (const float*)(p.ws + WS_SLOTGATE), (bf16*)(p.ws + WS_YB)};
        pg8::gemm_phase(lds + RING_OFF, g, pg8::AoRow{1024}, S, E);
    }
    SEAM(13);
    PH(14) { ph_final(p, bx, G); }
#undef IN
#undef PH
#undef SEAM
}

extern "C" void kernel_launch(void* const* d_in, const int* in_sizes, int n_in, void* d_out, int out_size, void* d_ws, size_t ws_size, hipStream_t stream) {
    if (n_in != 31 || out_size != T * DM || ws_size < WS_END) { fprintf(stderr, "kernel_launch: unexpected shapes (n_in %d out %d ws %zu)\n", n_in, out_size, ws_size); return; }
    static int grid = 0;
    if (!grid) {
        int dev = 0, cus = 0, per_cu = 0;
        (void)hipGetDevice(&dev); (void)hipDeviceGetAttribute(&cus, hipDeviceAttributeMultiprocessorCount, dev);
        (void)hipFuncSetAttribute((const void*)mk_fwd, hipFuncAttributeMaxDynamicSharedMemorySize, LDS_BYTES);
        (void)hipOccupancyMaxActiveBlocksPerMultiprocessor(&per_cu, (const void*)mk_fwd, NWAVES * 64, LDS_BYTES);
        (void)hipGetLastError();
        if (cus != 256 || per_cu < 1) fprintf(stderr, "kernel_launch: note: %d CUs, occupancy query %d; this kernel is built for one 512-thread workgroup on each of 256 CUs\n", cus, per_cu);
        grid = 256;
    }
    P p{}; for (int i = 0; i < 31; ++i) p.in[i] = (const float*)d_in[i]; p.out = (float*)d_out; p.ws = (unsigned char*)d_ws;
    (void)hipMemsetAsync((char*)d_ws + WS_CTL, 0, 1 * MiB, stream);
    hipLaunchKernelGGL(mk_fwd, dim3(grid), dim3(NWAVES * 64), LDS_BYTES, stream, p, 0, 15);
}
```
